# Optimizing an MI355X kernel written in HIP

```python
import math
import jax
import jax.numpy as jnp
from jax import lax
import numpy as np


D_MODEL = 1024
BATCH = 8
SEQ = 2048
DEPTH = 4

GRID_W = 64
CTX_LEN = 256
Q_BLOCK = 128
ROPE_BASE = 10000.0
EPS = 1e-6

A_HEADS = 4
A_HD = 64
A_VD = 2 * A_HD
B_HEADS = 8
B_NOPE = 64
B_ROPE = 32
B_QK = B_NOPE + B_ROPE
B_VD = 64
B_QLORA = 384
B_KVLORA = 256
POOL_WINDOWS = (2, 4, 8, 16)
POOL_GROUP = 128
C_WIDTH = len(POOL_WINDOWS) * POOL_GROUP
D_WIDTH = 512
N_BRANCH = 4
BRANCH_W = 512
D_FF = 4 * D_MODEL

IN_SIZES = (2 * A_HEADS * A_HD, 2 * A_HEADS * A_HD, A_HEADS * A_VD,
            B_QLORA, B_KVLORA, B_ROPE,
            C_WIDTH,
            D_WIDTH, D_WIDTH, D_WIDTH,
            N_BRANCH * D_MODEL)
D_IN = sum(IN_SIZES)

kernel_name = 'hybrid_parallel_gated_diffusion_block'


def rmsnorm(x, g):
    xf = x.astype(jnp.float32)
    y = xf * lax.rsqrt(jnp.mean(xf * xf, axis=-1, keepdims=True) + EPS)
    return (y * g.astype(jnp.float32)).astype(x.dtype)


def modulate(h, shift, scale):
    return h * (1.0 + scale) + shift


def rope_tables(n_tok, rot_dim):
    rows = n_tok // GRID_W
    row = jnp.repeat(jnp.arange(rows, dtype=jnp.float32), GRID_W)
    col = jnp.tile(jnp.arange(GRID_W, dtype=jnp.float32), rows)
    n_freq = rot_dim // 4
    inv = ROPE_BASE ** (-jnp.arange(n_freq, dtype=jnp.float32) / n_freq)
    ang = jnp.concatenate([row[:, None] * inv, col[:, None] * inv], axis=-1)
    return jnp.cos(ang), jnp.sin(ang)


def apply_rope(t, cos, sin):
    half = t.shape[-1] // 2
    tf = t.astype(jnp.float32)
    t1, t2 = tf[..., :half], tf[..., half:]
    return jnp.concatenate([t1 * cos - t2 * sin, t1 * sin + t2 * cos], axis=-1).astype(t.dtype)


def split_in(p):
    outs = []
    off = 0
    for n in IN_SIZES:
        outs.append(p[..., off:off + n])
        off += n
    return outs


def to_heads(t, n_heads):
    b, s, _ = t.shape
    return t.reshape(b, s, n_heads, -1).transpose(0, 2, 1, 3)


def from_heads(t):
    b, h, s, d = t.shape
    return t.transpose(0, 2, 1, 3).reshape(b, s, h * d)


def attend(qs, ks, v, coef):
    m, b, h, s, dk = qs.shape
    nb = s // Q_BLOCK
    qb = jnp.moveaxis(qs.reshape(m, b, h, nb, Q_BLOCK, dk), 3, 0)
    scale = dk ** -0.5

    def block(qi):
        sc = jnp.einsum('mbhqd,mbhkd->mbhqk', qi, ks, preferred_element_type=jnp.float32) * scale
        p = jnp.einsum('m,mbhqk->bhqk', coef, jax.nn.softmax(sc, axis=-1))
        return jnp.einsum('bhqk,bhkd->bhqd', p.astype(v.dtype), v)

    o = lax.map(block, qb)
    return jnp.moveaxis(o, 0, 2).reshape(b, h, s, v.shape[-1])


def diff_qkv(pq, pk, pv, gq, gk, rope):
    b, s, _ = pq.shape
    q = rmsnorm(pq.reshape(b, s, A_HEADS, 2, A_HD), gq).transpose(3, 0, 2, 1, 4)
    k = rmsnorm(pk.reshape(b, s, A_HEADS, 2, A_HD), gk).transpose(3, 0, 2, 1, 4)
    v = to_heads(pv, A_HEADS)
    if rope is not None:
        q = apply_rope(q, *rope)
        k = apply_rope(k, *rope)
    return q, k, v


def diff_post(o, g_sub, lam_init):
    return from_heads(rmsnorm(o, g_sub) * (1.0 - lam_init))


def mla_qkv(pcq, pckv, pkr, g_cq, w_uq, g_ckv, w_ukv, gq, gk, rope):
    b, s, _ = pcq.shape
    q = (rmsnorm(pcq, g_cq) @ w_uq).reshape(b, s, B_HEADS, B_QK)
    kv = (rmsnorm(pckv, g_ckv) @ w_ukv).reshape(b, s, B_HEADS, B_NOPE + B_VD)
    q = jnp.concatenate([rmsnorm(q[..., :B_NOPE], gq[:B_NOPE]),
                         rmsnorm(q[..., B_NOPE:], gq[B_NOPE:])], axis=-1).transpose(0, 2, 1, 3)
    k_nope = rmsnorm(kv[..., :B_NOPE], gk[:B_NOPE]).transpose(0, 2, 1, 3)
    k_rope = rmsnorm(pkr, gk[B_NOPE:])[:, None, :, :]
    v = kv[..., B_NOPE:].transpose(0, 2, 1, 3)
    if rope is not None:
        q = jnp.concatenate([q[..., :B_NOPE], apply_rope(q[..., B_NOPE:], *rope)], axis=-1)
        k_rope = apply_rope(k_rope, *rope)
    k = jnp.concatenate([k_nope, jnp.broadcast_to(k_rope, k_nope.shape[:3] + (B_ROPE,))], axis=-1)
    return q, k, v


def pool_mixer(u, w_pool, s_pool):
    b, s, _ = u.shape
    uf = u.astype(jnp.float32)
    cs = jnp.pad(jnp.cumsum(uf, axis=1), ((0, 0), (1, 0), (0, 0)))
    t = jnp.arange(s)
    outs = []
    for gi, w in enumerate(POOL_WINDOWS):
        lo = jnp.clip(t - w // 2, 0, s)
        hi = jnp.clip(t + w // 2, 0, s)
        sl = slice(gi * POOL_GROUP, (gi + 1) * POOL_GROUP)
        csg = cs[..., sl]
        mean = (csg[:, hi] - csg[:, lo]) / (hi - lo).astype(jnp.float32)[:, None]
        outs.append(mean - uf[..., sl])
    d = jnp.stack(outs, axis=2).astype(u.dtype)
    y = jnp.einsum('bsgc,gcd->bsgd', d, w_pool).reshape(b, s, C_WIDTH)
    return y * s_pool


def conv_mixer(pb, pc, px, w_conv):
    u = pc * px
    up = jnp.pad(u, ((0, 0), (1, 1), (0, 0)))
    y = up[:, :-2] * w_conv[0] + up[:, 1:-1] * w_conv[1] + up[:, 2:] * w_conv[2]
    return pb * y


def merge_branches(ys, gate_logits, w_branch, w_o):
    b, s, _ = gate_logits.shape
    y = jnp.stack(ys, axis=2)
    proj = jnp.einsum('bsnc,ncd->bsnd', y, w_branch)
    g = jax.nn.sigmoid(gate_logits.reshape(b, s, N_BRANCH, D_MODEL))
    return jnp.einsum('bsnd,bsnd->bsd', g, proj) @ w_o


def squared_relu_mlp(h, w1, w2):
    a = jax.nn.relu(h @ w1)
    return (a * a) @ w2


def setup_inputs(seed: int = 0) -> dict:
    key = jax.random.key(seed)
    ks = jax.random.split(key, 26)
    f32 = jnp.float32

    def nrm(k, shape, scale):
        return jax.random.normal(k, shape, f32) * scale

    def gain(k, shape, noise=0.05):
        return 1.0 + nrm(k, shape, noise)

    return {
        'x': nrm(ks[0], (BATCH, SEQ, D_MODEL), 1.0),
        'c': nrm(ks[1], (BATCH, D_MODEL), 1.0),
        'ctx': nrm(ks[2], (BATCH, CTX_LEN, D_MODEL), 1.0),
        'c_ctx': nrm(ks[3], (D_MODEL,), 1.0),
        'w_mod': nrm(ks[4], (DEPTH, D_MODEL, 6 * D_MODEL), D_MODEL ** -0.5),
        'b_mod': nrm(ks[5], (DEPTH, 6 * D_MODEL), 0.02),
        'g_norm1': gain(ks[6], (DEPTH, D_MODEL)),
        'g_norm2': gain(ks[7], (DEPTH, D_MODEL)),
        'w_in': nrm(ks[8], (DEPTH, D_MODEL, D_IN), D_MODEL ** -0.5),
        'gq_a': gain(ks[9], (DEPTH, A_HD)),
        'gk_a': gain(ks[10], (DEPTH, A_HD)),
        'lam_a': nrm(ks[11], (DEPTH, 4, A_HD), 0.1),
        'g_sub_a': gain(ks[12], (DEPTH, A_VD)),
        'g_cq': gain(ks[13], (DEPTH, B_QLORA)),
        'w_uq': nrm(ks[14], (DEPTH, B_QLORA, B_HEADS * B_QK), B_QLORA ** -0.5),
        'g_ckv': gain(ks[15], (DEPTH, B_KVLORA)),
        'w_ukv': nrm(ks[16], (DEPTH, B_KVLORA, B_HEADS * (B_NOPE + B_VD)), B_KVLORA ** -0.5),
        'gq_b': gain(ks[17], (DEPTH, B_QK)),
        'gk_b': gain(ks[18], (DEPTH, B_QK)),
        'w_pool': nrm(ks[19], (DEPTH, len(POOL_WINDOWS), POOL_GROUP, POOL_GROUP), POOL_GROUP ** -0.5),
        's_pool': gain(ks[20], (DEPTH, C_WIDTH), 0.1),
        'w_conv': nrm(ks[21], (DEPTH, 3, D_WIDTH), 3 ** -0.5),
        'w_branch': nrm(ks[22], (DEPTH, N_BRANCH, BRANCH_W, D_MODEL), BRANCH_W ** -0.5),
        'w_o': nrm(ks[23], (DEPTH, D_MODEL, D_MODEL), D_MODEL ** -0.5),
        'w_ff1': nrm(ks[24], (DEPTH, D_MODEL, D_FF), D_MODEL ** -0.5),
        'w_ff2': nrm(ks[25], (DEPTH, D_FF, D_MODEL), D_FF ** -0.5),
    }


def reference(x, c, ctx, c_ctx, w_mod, b_mod, g_norm1, g_norm2, w_in, gq_a, gk_a, lam_a, g_sub_a,
              g_cq, w_uq, g_ckv, w_ukv, gq_b, gk_b, w_pool, s_pool, w_conv, w_branch, w_o,
              w_ff1, w_ff2):
    n_lat = x.shape[1]
    rope_a = rope_tables(n_lat, A_HD)
    rope_b = rope_tables(n_lat, B_ROPE)
    coef_b = jnp.ones((1,), jnp.float32)
    xc = ctx
    for l in range(DEPTH):
        last = l == DEPTH - 1
        lam_init = 0.8 - 0.6 * math.exp(-0.3 * l)
        mod_x = jnp.split((jax.nn.silu(c) @ w_mod[l] + b_mod[l])[:, None, :], 6, axis=-1)
        mod_c = jnp.split(jax.nn.silu(c_ctx) @ w_mod[l] + b_mod[l], 6, axis=-1)

        px = split_in(modulate(rmsnorm(x, g_norm1[l]), mod_x[0], mod_x[1]) @ w_in[l])
        pc = split_in(modulate(rmsnorm(xc, g_norm1[l]), mod_c[0], mod_c[1]) @ w_in[l])

        la = lam_a[l].astype(jnp.float32)
        lam = jnp.exp(jnp.sum(la[0] * la[1])) - jnp.exp(jnp.sum(la[2] * la[3])) + lam_init
        coef_a = jnp.stack([jnp.ones((), jnp.float32), -lam])
        qa_x, ka_x, va_x = diff_qkv(px[0], px[1], px[2], gq_a[l], gk_a[l], rope_a)
        qa_c, ka_c, va_c = diff_qkv(pc[0], pc[1], pc[2], gq_a[l], gk_a[l], None)
        ka_all = jnp.concatenate([ka_c, ka_x], axis=3)
        va_all = jnp.concatenate([va_c, va_x], axis=2)
        ya_x = diff_post(attend(qa_x, ka_all, va_all, coef_a), g_sub_a[l], lam_init)

        qb_x, kb_x, vb_x = mla_qkv(px[3], px[4], px[5], g_cq[l], w_uq[l], g_ckv[l], w_ukv[l],
                                   gq_b[l], gk_b[l], rope_b)
        qb_c, kb_c, vb_c = mla_qkv(pc[3], pc[4], pc[5], g_cq[l], w_uq[l], g_ckv[l], w_ukv[l],
                                   gq_b[l], gk_b[l], None)
        kb_all = jnp.concatenate([kb_c, kb_x], axis=2)
        vb_all = jnp.concatenate([vb_c, vb_x], axis=2)
        yb_x = from_heads(attend(qb_x[None], kb_all[None], vb_all, coef_b))

        mix_x = merge_branches([ya_x, yb_x,
                                pool_mixer(px[6], w_pool[l], s_pool[l]),
                                conv_mixer(px[7], px[8], px[9], w_conv[l])],
                               px[10], w_branch[l], w_o[l])
        x = x + mod_x[2] * mix_x
        x = x + mod_x[5] * squared_relu_mlp(modulate(rmsnorm(x, g_norm2[l]), mod_x[3], mod_x[4]),
                                            w_ff1[l], w_ff2[l])

        if not last:
            ya_c = diff_post(attend(qa_c, ka_c, va_c, coef_a), g_sub_a[l], lam_init)
            yb_c = from_heads(attend(qb_c[None], kb_c[None], vb_c, coef_b))
            mix_c = merge_branches([ya_c, yb_c,
                                    pool_mixer(pc[6], w_pool[l], s_pool[l]),
                                    conv_mixer(pc[7], pc[8], pc[9], w_conv[l])],
                                   pc[10], w_branch[l], w_o[l])
            xc = xc + mod_c[2] * mix_c
            xc = xc + mod_c[5] * squared_relu_mlp(modulate(rmsnorm(xc, g_norm2[l]), mod_c[3], mod_c[4]),
                                                  w_ff1[l], w_ff2[l])
    return x
```

```cpp
#include <hip/hip_runtime.h>
#include <hip/hip_cooperative_groups.h>
#include <cstdio>
#include <cstdint>
namespace cg = cooperative_groups;

#ifndef PHM
#define PHM 0xffff
#endif
#ifndef MK_COOP
#define MK_COOP 1
#endif

#define LAS __attribute__((address_space(3)))
typedef unsigned short bf16_t;
typedef short bf16x8 __attribute__((ext_vector_type(8)));
typedef float f32x2 __attribute__((ext_vector_type(2)));
typedef float f32x4 __attribute__((ext_vector_type(4)));
typedef float f32x8 __attribute__((ext_vector_type(8)));
typedef float f32x16 __attribute__((ext_vector_type(16)));
typedef unsigned u32x2 __attribute__((ext_vector_type(2)));
typedef unsigned u32x4 __attribute__((ext_vector_type(4)));
typedef __bf16 bf16x2_t __attribute__((ext_vector_type(2)));

constexpr int DM = 1024, NB = 8, SEQ = 2048, DEPTH = 4, CTX = 256, TK = CTX + SEQ;
constexpr int MX = NB * SEQ, MC = NB * CTX, MT = MX + MC;
constexpr int DIN = 8352, NPM = 4352, NPG = 4096, NIN = NPM + NPG, DFF = 4096;
constexpr int NGATE0 = 4256;
constexpr float EPS = 1e-6f;
constexpr int C_Q = 0, C_K = 512, C_V = 1024, C_CQ = 1536, C_CKV = 1920, C_KR = 2176, C_POOL = 2208, C_PB = 2720, C_PC = 3232, C_PX = 3744;

constexpr size_t MiB = 1u << 20;
constexpr size_t WS_WIN = 0, WS_WUQ = 17 * MiB, WS_WUKV = 18 * MiB, WS_WBR = 19 * MiB, WS_WO4 = 23 * MiB, WS_WF1 = 31 * MiB, WS_WF2 = 39 * MiB;
constexpr size_t WS_MOD = 48 * MiB, WS_LAM = 49 * MiB, WS_KR = 50 * MiB;
constexpr size_t WS_BAR = 51 * MiB + 512 * 1024;
constexpr size_t WS_XC = 52 * MiB;
constexpr size_t WS_Y = 60 * MiB, WS_H = WS_Y;
constexpr size_t WS_MIX = WS_Y + 36 * MiB;
constexpr size_t WS_QA = 132 * MiB, WS_KA = 150 * MiB, WS_VA = 168 * MiB;
constexpr size_t WS_CQ = 186 * MiB, WS_CKV = 200 * MiB;
constexpr size_t WS_R1 = 209 * MiB;
constexpr size_t WS_QBR = WS_R1, WS_KVR = WS_R1 + 27 * MiB, WS_QB = WS_R1 + 63 * MiB, WS_KB = WS_R1 + 90 * MiB, WS_VB = WS_R1 + 117 * MiB;
constexpr size_t WS_R2 = 362 * MiB;
constexpr size_t WS_VM = 49 * MiB + 4096, WS_BIAS1 = 49 * MiB + 512 * 1024, WS_BIAS2 = 49 * MiB + 832 * 1024;
constexpr size_t WS_PART = 506 * MiB;
constexpr size_t WS_END = 508 * MiB;
constexpr int LDS_BYTES = 131072 + 1024 + 10 * 2048;

struct Params {
    const float *x, *c, *ctx, *c_ctx, *w_mod, *b_mod, *g1, *g2, *w_in, *gq_a, *gk_a, *lam_a, *g_sub, *g_cq, *w_uq, *g_ckv, *w_ukv, *gq_b, *gk_b,
        *w_pool, *s_pool, *w_conv, *w_branch, *w_o, *w_ff1, *w_ff2;
    float* out; unsigned char* ws;
};

typedef const __attribute__((address_space(4))) Params* KP;
__device__ __forceinline__ unsigned cvtpk(float lo, float hi) { f32x2 v = {lo, hi}; bf16x2_t b = __builtin_convertvector(v, bf16x2_t); return __builtin_bit_cast(unsigned, b); }
__device__ __forceinline__ f32x8 unpack8(u32x4 w) {
    f32x8 r;
    r[0] = __uint_as_float(w.x << 16); r[1] = __uint_as_float(w.x & 0xffff0000u); r[2] = __uint_as_float(w.y << 16); r[3] = __uint_as_float(w.y & 0xffff0000u);
    r[4] = __uint_as_float(w.z << 16); r[5] = __uint_as_float(w.z & 0xffff0000u); r[6] = __uint_as_float(w.w << 16); r[7] = __uint_as_float(w.w & 0xffff0000u);
    return r;
}
__device__ __forceinline__ f32x4 unpack4(u32x2 w) {
    f32x4 r; r[0] = __uint_as_float(w.x << 16); r[1] = __uint_as_float(w.x & 0xffff0000u); r[2] = __uint_as_float(w.y << 16); r[3] = __uint_as_float(w.y & 0xffff0000u); return r;
}
__device__ __forceinline__ u32x4 pack8(f32x8 v) { u32x4 w; w.x = cvtpk(v[0], v[1]); w.y = cvtpk(v[2], v[3]); w.z = cvtpk(v[4], v[5]); w.w = cvtpk(v[6], v[7]); return w; }
__device__ __forceinline__ u32x2 pack4(f32x4 v) { u32x2 w; w.x = cvtpk(v[0], v[1]); w.y = cvtpk(v[2], v[3]); return w; }
__device__ __forceinline__ u32x4 ld16(const bf16_t* p) { return *(const u32x4*)p; }
template <int O> __device__ __forceinline__ float shx(float v) {
    if constexpr (O < 32) return __builtin_bit_cast(float, __builtin_amdgcn_ds_swizzle(__builtin_bit_cast(int, v), (O << 10) | 0x1f));
    else { auto rr = __builtin_amdgcn_permlane32_swap(__builtin_bit_cast(unsigned, v), __builtin_bit_cast(unsigned, v), false, false);
           const float a = __builtin_bit_cast(float, (unsigned)rr[0]), b = __builtin_bit_cast(float, (unsigned)rr[1]); return a == v ? b : a; }
}
__device__ __forceinline__ float xsum32(float v) { auto rr = __builtin_amdgcn_permlane32_swap(__builtin_bit_cast(unsigned, v), __builtin_bit_cast(unsigned, v), false, false);
    return __builtin_bit_cast(float, (unsigned)rr[0]) + __builtin_bit_cast(float, (unsigned)rr[1]); }
__device__ __forceinline__ float xmax32(float v) { auto rr = __builtin_amdgcn_permlane32_swap(__builtin_bit_cast(unsigned, v), __builtin_bit_cast(unsigned, v), false, false);
    return fmaxf(__builtin_bit_cast(float, (unsigned)rr[0]), __builtin_bit_cast(float, (unsigned)rr[1])); }
__device__ __forceinline__ float wave_sum(float v) {
    v += shx<1>(v); v += shx<2>(v); v += shx<4>(v); v += shx<8>(v); v += shx<16>(v); return xsum32(v);
}
__device__ __forceinline__ float sum8(f32x8 v) { return ((v[0] * v[0] + v[1] * v[1]) + (v[2] * v[2] + v[3] * v[3])) + ((v[4] * v[4] + v[5] * v[5]) + (v[6] * v[6] + v[7] * v[7])); }
__device__ __forceinline__ int olane() { int l; asm volatile("v_mbcnt_lo_u32_b32 %0, -1, 0\n\tv_mbcnt_hi_u32_b32 %0, -1, %0" : "=v"(l)); return l; }
#define otid() ((wv << 6) | olane())
__device__ __forceinline__ int obid() { int t = blockIdx.x; asm volatile("" : "+s"(t)); return t; }
__device__ __forceinline__ float rsq(float x) { return __builtin_amdgcn_rsqf(x); }

__device__ constexpr float INVA_REV[16] = {1.591549431e-01f, 8.949940161e-02f, 5.032921210e-02f, 2.830219583e-02f, 1.591549431e-02f, 8.949940161e-03f, 5.032921210e-03f, 2.830219583e-03f, 1.591549431e-03f, 8.949940161e-04f, 5.032921210e-04f, 2.830219583e-04f, 1.591549431e-04f, 8.949940161e-05f, 5.032921210e-05f, 2.830219583e-05f};
__device__ constexpr float INVB_REV[8] = {1.591549431e-01f, 5.032921210e-02f, 1.591549431e-02f, 5.032921210e-03f, 1.591549431e-03f, 5.032921210e-04f, 1.591549431e-04f, 5.032921210e-05f};
__device__ constexpr float LAM_INIT[4] = {2.000000000e-01f, 3.555090676e-01f, 4.707130183e-01f, 5.560582042e-01f};

namespace pg8 {
constexpr int BM = 256, BK = 64, HALF = 128, HTB = HALF * BK * 2, STAGE_BYTES = 8 * HTB, NXCD = 8, WGM = 8;
__host__ __device__ __forceinline__ int lds_byte(int r, int c) { const int st = (r >> 4) * 2 + (c >> 5), rr = r & 15, cc = c & 31, ob = rr * 64 + cc * 2; return st * 1024 + (ob ^ (((ob >> 9) & 1) << 5)); }
__host__ __device__ __forceinline__ void stage_rc(int b, int& R, int& C) { const int st = b / 1024, sb = b % 1024, swz = sb ^ (((sb >> 9) & 1) << 5); R = (st >> 1) * 16 + swz / 64; C = (st & 1) * 32 + (swz % 64) / 2; }
__host__ __device__ __forceinline__ int perm32(int rho) { const int n = rho >> 4, i = rho & 15; return 8 * (i >> 2) + 4 * n + (i & 3); }

struct Unit { int pm, pn; };
struct Gemm { const bf16_t* A; const bf16_t* Bt; int K, lda, ldb, zshift; size_t zA; };

struct StaticOrder {
    int nM, nN, nwg, G, c;
    __device__ void init(int M, int N, int G_, int c_) { nM = M / BM; nN = N / BM; nwg = nM * nN; G = G_; c = c_; }
    __device__ bool next(int i, Unit& u) const {
        const long L = (long)i * G + c; if (L >= nwg) return false;
        int wgid = (int)L; { const int q = nwg / NXCD, r = nwg % NXCD, xcd = wgid % NXCD, off = wgid / NXCD; wgid = (xcd < r ? xcd * (q + 1) : r * (q + 1) + (xcd - r) * q) + off; }
        const int nig = WGM * nN, gid = wgid / nig, fm = gid * WGM, gsz = (nM - fm) < WGM ? (nM - fm) : WGM;
        u.pm = fm + ((wgid % nig) % gsz); u.pn = (wgid % nig) / gsz; return true;
    }
};

template <int MODE> struct Epi {
    static constexpr bool PERM = true, TAB = (MODE == 1 || MODE == 4);
    bf16_t* O; int ldc; int split_tile; bf16_t* O2; int ldc2;
    const bf16_t* gate;
    float* xo; float* xc; const float* mod; const float* xi; const float* xci;
    const float* vm; bf16_t* Hout; float* part;
    const float* partr; const float* bias; int bias_ld;
    __device__ __forceinline__ void operator()(const f32x4 (&acc)[2][2][4][2], const Unit& u, int wr, int wc, int fr, int fq, const LAS float* tab) const {
        const int ln_ = olane(); const int fr_ = ln_ & 15, fq_ = ln_ >> 4; (void)fr; (void)fq;
        const int row0 = u.pm * BM + wr * 64 + fr_;
        const int ct = u.pn * BM + wc * 32 + 8 * fq_;
        if constexpr (MODE == 0 || MODE == 1 || MODE == 4) {
            bf16_t* base = O; int ld = ldc; int c0 = ct;
            if (MODE == 1 && u.pn >= split_tile) { base = O2; ld = ldc2; c0 = ct - split_tile * BM; }
            float rs[8];
#pragma unroll
            for (int i = 0; i < 8; ++i) rs[i] = 1.f;
            if (MODE != 0) {
#pragma unroll
                for (int i = 0; i < 8; ++i) rs[i] = tab[wr * 64 + fr_ + (i >> 2) * HALF + (i & 3) * 16]; }
#pragma unroll
            for (int bj = 0; bj < 2; ++bj) {
                f32x4 b0 = {0.f, 0.f, 0.f, 0.f}, b1 = b0;
                if (MODE != 0) { const LAS float* bp = tab + 256 + wc * 32 + 8 * fq_ + bj * HALF; b0 = *(const LAS f32x4*)bp; b1 = *(const LAS f32x4*)(bp + 4); }
#pragma unroll
                for (int i = 0; i < 8; ++i) { const int ai = i >> 2, m = i & 3; bf16_t* rowp = base + (size_t)(row0 + ai * HALF + m * 16) * ld + c0;
                    if (MODE == 1 && (u.pn == 4 || u.pn == 5)) {
                        const bool isx = u.pm < MX / BM; const int bb = isx ? (u.pm >> 3) : (u.pm - MX / BM), ar0 = isx ? CTX + (u.pm & 7) * BM : 0;
                        rowp = Hout + ((size_t)(bb * 4 + 2 * (u.pn - 4) + bj) * TK + ar0 + wr * 64 + fr_ + ai * HALF + m * 16) * 128 + wc * 32 + 8 * fq_ - bj * HALF; }
                    f32x4 v0 = acc[ai][bj][m][0], v1 = acc[ai][bj][m][1];
                    if (MODE != 0) { v0 = v0 * rs[i] + b0; v1 = v1 * rs[i] + b1; }
                    if (MODE == 4) {
#pragma unroll
                        for (int e = 0; e < 4; ++e) { float a = fmaxf(v0[e], 0.f), b = fmaxf(v1[e], 0.f); v0[e] = a * a; v1[e] = b * b; } }
                    u32x4 w; w.x = cvtpk(v0[0], v0[1]); w.y = cvtpk(v0[2], v0[3]); w.z = cvtpk(v1[0], v1[1]); w.w = cvtpk(v1[2], v1[3]);
                    *(u32x4*)(rowp + bj * HALF) = w; } }
        } else if constexpr (MODE == 6 || MODE == 7) {
            LAS float* xb = (LAS float*)tab;
            const bool isx = u.pm < MX / BM;
            const int b = isx ? (u.pm >> 3) : (u.pm - MX / BM);
            const int arow0 = isx ? CTX + (u.pm & 7) * BM : 0, t0 = (u.pm & 7) * BM;
            const int lr0 = wr * 64 + fr_;
#pragma unroll
            for (int bj = 0; bj < 2; ++bj)
#pragma unroll
                for (int i = 0; i < 8; ++i) { const f32x4 v0 = acc[i >> 2][bj][i & 3][0], v1 = acc[i >> 2][bj][i & 3][1];
                    float s = ((v0[0] * v0[0] + v0[1] * v0[1]) + (v0[2] * v0[2] + v0[3] * v0[3])) + ((v1[0] * v1[0] + v1[1] * v1[1]) + (v1[2] * v1[2] + v1[3] * v1[3]));
                    s += shx<16>(s); s = xsum32(s);
                    if (fq_ == 0) xb[((lr0 + (i >> 2) * HALF + (i & 3) * 16) * 2 + bj) * 4 + wc] = s; }
            asm volatile("s_waitcnt lgkmcnt(0)" ::: "memory"); __builtin_amdgcn_s_barrier(); asm volatile("" ::: "memory");
            const bool rope_tile = (MODE == 6) && (u.pn == 2);
            const bool vwave = (MODE == 7) && (wc >= 2);
#pragma unroll
            for (int bj = 0; bj < 2; ++bj) {
                const int h = (MODE == 7) ? (2 * u.pn + bj) : (rope_tile ? (4 * bj + wc) : (4 * u.pn + 2 * bj + (wc >> 1)));
                const size_t hb = (size_t)(b * 8 + h) * TK + arow0;
                f32x8 gn;
#pragma unroll
                for (int e = 0; e < 8; ++e) gn[e] = mod[(rope_tile ? 64 : (wc & 1) * 32) + 8 * fq_ + e];
#pragma unroll
                for (int i = 0; i < 8; ++i) { const int lr = lr0 + (i >> 2) * HALF + (i & 3) * 16; const f32x4 v0 = acc[i >> 2][bj][i & 3][0], v1 = acc[i >> 2][bj][i & 3][1];
                    f32x8 v; v[0] = v0[0]; v[1] = v0[1]; v[2] = v0[2]; v[3] = v0[3]; v[4] = v1[0]; v[5] = v1[1]; v[6] = v1[2]; v[7] = v1[3];
                    if (vwave) {
                        *(u32x4*)(O2 + (hb + lr) * 64 + (wc - 2) * 32 + 8 * fq_) = pack8(v);
                        if (wc == 2) *(u32x4*)(O + (hb + lr) * 96 + 64 + 8 * fq_) = ld16(gate + (size_t)(u.pm * BM + lr) * 32 + 8 * fq_);
                    } else if (rope_tile) {
                        const float rs = rsq(xb[((lr * 2 + bj) * 4 + wc)] * (1.f / 32.f) + EPS);
#pragma unroll
                        for (int e = 0; e < 8; ++e) v[e] = v[e] * rs * gn[e];
                        if (isx) { const int t = t0 + lr; const float pos = (float)((fq_ & 1) ? (t & 63) : (t >> 6));
#pragma unroll
                            for (int e = 0; e < 8; ++e) { const float a = pos * INVB_REV[e]; const float cs = __builtin_amdgcn_cosf(a), sn = __builtin_amdgcn_sinf(a); const float o = shx<32>(v[e]);
                                v[e] = (fq_ & 2) ? (o * sn + v[e] * cs) : (v[e] * cs - o * sn); } }
                        *(u32x4*)(O + (hb + lr) * 96 + 64 + 8 * fq_) = pack8(v);
                    } else {
                        const LAS float* xp = xb + ((lr * 2 + bj) * 4 + (wc & 2));
                        const float rs = rsq((xp[0] + xp[1]) * (1.f / 64.f) + EPS);
#pragma unroll
                        for (int e = 0; e < 8; ++e) v[e] = v[e] * rs * gn[e];
                        *(u32x4*)(O + (hb + lr) * 96 + (wc & 1) * 32 + 8 * fq_) = pack8(v);
                    } } }
            asm volatile("s_waitcnt lgkmcnt(0)" ::: "memory"); __builtin_amdgcn_s_barrier(); asm volatile("" ::: "memory");
        } else if constexpr (MODE == 2) {
#pragma unroll
            for (int bj = 0; bj < 2; ++bj) {
                u32x4 gw[8];
#pragma unroll
                for (int i = 0; i < 8; ++i) gw[i] = ld16(gate + (size_t)(row0 + (i >> 2) * HALF + (i & 3) * 16) * NPG + ct + bj * HALF);
#pragma unroll
                for (int i = 0; i < 8; ++i) { const int ai = i >> 2, m = i & 3; const size_t off = (size_t)(row0 + ai * HALF + m * 16) * NPG + ct + bj * HALF;
                    const f32x8 g = unpack8(gw[i]); const f32x4 v0 = acc[ai][bj][m][0], v1 = acc[ai][bj][m][1]; f32x8 o;
#pragma unroll
                    for (int e = 0; e < 8; ++e) { const float sg = __builtin_amdgcn_rcpf(1.f + __builtin_amdgcn_exp2f(-1.4426950408889634f * g[e])); o[e] = (e < 4 ? v0[e & 3] : v1[e & 3]) * sg; }
                    *(u32x4*)(O + off) = pack8(o); } }
        } else if (MODE == 3 && ldc != 12345) {
            const int R = u.pm * BM;
            float* xb = (R < MX) ? xo + (size_t)R * DM : xc + (size_t)(R - MX) * DM;
            const float* xr = (R < MX) ? xi + (size_t)R * DM : xci + (size_t)(R - MX) * DM;
            const int mr = (R < MX) ? (R >> 11) : 8;
            float ss[8];
#pragma unroll
            for (int i = 0; i < 8; ++i) ss[i] = 0.f;
#pragma unroll
            for (int bj = 0; bj < 2; ++bj) {
                const float* gp = mod + (size_t)mr * 6144 + ct + bj * HALF; const f32x4 g0 = *(const f32x4*)gp, g1 = *(const f32x4*)(gp + 4);
                f32x4 w0 = {0.f, 0.f, 0.f, 0.f}, w1 = w0;
                if (vm) { const float* vp = vm + (size_t)mr * DM + ct + bj * HALF; w0 = *(const f32x4*)vp; w1 = *(const f32x4*)(vp + 4); }
#define MK_RES_BATCH(I0, NB) { f32x4 xa[NB], xbv[NB]; \
                    _Pragma("unroll") for (int q = 0; q < NB; ++q) { const int i = (I0) + q; const int lr = wr * 64 + fr_ + (i >> 2) * HALF + (i & 3) * 16; const float* xp = xr + (size_t)lr * DM + ct + bj * HALF; xa[q] = *(const f32x4*)xp; xbv[q] = *(const f32x4*)(xp + 4); } \
                    _Pragma("unroll") for (int q = 0; q < NB; ++q) { const int i = (I0) + q; const int ai = i >> 2, m = i & 3; const int lr = wr * 64 + fr_ + ai * HALF + m * 16; float* xp = xb + (size_t)lr * DM + ct + bj * HALF; \
                        f32x4 xv0 = xa[q] + g0 * acc[ai][bj][m][0], xv1 = xbv[q] + g1 * acc[ai][bj][m][1]; \
                        *(f32x4*)xp = xv0; *(f32x4*)(xp + 4) = xv1; \
                        if (vm) { ss[i] += ((xv0[0] * xv0[0] + xv0[1] * xv0[1]) + (xv0[2] * xv0[2] + xv0[3] * xv0[3])) + ((xv1[0] * xv1[0] + xv1[1] * xv1[1]) + (xv1[2] * xv1[2] + xv1[3] * xv1[3])); \
                            const f32x4 h0 = xv0 * w0, h1 = xv1 * w1; u32x4 w; w.x = cvtpk(h0[0], h0[1]); w.y = cvtpk(h0[2], h0[3]); w.z = cvtpk(h1[0], h1[1]); w.w = cvtpk(h1[2], h1[3]); \
                            *(u32x4*)(Hout + (size_t)(R + lr) * DM + ct + bj * HALF) = w; } } }
                if (bj == 0) { MK_RES_BATCH(0, 4) MK_RES_BATCH(4, 4) } else { MK_RES_BATCH(0, 8) }
#undef MK_RES_BATCH
            }
            if (vm) {
#pragma unroll
                for (int i = 0; i < 8; ++i) { float s = ss[i]; s += shx<16>(s); s = xsum32(s); const int lr = wr * 64 + fr_ + (i >> 2) * HALF + (i & 3) * 16;
                    if (fq_ == 0) part[(size_t)(R + lr) * 16 + u.pn * 4 + wc] = s; } }
        }
    }
};

template <class EpiT, class Sched>
__device__ __forceinline__ void gemm_phase(LAS unsigned char* lds, const Gemm g, const Sched& S, const EpiT& E, int wv) {
    LAS float* tab = (LAS float*)(lds + STAGE_BYTES + 1024);
    const int tid = otid(), wid = __builtin_amdgcn_readfirstlane(tid >> 6), lane = tid & 63, wr = wid >> 2, wc = wid & 3, fr = lane & 15, fq = lane >> 4;
    const int K = g.K, nt = K / BK;
    unsigned voffA[2], voffB[2];
#pragma unroll
    for (int i = 0; i < 2; ++i) { int R, C; stage_rc(tid * 16 + i * 8192, R, C); const int Rb = EpiT::PERM ? ((R & ~31) + perm32(R & 31)) : R;
        voffA[i] = (unsigned)(R * g.lda + C) * 2u; voffB[i] = (unsigned)(Rb * g.ldb + C) * 2u; }
    const size_t kstep = (size_t)(BK * 2);
    const size_t hstepA = (size_t)HALF * g.lda * 2, hstepB = (size_t)HALF * g.ldb * 2;
    const size_t tstepA = 2 * hstepA, tstepB = 2 * hstepB;
    const unsigned ldsw = (unsigned)wid * 1024u;
    const int foff = lds_byte(fr, fq * 8);
    const int aoff = wr * 8192 + foff, boff = wc * 4096 + foff;
#define PG8_SA(b, h) (((b) * 2 + (h)) * HTB)
#define PG8_SB(b, h) ((4 + (b) * 2 + (h)) * HTB)
#define PG8_STAGE(bufoff, gbase, voff) do { _Pragma("unroll") for (int _i = 0; _i < 2; ++_i) \
        __builtin_amdgcn_global_load_lds((const unsigned*)((const char*)(gbase) + (voff)[_i]), (LAS unsigned*)(lds + (bufoff) + ldsw + _i * 8192), 16, 0, 0); } while (0)
#define PG8_LDA(dst, b, h) do { _Pragma("unroll") for (int m = 0; m < 4; ++m) _Pragma("unroll") for (int k = 0; k < 2; ++k) dst[m][k] = *(const LAS bf16x8*)(lds + PG8_SA(b, h) + aoff + m * 2048 + k * 1024); } while (0)
#define PG8_LDB(dst, b, h) do { _Pragma("unroll") for (int n = 0; n < 2; ++n) _Pragma("unroll") for (int k = 0; k < 2; ++k) dst[n][k] = *(const LAS bf16x8*)(lds + PG8_SB(b, h) + boff + n * 2048 + k * 1024); } while (0)
#define PG8_MMA(ai, bj, At, Bt) do { __builtin_amdgcn_s_setprio(1); _Pragma("unroll") for (int m = 0; m < 4; ++m) _Pragma("unroll") for (int n = 0; n < 2; ++n) _Pragma("unroll") for (int k = 0; k < 2; ++k) \
        acc[ai][bj][m][n] = __builtin_amdgcn_mfma_f32_16x16x32_bf16(Bt[n][k], At[m][k], acc[ai][bj][m][n], 0, 0, 0); __builtin_amdgcn_s_setprio(0); } while (0)
#define PG8_WAIT_V(n) asm volatile("s_waitcnt vmcnt(" #n ")" ::: "memory")
#define PG8_WAIT_L(n) asm volatile("s_waitcnt lgkmcnt(" #n ")" ::: "memory")
#define PG8_BAR __builtin_amdgcn_s_barrier()
#define PG8_SCHED __builtin_amdgcn_sched_barrier(0)
    Unit cur, nxt; int ui = 0;
    if (!S.next(0, cur)) return;
    if constexpr (EpiT::TAB) {
        Unit tu;
        for (int i = 0; S.next(i, tu); ++i) {
            if (tid < 256) { const f32x4* pp = (const f32x4*)(E.partr + (size_t)(tu.pm * BM + tid) * 16); const f32x4 p0 = pp[0], p1 = pp[1], p2 = pp[2], p3 = pp[3];
                const f32x4 ps = (p0 + p1) + (p2 + p3); tab[i * 512 + tid] = rsq(((ps[0] + ps[1]) + (ps[2] + ps[3])) * (1.f / DM) + EPS); }
            else { const int mr = (tu.pm * BM < MX) ? ((tu.pm * BM) >> 11) : 8; tab[i * 512 + tid] = E.bias[(size_t)mr * E.bias_ld + tu.pn * BM + (tid - 256)]; }
        }
        __syncthreads();
    }
    f32x4 acc[2][2][4][2];
#pragma unroll
    for (int a = 0; a < 2; ++a)
#pragma unroll
        for (int b = 0; b < 2; ++b)
#pragma unroll
            for (int m = 0; m < 4; ++m)
#pragma unroll
                for (int n = 0; n < 2; ++n) acc[a][b][m][n] = (f32x4){0.f, 0.f, 0.f, 0.f};
    bf16x8 At[4][2], B0[2][2], B1[2][2];
    const char* cA = (const char*)g.A + (size_t)cur.pm * tstepA + (size_t)(cur.pn >> g.zshift) * g.zA; const char* cB = (const char*)g.Bt + (size_t)cur.pn * tstepB;
    PG8_STAGE(PG8_SB(0, 0), cB, voffB); PG8_STAGE(PG8_SB(0, 1), cB + hstepB, voffB); PG8_STAGE(PG8_SA(0, 0), cA, voffA); PG8_STAGE(PG8_SA(0, 1), cA + hstepA, voffA);
    if (wr == 1) PG8_BAR;
    PG8_WAIT_V(2); PG8_BAR;
    PG8_STAGE(PG8_SB(1, 0), cB + kstep, voffB); PG8_STAGE(PG8_SA(1, 0), cA + kstep, voffA); PG8_STAGE(PG8_SB(1, 1), cB + hstepB + kstep, voffB);
    PG8_WAIT_V(6); PG8_BAR;
    for (;;) {
        const bool has_next = S.next(ui + 1, nxt);
        const char* nA = has_next ? (const char*)g.A + (size_t)nxt.pm * tstepA + (size_t)(nxt.pn >> g.zshift) * g.zA : cA; const char* nB = has_next ? (const char*)g.Bt + (size_t)nxt.pn * tstepB : cB;
        for (int t = 0; t < nt; t += 2) {
            const bool last = (t == nt - 2);
            const char* a1 = cA + (size_t)(t + 1) * kstep;
            const char* a2 = last ? nA : cA + (size_t)(t + 2) * kstep; const char* b2 = last ? nB : cB + (size_t)(t + 2) * kstep;
            const char* a3 = a2 + kstep; const char* b3 = b2 + kstep;
            PG8_LDB(B0, 0, 0); PG8_LDB(B1, 0, 1); PG8_SCHED; PG8_LDA(At, 0, 0); PG8_STAGE(PG8_SA(1, 1), a1 + hstepA, voffA);
            PG8_WAIT_V(8); PG8_WAIT_L(0); PG8_BAR; PG8_MMA(0, 0, At, B0); PG8_MMA(0, 1, At, B1); PG8_BAR; PG8_SCHED;
            PG8_LDA(At, 0, 1); PG8_STAGE(PG8_SB(0, 0), b2, voffB); PG8_STAGE(PG8_SB(0, 1), b2 + hstepB, voffB); PG8_STAGE(PG8_SA(0, 0), a2, voffA);
            PG8_WAIT_V(8); PG8_WAIT_L(0); PG8_BAR; PG8_MMA(1, 0, At, B0); PG8_MMA(1, 1, At, B1); PG8_BAR; PG8_SCHED;
            PG8_LDB(B0, 1, 0); PG8_LDB(B1, 1, 1); PG8_SCHED; PG8_LDA(At, 1, 0); PG8_STAGE(PG8_SA(0, 1), a2 + hstepA, voffA);
            PG8_WAIT_V(8); PG8_WAIT_L(0); PG8_BAR; PG8_MMA(0, 0, At, B0); PG8_MMA(0, 1, At, B1); PG8_BAR; PG8_SCHED;
            PG8_LDA(At, 1, 1); PG8_STAGE(PG8_SB(1, 0), b3, voffB); PG8_STAGE(PG8_SB(1, 1), b3 + hstepB, voffB); PG8_STAGE(PG8_SA(1, 0), a3, voffA);
            PG8_WAIT_V(8); PG8_WAIT_L(0); PG8_BAR; PG8_MMA(1, 0, At, B0); PG8_MMA(1, 1, At, B1); PG8_BAR; PG8_SCHED;
        }
        if (wr == 0) PG8_BAR;
        E(acc, cur, wr, wc, fr, fq, EpiT::TAB ? tab + ui * 512 : tab);
        if (!has_next) break;
#pragma unroll
        for (int a = 0; a < 2; ++a)
#pragma unroll
            for (int b = 0; b < 2; ++b)
#pragma unroll
                for (int m = 0; m < 4; ++m)
#pragma unroll
                    for (int n = 0; n < 2; ++n) acc[a][b][m][n] = (f32x4){0.f, 0.f, 0.f, 0.f};
        cur = nxt; cA = nA; cB = nB; ++ui;
        if (wr == 1) PG8_BAR;
    }
    PG8_WAIT_V(0);
    PG8_BAR;
#undef PG8_SA
#undef PG8_SB
#undef PG8_STAGE
#undef PG8_LDA
#undef PG8_LDB
#undef PG8_MMA
#undef PG8_WAIT_V
#undef PG8_WAIT_L
#undef PG8_BAR
#undef PG8_SCHED
}
}

#define MFMA32(a, b, c) __builtin_amdgcn_mfma_f32_32x32x16_bf16((a), (b), (c), 0, 0, 0)
constexpr int ATT_BUF = 32768, ATT_VOFF = 13312, ATT_VP = 136;

template <int DK, int DV, int VAR>
__device__ __forceinline__ void attn_pass(LAS unsigned char* lds, const bf16_t* Qg, const bf16_t* Kg, const bf16_t* Vg, int ntiles, float cs, f32x16 (&O)[DV / 32], float& lsum, int wv) {
    constexpr int KP = DK * 2 + 16, KCH = DK / 8, NKC = 64 * KCH;
    const int tid = otid(), lane = tid & 63, wid = tid >> 6, l32 = lane & 31, hf = lane >> 5;
    bf16x8 qf[DK / 16];
    { const bf16_t* qrow = Qg + (size_t)(wid * 32 + l32) * DK + hf * 8;
#pragma unroll
      for (int kk = 0; kk < DK / 16; ++kk) qf[kk] = *(const bf16x8*)(qrow + kk * 16); }
    const int kc0 = tid, kc1 = tid + 512;
    const int kr0 = kc0 / KCH, kq0 = kc0 % KCH, kr1 = kc1 / KCH, kq1 = kc1 % KCH;
    const bool k1on = (kc1 < NKC);
    const int kp = (DV == 128 ? (wid >> 2) : ((wid >> 1) & 1)) * 16 + (lane & 15);
    const int vch = (DV == 128 ? (wid & 3) : (wid & 1)) * 4 + (lane >> 4);
    const bool von = (DV == 128) || (wid < 4);
    const bf16_t* kg0 = Kg + kr0 * DK + kq0 * 8; const bf16_t* kg1 = Kg + kr1 * DK + kq1 * 8;
    const bf16_t* vg0 = Vg + (size_t)(2 * kp) * DV + vch * 8;
    const unsigned kl0 = kr0 * KP + kq0 * 16, kl1 = kr1 * KP + kq1 * 16, vl0 = ATT_VOFF + (vch * 8) * ATT_VP + kp * 4;
    u32x4 ka0, ka1, va0, va1;
    { unsigned z0 = 0u; asm volatile("" : "+v"(z0)); ka1 = (u32x4){z0, z0, z0, z0}; } va0 = ka1; va1 = ka1; ka0 = ka1;
#define ATT_LOADK(t, r0, r1) do { r0 = *(const u32x4*)(kg0 + (size_t)(t) * 64 * DK); if (k1on) r1 = *(const u32x4*)(kg1 + (size_t)(t) * 64 * DK); } while (0)
#define ATT_LOADV(t, r0, r1) do { if (von) { r0 = *(const u32x4*)(vg0 + (size_t)(t) * 64 * DV); r1 = *(const u32x4*)(vg0 + (size_t)(t) * 64 * DV + DV); } } while (0)
#define ATT_STOREK(bi, r0, r1) do { LAS unsigned char* kb_ = lds + (bi) * ATT_BUF; *(LAS u32x4*)(kb_ + kl0) = r0; if (k1on) *(LAS u32x4*)(kb_ + kl1) = r1; } while (0)
#define ATT_STOREV(bi, r0, r1) do { if (von) { LAS unsigned char* vb_ = lds + (bi) * ATT_BUF + vl0; \
            *(LAS unsigned*)(vb_ + 0 * ATT_VP) = (r0.x & 0xffffu) | (r1.x << 16); *(LAS unsigned*)(vb_ + 1 * ATT_VP) = (r0.x >> 16) | (r1.x & 0xffff0000u); \
            *(LAS unsigned*)(vb_ + 2 * ATT_VP) = (r0.y & 0xffffu) | (r1.y << 16); *(LAS unsigned*)(vb_ + 3 * ATT_VP) = (r0.y >> 16) | (r1.y & 0xffff0000u); \
            *(LAS unsigned*)(vb_ + 4 * ATT_VP) = (r0.z & 0xffffu) | (r1.z << 16); *(LAS unsigned*)(vb_ + 5 * ATT_VP) = (r0.z >> 16) | (r1.z & 0xffff0000u); \
            *(LAS unsigned*)(vb_ + 6 * ATT_VP) = (r0.w & 0xffffu) | (r1.w << 16); *(LAS unsigned*)(vb_ + 7 * ATT_VP) = (r0.w >> 16) | (r1.w & 0xffff0000u); } } while (0)
#define ATT_QK(bi, S0, S1) do { const unsigned ka_ = (unsigned)(unsigned long long)(lds + (bi) * ATT_BUF + l32 * KP + hf * 16); \
        bf16x8 kfa[DK / 16], kfb[DK / 16]; \
          \
        if constexpr (DK == 64) { \
            asm volatile("ds_read_b128 %0, %8\n\tds_read_b128 %1, %8 offset:%9\n\tds_read_b128 %2, %8 offset:32\n\tds_read_b128 %3, %8 offset:%10\n\t" \
                         "ds_read_b128 %4, %8 offset:64\n\tds_read_b128 %5, %8 offset:%11\n\tds_read_b128 %6, %8 offset:96\n\tds_read_b128 %7, %8 offset:%12\n\ts_waitcnt lgkmcnt(0)" \
                         : "=&v"(kfa[0]), "=&v"(kfb[0]), "=&v"(kfa[1]), "=&v"(kfb[1]), "=&v"(kfa[2]), "=&v"(kfb[2]), "=&v"(kfa[3]), "=&v"(kfb[3]) \
                         : "v"(ka_), "n"(32 * KP), "n"(32 * KP + 32), "n"(32 * KP + 64), "n"(32 * KP + 96) : "memory"); \
        } else { \
            asm volatile("ds_read_b128 %0, %12\n\tds_read_b128 %1, %12 offset:%13\n\tds_read_b128 %2, %12 offset:32\n\tds_read_b128 %3, %12 offset:%14\n\t" \
                         "ds_read_b128 %4, %12 offset:64\n\tds_read_b128 %5, %12 offset:%15\n\tds_read_b128 %6, %12 offset:96\n\tds_read_b128 %7, %12 offset:%16\n\t" \
                         "ds_read_b128 %8, %12 offset:128\n\tds_read_b128 %9, %12 offset:%17\n\tds_read_b128 %10, %12 offset:160\n\tds_read_b128 %11, %12 offset:%18\n\ts_waitcnt lgkmcnt(0)" \
                         : "=&v"(kfa[0]), "=&v"(kfb[0]), "=&v"(kfa[1]), "=&v"(kfb[1]), "=&v"(kfa[2]), "=&v"(kfb[2]), "=&v"(kfa[3]), "=&v"(kfb[3]), "=&v"(kfa[DK / 16 - 2]), "=&v"(kfb[DK / 16 - 2]), "=&v"(kfa[DK / 16 - 1]), "=&v"(kfb[DK / 16 - 1]) \
                         : "v"(ka_), "n"(32 * KP), "n"(32 * KP + 32), "n"(32 * KP + 64), "n"(32 * KP + 96), "n"(32 * KP + 128), "n"(32 * KP + 160) : "memory"); \
        } \
        _Pragma("unroll") for (int i = 0; i < 16; ++i) { S0[i] = 0.f; S1[i] = 0.f; } \
        _Pragma("unroll") for (int kk = 0; kk < DK / 16; ++kk) { S0 = MFMA32(kfa[kk], qf[kk], S0); S1 = MFMA32(kfb[kk], qf[kk], S1); } } while (0)
#define ATT_VISSUE(vl, vh, base) asm volatile("ds_read_b64 %0, %16\n\tds_read_b64 %1, %16 offset:16\n\tds_read_b64 %2, %16 offset:32\n\tds_read_b64 %3, %16 offset:48\n\t" \
                         "ds_read_b64 %4, %16 offset:64\n\tds_read_b64 %5, %16 offset:80\n\tds_read_b64 %6, %16 offset:96\n\tds_read_b64 %7, %16 offset:112\n\t" \
                         "ds_read_b64 %8, %16 offset:%17\n\tds_read_b64 %9, %16 offset:%18\n\tds_read_b64 %10, %16 offset:%19\n\tds_read_b64 %11, %16 offset:%20\n\t" \
                         "ds_read_b64 %12, %16 offset:%21\n\tds_read_b64 %13, %16 offset:%22\n\tds_read_b64 %14, %16 offset:%23\n\tds_read_b64 %15, %16 offset:%24" \
                         : "=&v"(vl[0]), "=&v"(vh[0]), "=&v"(vl[1]), "=&v"(vh[1]), "=&v"(vl[2]), "=&v"(vh[2]), "=&v"(vl[3]), "=&v"(vh[3]), \
                           "=&v"(vl[4]), "=&v"(vh[4]), "=&v"(vl[5]), "=&v"(vh[5]), "=&v"(vl[6]), "=&v"(vh[6]), "=&v"(vl[7]), "=&v"(vh[7]) \
                         : "v"(base), "n"(32 * ATT_VP), "n"(32 * ATT_VP + 16), "n"(32 * ATT_VP + 32), "n"(32 * ATT_VP + 48), "n"(32 * ATT_VP + 64), "n"(32 * ATT_VP + 80), "n"(32 * ATT_VP + 96), "n"(32 * ATT_VP + 112) : "memory")
#define ATT_VWAIT(vl, vh) asm volatile("s_waitcnt lgkmcnt(0)" : "+v"(vl[0]), "+v"(vh[0]), "+v"(vl[1]), "+v"(vh[1]), "+v"(vl[2]), "+v"(vh[2]), "+v"(vl[3]), "+v"(vh[3]), \
                           "+v"(vl[4]), "+v"(vh[4]), "+v"(vl[5]), "+v"(vh[5]), "+v"(vl[6]), "+v"(vh[6]), "+v"(vl[7]), "+v"(vh[7]) :: "memory")
#define ATT_VFRAG(vl, vh, i) __builtin_bit_cast(bf16x8, (u32x4){vl[i].x, vl[i].y, vh[i].x, vh[i].y})
#define ATT_SOFTMAX_PV(bi, S0, S1) do { \
        const unsigned va_ = (unsigned)(unsigned long long)(lds + (bi) * ATT_BUF + ATT_VOFF + l32 * ATT_VP + 8 * hf); \
        u32x2 vl[8], vh[8]; \
        if (VAR != 4) ATT_VISSUE(vl, vh, va_);                        \
        float mx = fmaxf(fmaxf(S0[0], S1[0]), fmaxf(S0[1], S1[1])); \
        _Pragma("unroll") for (int i = 2; i < 16; i += 2) mx = fmaxf(mx, fmaxf(fmaxf(S0[i], S1[i]), fmaxf(S0[i + 1], S1[i + 1]))); \
        mx = xmax32(mx); \
        if (__builtin_amdgcn_ballot_w64(mx > mrun) != 0ull) { const float mnew = fmaxf(mrun, mx); const float alpha = __builtin_amdgcn_exp2f((mrun - mnew) * cs); mrun = mnew; lrun *= alpha; \
            _Pragma("unroll") for (int tt = 0; tt < DV / 32; ++tt) O[tt] *= alpha; } \
        const float mc = mrun * cs; const f32x2 cs2 = {cs, cs}, mc2 = {mc, mc}; f32x2 ps2 = {0.f, 0.f}; \
        _Pragma("unroll") for (int i = 0; i < 16; i += 2) { f32x2 a = {S0[i], S0[i + 1]}, c = {S1[i], S1[i + 1]}; a = a * cs2 - mc2; c = c * cs2 - mc2; \
            if (VAR != 2) { a.x = __builtin_amdgcn_exp2f(a.x); a.y = __builtin_amdgcn_exp2f(a.y); c.x = __builtin_amdgcn_exp2f(c.x); c.y = __builtin_amdgcn_exp2f(c.y); } ps2 += a; ps2 += c; \
            S0[i] = a.x; S0[i + 1] = a.y; S1[i] = c.x; S1[i + 1] = c.y; } \
        lrun += ps2.x + ps2.y; \
        bf16x8 pf[4]; \
        _Pragma("unroll") for (int j = 0; j < 4; ++j) { u32x4 w; \
            if (j < 2) { w.x = cvtpk(S0[8 * j + 0], S0[8 * j + 1]); w.y = cvtpk(S0[8 * j + 2], S0[8 * j + 3]); w.z = cvtpk(S0[8 * j + 4], S0[8 * j + 5]); w.w = cvtpk(S0[8 * j + 6], S0[8 * j + 7]); } \
            else { const int jj = j - 2; w.x = cvtpk(S1[8 * jj + 0], S1[8 * jj + 1]); w.y = cvtpk(S1[8 * jj + 2], S1[8 * jj + 3]); w.z = cvtpk(S1[8 * jj + 4], S1[8 * jj + 5]); w.w = cvtpk(S1[8 * jj + 6], S1[8 * jj + 7]); } \
            pf[j] = __builtin_bit_cast(bf16x8, w); } \
        if (VAR == 4) { _Pragma("unroll") for (int tt = 0; tt < DV / 32; ++tt) _Pragma("unroll") for (int j = 0; j < 4; ++j) O[tt][j] += __builtin_bit_cast(float, (int)pf[j][0]); } else { \
            ATT_VWAIT(vl, vh); \
            _Pragma("unroll") for (int j = 0; j < 4; ++j) O[0] = MFMA32(ATT_VFRAG(vl, vh, j), pf[j], O[0]); \
            _Pragma("unroll") for (int j = 0; j < 4; ++j) O[1] = MFMA32(ATT_VFRAG(vl, vh, 4 + j), pf[j], O[1]); \
            if constexpr (DV == 128) { const unsigned vc_ = va_ + 64 * ATT_VP; u32x2 wl[8], wh[8]; ATT_VISSUE(wl, wh, vc_); ATT_VWAIT(wl, wh); \
                _Pragma("unroll") for (int j = 0; j < 4; ++j) O[2] = MFMA32(ATT_VFRAG(wl, wh, j), pf[j], O[2]); \
                _Pragma("unroll") for (int j = 0; j < 4; ++j) O[3] = MFMA32(ATT_VFRAG(wl, wh, 4 + j), pf[j], O[3]); } } } while (0)
#pragma unroll
    for (int t = 0; t < DV / 32; ++t)
#pragma unroll
        for (int i = 0; i < 16; ++i) O[t][i] = 0.f;
    float mrun = -1e30f, lrun = 0.f;
    f32x16 Sa0, Sa1;
    __syncthreads();
    ATT_LOADK(0, ka0, ka1); ATT_LOADV(0, va0, va1);
    for (int t = 0; t < ntiles; ++t) {
        if (VAR != 1 || t < 2) { ATT_STOREK(t & 1, ka0, ka1); ATT_STOREV(t & 1, va0, va1); }
        __syncthreads();
        if (VAR != 1) { if (t + 1 < ntiles) { ATT_LOADK(t + 1, ka0, ka1); ATT_LOADV(t + 1, va0, va1); } }
        if (VAR != 3) { ATT_QK(t & 1, Sa0, Sa1); } else {
#pragma unroll
            for (int i = 0; i < 16; ++i) { Sa0[i] = (float)(t + i) * 1e-3f; Sa1[i] = (float)(t - i) * 1e-3f; } }
        ATT_SOFTMAX_PV(t & 1, Sa0, Sa1);
    }
    lsum = xsum32(lrun);
#undef ATT_LOADK
#undef ATT_LOADV
#undef ATT_STOREK
#undef ATT_STOREV
#undef ATT_QK
#undef ATT_SOFTMAX_PV
#undef ATT_VISSUE
#undef ATT_VWAIT
#undef ATT_VFRAG
}

template <int VAR> __device__ __forceinline__ void attn_unit_a(LAS unsigned char* lds, KP p, int l, int bh, int qb, int wv) {
    unsigned char* ws = p->ws;
    const int b = bh >> 2, h = bh & 3;
    const int tid_ = otid(); const int lane = tid_ & 63, wid = tid_ >> 6, l32 = lane & 31, hf = lane >> 5;
    const int ntiles = qb == 0 ? CTX / 64 : TK / 64;
    const int q0 = qb == 0 ? 0 : CTX + (qb - 1) * 256;
    const bf16_t* QA = (const bf16_t*)(ws + WS_QA); const bf16_t* KA = (const bf16_t*)(ws + WS_KA); const bf16_t* VA = (const bf16_t*)(ws + WS_VA);
    const float cs = 0.125f * 1.4426950408889634f;
    const float lam = ((const float*)(ws + WS_LAM))[l];
    const float lam_init = ((const float*)(ws + WS_LAM))[8 + l];
    f32x16 O[4]; float lsum;
    const bf16_t* Vg = VA + (size_t)(b * 4 + h) * TK * 128;
    attn_pass<64, 128, VAR>(lds, QA + ((size_t)(b * 8 + h * 2 + 0) * TK + q0) * 64, KA + (size_t)(b * 8 + h * 2 + 0) * TK * 64, Vg, ntiles, cs, O, lsum, wv);
    LAS unsigned* o0 = (LAS unsigned*)(lds + 65536 + wid * 8192) + lane;
    { const float inv = 1.f / lsum;
#pragma unroll
      for (int t = 0; t < 4; ++t)
#pragma unroll
          for (int i = 0; i < 8; ++i) o0[(t * 8 + i) * 64] = cvtpk(O[t][2 * i] * inv, O[t][2 * i + 1] * inv); }
    attn_pass<64, 128, VAR>(lds, QA + ((size_t)(b * 8 + h * 2 + 1) * TK + q0) * 64, KA + (size_t)(b * 8 + h * 2 + 1) * TK * 64, Vg, ntiles, cs, O, lsum, wv);
    const float inv1 = lam / lsum;
    float ss = 0.f;
#pragma unroll
    for (int t = 0; t < 4; ++t)
#pragma unroll
        for (int i = 0; i < 8; ++i) { const unsigned ow = o0[(t * 8 + i) * 64]; const float a = __uint_as_float(ow << 16) - O[t][2 * i] * inv1, c = __uint_as_float(ow & 0xffff0000u) - O[t][2 * i + 1] * inv1;
            O[t][2 * i] = a; O[t][2 * i + 1] = c; ss += a * a + c * c; }
    ss = xsum32(ss);
    const float rs = rsq(ss * (1.f / 128.f) + EPS) * (1.f - lam_init);
    const int row = (qb == 0 ? MX + b * CTX : b * SEQ + (qb - 1) * 256) + wid * 32 + l32;
    if (VAR != 0 && rs != 12345.f) return;
    bf16_t* yp = (bf16_t*)(ws + WS_Y) + (size_t)row * 2048 + h * 128 + 4 * hf;
    const float* gs = p->g_sub + l * 128 + 4 * hf;
#pragma unroll
    for (int t = 0; t < 4; ++t)
#pragma unroll
        for (int i4 = 0; i4 < 4; ++i4) { const f32x4 g = *(const f32x4*)(gs + 32 * t + 8 * i4);
            f32x4 v; v[0] = O[t][4 * i4] * rs * g[0]; v[1] = O[t][4 * i4 + 1] * rs * g[1]; v[2] = O[t][4 * i4 + 2] * rs * g[2]; v[3] = O[t][4 * i4 + 3] * rs * g[3];
            *(u32x2*)(yp + 32 * t + 8 * i4) = pack4(v); }
}
template <int VAR> __device__ __forceinline__ void attn_unit_b(LAS unsigned char* lds, KP p, int bh, int qb, int wv) {
    unsigned char* ws = p->ws;
    const int b = bh >> 3, h = bh & 7;
    const int tid_ = otid(); const int lane = tid_ & 63, wid = tid_ >> 6, l32 = lane & 31, hf = lane >> 5;
    const int ntiles = qb == 0 ? CTX / 64 : TK / 64;
    const int q0 = qb == 0 ? 0 : CTX + (qb - 1) * 256;
    const bf16_t* QB = (const bf16_t*)(ws + WS_QB); const bf16_t* KB = (const bf16_t*)(ws + WS_KB); const bf16_t* VB = (const bf16_t*)(ws + WS_VB);
    const float cs = 0.10206207261596577f * 1.4426950408889634f;
    f32x16 O[2]; float lsum;
    attn_pass<96, 64, VAR>(lds, QB + ((size_t)bh * TK + q0) * 96, KB + (size_t)bh * TK * 96, VB + (size_t)bh * TK * 64, ntiles, cs, O, lsum, wv);
    const float inv = 1.f / lsum;
    const int row = (qb == 0 ? MX + b * CTX : b * SEQ + (qb - 1) * 256) + wid * 32 + l32;
    if (VAR != 0 && inv != 12345.f) return;
    bf16_t* yp = (bf16_t*)(ws + WS_Y) + (size_t)row * 2048 + 512 + h * 64 + 4 * hf;
#pragma unroll
    for (int t = 0; t < 2; ++t)
#pragma unroll
        for (int i4 = 0; i4 < 4; ++i4) { f32x4 v; v[0] = O[t][4 * i4] * inv; v[1] = O[t][4 * i4 + 1] * inv; v[2] = O[t][4 * i4 + 2] * inv; v[3] = O[t][4 * i4 + 3] * inv;
            *(u32x2*)(yp + 32 * t + 8 * i4) = pack4(v); }
}
template <int VAR> __device__ __forceinline__ void attn_phase(LAS unsigned char* lds, KP p, int l, int wv) {
    const int G = gridDim.x, c = blockIdx.x;
    const int NU = (l == DEPTH - 1) ? 768 : 864;
    for (int u = c; u < NU; u += G) {
        if (u < 256) { const int xcd = u & 7, j = u >> 3; attn_unit_a<VAR>(lds, p, l, xcd * 4 + (j >> 3), 1 + (j & 7), wv); }
        else if (u < 768) { const int u2 = u - 256, r = u2 >> 8, c2 = u2 & 255, xcd = c2 & 7, j = c2 >> 3; attn_unit_b<VAR>(lds, p, xcd * 8 + (j >> 3) * 2 + r, 1 + (j & 7), wv); }
        else { const int u3 = u - 768; if (u3 < 32) attn_unit_a<VAR>(lds, p, l, u3, 0, wv); else attn_unit_b<VAR>(lds, p, u3 - 32, 0, wv); }
    }
}

__device__ __forceinline__ void tr_item(const float* W, int N, bf16_t* WT, int ldk, int row_off, int split, int shift, int ncopy, int copy_stride, LAS float* scr, int item, int lane) {
    const int nblk = N / 32, kb = item / nblk, nb = item % nblk, k0 = 64 * kb, n0 = 32 * nb;
    float wv_[32];
#pragma unroll
    for (int i = 0; i < 32; ++i) wv_[i] = W[(size_t)(k0 + 2 * i + (lane >> 5)) * N + n0 + (lane & 31)];
#pragma unroll
    for (int i = 0; i < 32; ++i) scr[(2 * i + (lane >> 5)) * 33 + (lane & 31)] = wv_[i];
    asm volatile("s_waitcnt lgkmcnt(0)" ::: "memory");
    const int c = lane & 7;
    const int rsh = row_off + n0 + (n0 >= split ? shift : 0);
#pragma unroll
    for (int j = 0; j < 4; ++j) { const int n = (lane >> 3) + 8 * j; const LAS float* s = scr + (8 * c) * 33 + n;
        u32x4 o; o.x = cvtpk(s[0 * 33], s[1 * 33]); o.y = cvtpk(s[2 * 33], s[3 * 33]); o.z = cvtpk(s[4 * 33], s[5 * 33]); o.w = cvtpk(s[6 * 33], s[7 * 33]);
        for (int cp = 0; cp < ncopy; ++cp) *(u32x4*)(WT + (size_t)(rsh + n) * ldk + cp * copy_stride + k0 + 8 * c) = o; }
    asm volatile("s_waitcnt lgkmcnt(0)" ::: "memory");
}
__device__ __forceinline__ void convert_weights(LAS unsigned char* lds, KP p, int l, int wv) {
    unsigned char* ws = p->ws;
    const int tid_ = otid(); const int lane = tid_ & 63, wid = tid_ >> 6;
    LAS float* scr = (LAS float*)(lds + wid * 8704);
    const int gw = blockIdx.x * 8 + wid, NGW = gridDim.x * 8;
    constexpr int I_IN = 16 * (DIN / 32), I_UQ = 6 * 24, I_UKV = 4 * 32, I_BR = 8 * 32, I_O = 16 * 32, I_F1 = 16 * 128, I_F2 = 64 * 32;
    constexpr int NIT = I_IN + I_UQ + I_UKV + 3 * I_BR + I_O + I_F1 + I_F2;
    const int BIG = 1 << 30;
    for (int it = gw; it < NIT; it += NGW) {
        int r = it;
        if (r < I_IN) { tr_item(p->w_in + (size_t)l * DM * DIN, DIN, (bf16_t*)(ws + WS_WIN), DM, 0, NGATE0, NPM - NGATE0, 1, 0, scr, r, lane); continue; } r -= I_IN;
        if (r < I_UQ) { const int nb = r % 24, hh = nb / 3, part = nb % 3, dest = part < 2 ? (2 * hh + part) * 32 : 512 + 32 * hh;
            tr_item(p->w_uq + (size_t)l * 384 * 768, 768, (bf16_t*)(ws + WS_WUQ), 384, dest - 32 * nb, BIG, 0, 1, 0, scr, r, lane); continue; } r -= I_UQ;
        if (r < I_UKV) { tr_item(p->w_ukv + (size_t)l * 256 * 1024, 1024, (bf16_t*)(ws + WS_WUKV), 256, 0, BIG, 0, 1, 0, scr, r, lane); continue; } r -= I_UKV;
        if (r < 3 * I_BR) { const int z3 = r / I_BR, z = z3 == 2 ? 3 : z3; tr_item(p->w_branch + ((size_t)l * 4 + z) * 512 * 1024, 1024, (bf16_t*)(ws + WS_WBR), 512, z * 1024, BIG, 0, 1, 0, scr, r % I_BR, lane); continue; } r -= 3 * I_BR;
        if (r < I_O) { tr_item(p->w_o + (size_t)l * DM * DM, DM, (bf16_t*)(ws + WS_WO4), 4096, 0, BIG, 0, 1, 0, scr, r, lane); continue; } r -= I_O;
        if (r < I_F1) { tr_item(p->w_ff1 + (size_t)l * DM * DFF, DFF, (bf16_t*)(ws + WS_WF1), DM, 0, BIG, 0, 1, 0, scr, r, lane); continue; } r -= I_F1;
        tr_item(p->w_ff2 + (size_t)l * DFF * DM, DM, (bf16_t*)(ws + WS_WF2), DFF, 0, BIG, 0, 1, 0, scr, r, lane);
    }
    { const int gt = blockIdx.x * 512 + otid(), NT = gridDim.x * 512; u32x4* z = (u32x4*)((bf16_t*)(ws + WS_WIN) + (size_t)NGATE0 * DM);
      unsigned z0 = 0u; asm volatile("" : "+v"(z0));
      for (int i = gt; i < (NPM - NGATE0) * DM / 8; i += NT) z[i] = (u32x4){z0, z0, z0, z0}; }
    { const float* wp = p->w_pool + (size_t)l * 4 * 128 * 128; const float* sp = p->s_pool + l * 512; const float* wb = p->w_branch + ((size_t)l * 4 + 2) * 512 * 1024;
      bf16_t* dst = (bf16_t*)(ws + WS_WBR) + (size_t)2048 * 512;
      LAS float* As = (LAS float*)lds;
      const int tid = otid();
      int gcur = -1;
      for (int it = blockIdx.x; it < 4 * 256; it += gridDim.x) {
          const int gi = it >> 8, d0 = (it & 255) * 4;
          if (gi != gcur) { __syncthreads();
              for (int i = tid; i < 128 * 128; i += 512) { const int cl = i >> 7, j = i & 127; As[cl * 129 + j] = wp[(size_t)gi * 16384 + i] * sp[gi * 128 + j]; }
              __syncthreads(); gcur = gi; }
          const int cl = tid & 127, d = d0 + __builtin_amdgcn_readfirstlane(tid >> 7);
          const float* br = wb + (size_t)gi * 128 * 1024 + d;
          float a = 0.f;
#pragma unroll 8
          for (int j = 0; j < 128; ++j) a += As[cl * 129 + j] * br[(size_t)j * 1024];
          dst[(size_t)d * 512 + gi * 128 + cl] = (bf16_t)(cvtpk(a, 0.f) & 0xffffu);
      }
      __syncthreads(); }
}
__device__ __forceinline__ void mod_phase(LAS unsigned char* lds, KP p, int wv) {
    LAS float* sv = (LAS float*)lds;
    LAS float* red = (LAS float*)(lds + 9 * 1024 * 4);
    const int tid = otid(), lane = tid & 63, wid = tid >> 6;
    for (int i = tid; i < 9 * 1024; i += 512) { const float v = i < 8192 ? p->c[i] : p->c_ctx[i - 8192]; sv[i] = v / (1.f + __expf(-v)); }
    __syncthreads();
    float* mod = (float*)(p->ws + WS_MOD);
    for (int it = blockIdx.x; it < DEPTH * 96; it += gridDim.x) {
        const int l = it / 96, n0 = (it % 96) * 64;
        const float* W = p->w_mod + (size_t)l * DM * 6144 + n0 + lane;
        float a[9];
#pragma unroll
        for (int r = 0; r < 9; ++r) a[r] = 0.f;
        for (int k = wid * 128; k < wid * 128 + 128; k += 8) { float w[8];
#pragma unroll
            for (int j = 0; j < 8; ++j) w[j] = W[(size_t)(k + j) * 6144];
#pragma unroll
            for (int r = 0; r < 9; ++r) { const f32x4 s0 = *(const LAS f32x4*)(sv + r * 1024 + k), s1 = *(const LAS f32x4*)(sv + r * 1024 + k + 4);
                a[r] += ((s0[0] * w[0] + s0[1] * w[1]) + (s0[2] * w[2] + s0[3] * w[3])) + ((s1[0] * w[4] + s1[1] * w[5]) + (s1[2] * w[6] + s1[3] * w[7])); } }
#pragma unroll
        for (int r = 0; r < 9; ++r) red[(wid * 9 + r) * 64 + lane] = a[r];
        __syncthreads();
        for (int o = tid; o < 9 * 64; o += 512) { const int r = o >> 6, n = o & 63; float s = p->b_mod[l * 6144 + n0 + n];
#pragma unroll
            for (int w = 0; w < 8; ++w) s += red[(w * 9 + r) * 64 + n];
            mod[((size_t)l * 9 + r) * 6144 + n0 + n] = s;
            const int nn = n0 + n, ch = nn >> 10, cc = nn & 1023;
            if (ch == 1) ((float*)(p->ws + WS_VM))[(((size_t)l * 2 + 0) * 9 + r) * DM + cc] = p->g1[l * DM + cc] * (1.f + s);
            if (ch == 4) ((float*)(p->ws + WS_VM))[(((size_t)l * 2 + 1) * 9 + r) * DM + cc] = p->g2[l * DM + cc] * (1.f + s); }
        __syncthreads();
    }
}
__device__ __forceinline__ void bias_gemv(LAS unsigned char* lds, KP p, int l, int wv) {
    LAS float* sv = (LAS float*)lds;
    LAS float* red = (LAS float*)(lds + 2 * 9 * 1024 * 4);
    const int tid = otid(), lane = tid & 63, wid = tid >> 6;
    const float* mod = (const float*)(p->ws + WS_MOD) + (size_t)l * 9 * 6144;
    __syncthreads();
    for (int i = tid; i < 2 * 9 * 1024; i += 512) { const int which = i / 9216, r = (i % 9216) >> 10, k = i & 1023; sv[i] = mod[(size_t)r * 6144 + (which ? 3 : 0) * 1024 + k]; }
    __syncthreads();
    constexpr int IT1 = (DIN + 63) / 64, IT2 = DFF / 64;
    for (int it = blockIdx.x; it < IT1 + IT2; it += gridDim.x) {
        const bool second = it >= IT1; const int n0 = (second ? it - IT1 : it) * 64; const int N = second ? DFF : DIN;
        const int col = n0 + lane; const bool on = col < N;
        const float* W = (second ? p->w_ff1 + (size_t)l * DM * DFF : p->w_in + (size_t)l * DM * DIN) + (on ? col : 0);
        const LAS float* s9 = sv + (second ? 9216 : 0);
        float a[9];
#pragma unroll
        for (int r = 0; r < 9; ++r) a[r] = 0.f;
        for (int k = wid * 128; k < wid * 128 + 128; k += 8) { float w[8];
#pragma unroll
            for (int j = 0; j < 8; ++j) w[j] = W[(size_t)(k + j) * N];
#pragma unroll
            for (int r = 0; r < 9; ++r) { const f32x4 s0 = *(const LAS f32x4*)(s9 + r * 1024 + k), s1 = *(const LAS f32x4*)(s9 + r * 1024 + k + 4);
                a[r] += ((s0[0] * w[0] + s0[1] * w[1]) + (s0[2] * w[2] + s0[3] * w[3])) + ((s1[0] * w[4] + s1[1] * w[5]) + (s1[2] * w[6] + s1[3] * w[7])); } }
#pragma unroll
        for (int r = 0; r < 9; ++r) red[(wid * 9 + r) * 64 + lane] = a[r];
        __syncthreads();
        for (int o = tid; o < 9 * 64; o += 512) { const int r = o >> 6, n = o & 63; const int c = n0 + n;
            if (c < N) { float s = 0.f;
#pragma unroll
                for (int w = 0; w < 8; ++w) s += red[(w * 9 + r) * 64 + n];
                if (second) ((float*)(p->ws + WS_BIAS2))[(size_t)r * DFF + c] = s;
                else ((float*)(p->ws + WS_BIAS1))[(size_t)r * NIN + (c < NGATE0 ? c : c + (NPM - NGATE0))] = s; } }
        __syncthreads();
    }
}
__device__ __forceinline__ void init_h(KP p, int wv) {
    const int tid_ = otid(); const int lane = tid_ & 63, wid = tid_ >> 6;
    const int gw = blockIdx.x * 8 + wid, NGW = gridDim.x * 8;
    const float* vm = (const float*)(p->ws + WS_VM);
    bf16_t* H = (bf16_t*)(p->ws + WS_H); float* part = (float*)(p->ws + WS_PART);
    for (int row = gw; row < MT; row += NGW) {
        const float* xr = row < MX ? p->x + (size_t)row * DM : p->ctx + (size_t)(row - MX) * DM;
        const float* vr = vm + (size_t)(row < MX ? (row >> 11) : 8) * DM;
        float s = 0.f;
#pragma unroll
        for (int j = 0; j < 4; ++j) { const int col = 4 * lane + 256 * j; const f32x4 v = *(const f32x4*)(xr + col); s += (v[0] * v[0] + v[1] * v[1]) + (v[2] * v[2] + v[3] * v[3]);
            *(u32x2*)(H + (size_t)row * DM + col) = pack4(v * *(const f32x4*)(vr + col)); }
        s = wave_sum(s);
        if (lane < 16) part[(size_t)row * 16 + lane] = lane == 0 ? s : 0.f;
    }
}
__device__ __forceinline__ void norm_phase(KP p, int l, int chunk, int nrows, int wv) {
    const int tid_ = otid(); const int lane = tid_ & 63, wid = tid_ >> 6;
    const int gw = blockIdx.x * 8 + wid, NGW = gridDim.x * 8;
    const float* g = (chunk == 0 ? p->g1 : p->g2) + l * DM;
    const float* mod = (const float*)(p->ws + WS_MOD) + (size_t)l * 9 * 6144;
    bf16_t* H = (bf16_t*)(p->ws + WS_H);
    for (int row = gw; row < nrows; row += NGW) {
        const float* xr = row < MX ? p->out + (size_t)row * DM : (const float*)(p->ws + WS_XC) + (size_t)(row - MX) * DM;
        const float* mr = mod + (size_t)(row < MX ? (row >> 11) : 8) * 6144 + chunk * 1024;
        f32x4 v[4]; float s = 0.f;
#pragma unroll
        for (int j = 0; j < 4; ++j) { v[j] = *(const f32x4*)(xr + 4 * lane + 256 * j); s += (v[j][0] * v[j][0] + v[j][1] * v[j][1]) + (v[j][2] * v[j][2] + v[j][3] * v[j][3]); }
        const float rs = rsq(wave_sum(s) * (1.f / DM) + EPS);
#pragma unroll
        for (int j = 0; j < 4; ++j) { const int col = 4 * lane + 256 * j; const f32x4 gv = *(const f32x4*)(g + col), sh = *(const f32x4*)(mr + col), sc = *(const f32x4*)(mr + 1024 + col);
            f32x4 o = (v[j] * rs * gv) * (1.f + sc) + sh; *(u32x2*)(H + (size_t)row * DM + col) = pack4(o); }
    }
}

__device__ __forceinline__ void prep1_phase(KP p, int l, int wv) {
    unsigned char* ws = p->ws;
    const int tid_ = otid(); const int lane = tid_ & 63, wid = tid_ >> 6;
    const int gw = blockIdx.x * 8 + wid, NGW = gridDim.x * 8;
    const bf16_t* __restrict__ Pm = (const bf16_t*)(ws + WS_R1);
    bf16_t* __restrict__ QA = (bf16_t*)(ws + WS_QA); bf16_t* __restrict__ KA = (bf16_t*)(ws + WS_KA); bf16_t* __restrict__ VA = (bf16_t*)(ws + WS_VA);
    bf16_t* __restrict__ CQ = (bf16_t*)(ws + WS_CQ); bf16_t* __restrict__ CKV = (bf16_t*)(ws + WS_CKV); bf16_t* __restrict__ KR = (bf16_t*)(ws + WS_KR); bf16_t* __restrict__ Y = (bf16_t*)(ws + WS_Y);
    f32x8 invA, invB, gq, gk, gcq, gckv, gkr;
#pragma unroll
    for (int e = 0; e < 8; ++e) { invA[e] = (lane & 1) ? INVA_REV[8 + e] : INVA_REV[e]; invB[e] = INVB_REV[e];
        gq[e] = p->gq_a[l * 64 + (lane & 7) * 8 + e]; gk[e] = p->gk_a[l * 64 + (lane & 7) * 8 + e];
        gcq[e] = lane < 48 ? p->g_cq[l * 384 + 8 * lane + e] : 0.f; gckv[e] = lane < 32 ? p->g_ckv[l * 256 + 8 * lane + e] : 0.f; gkr[e] = lane < 4 ? p->gk_b[l * 96 + 64 + 8 * lane + e] : 0.f; }
    const float* wcv = p->w_conv + (size_t)l * 3 * 512 + 8 * lane;
#pragma unroll 2
    for (int row = gw; row < MT; row += NGW) {
        const bool isx = row < MX;
        const int b = isx ? (row >> 11) : ((row - MX) >> 8);
        const int t = isx ? (row & 2047) : ((row - MX) & 255);
        const int S = isx ? SEQ : CTX;
        const int arow = isx ? CTX + t : t;
        const bf16_t* pr = Pm + (size_t)row * NPM;
        f32x8 csA, snA, csB, snB;
        if (isx) { const float posA = (float)((lane & 2) ? (t & 63) : (t >> 6)); const float posB = (float)((lane & 1) ? (t & 63) : (t >> 6));
#pragma unroll
            for (int e = 0; e < 8; ++e) { const float a = posA * invA[e]; csA[e] = __builtin_amdgcn_cosf(a); snA[e] = __builtin_amdgcn_sinf(a); const float bq = posB * invB[e]; csB[e] = __builtin_amdgcn_cosf(bq); snB[e] = __builtin_amdgcn_sinf(bq); } }
        const u32x4 rq = ld16(pr + C_Q + 8 * lane), rk = ld16(pr + C_K + 8 * lane);
        const u32x4 rcq = ld16(pr + C_CQ + 8 * min(lane, 47)), rckv = ld16(pr + C_CKV + 8 * (lane & 31)), rkr = ld16(pr + C_KR + 8 * (lane & 3));
        const u32x4 rpb = ld16(pr + C_PB + 8 * lane), rpc = ld16(pr + C_PC + 8 * lane), rpx = ld16(pr + C_PX + 8 * lane);
        const bf16_t* prm = (t > 0) ? pr - NPM : pr; const bf16_t* prp = (t < S - 1) ? pr + NPM : pr;
        const float fm = (t > 0) ? 1.f : 0.f, fp = (t < S - 1) ? 1.f : 0.f;
        const u32x4 rpcm = ld16(prm + C_PC + 8 * lane), rpxm = ld16(prm + C_PX + 8 * lane), rpcp = ld16(prp + C_PC + 8 * lane), rpxp = ld16(prp + C_PX + 8 * lane);
        const int hw = 1 << (lane >> 4); const int lo = max(t - hw, 0), hi = min(t + hw, S);
        const bf16_t* pp = pr + C_POOL + 8 * lane;
        u32x4 pw[16]; float pvf[16];
#pragma unroll
        for (int j = 0; j < 16; ++j) { const int o = j - 8; const int tt = t + o; const bool v = (o >= -hw) && (o < hw) && (tt >= 0) && (tt < S); pw[j] = ld16(pp + (ptrdiff_t)(v ? o : 0) * NPM); pvf[j] = v ? 1.f : 0.f; }
        const u32x4 rpu = ld16(pp);
        asm volatile("" ::: "memory");
#pragma unroll
        for (int which = 0; which < 2; ++which) {
            f32x8 v = unpack8(which == 0 ? rq : rk);
            float ss = sum8(v); ss += shx<1>(ss); ss += shx<2>(ss); ss += shx<4>(ss);
            const float rs = rsq(ss * (1.f / 64.f) + EPS);
#pragma unroll
            for (int e = 0; e < 8; ++e) v[e] = v[e] * rs * (which == 0 ? gq[e] : gk[e]);
            if (isx) {
#pragma unroll
                for (int e = 0; e < 8; ++e) { const float o = shx<4>(v[e]); v[e] = (lane & 4) ? (o * snA[e] + v[e] * csA[e]) : (v[e] * csA[e] - o * snA[e]); } }
            bf16_t* dst = (which == 0 ? QA : KA) + ((size_t)(b * 8 + (lane >> 3)) * TK + arow) * 64 + (lane & 7) * 8;
            *(u32x4*)dst = pack8(v);
        }
        { f32x8 v = unpack8(rcq);
          if (lane >= 48) {
#pragma unroll
              for (int e = 0; e < 8; ++e) v[e] = 0.f; }
          const float rs = rsq(wave_sum(sum8(v)) * (1.f / 384.f) + EPS);
          if (lane < 48) {
#pragma unroll
              for (int e = 0; e < 8; ++e) v[e] = v[e] * rs * gcq[e];
              *(u32x4*)(CQ + (size_t)row * 384 + 8 * lane) = pack8(v); } }
        { f32x8 v = unpack8(rckv);
          if (lane >= 32) {
#pragma unroll
              for (int e = 0; e < 8; ++e) v[e] = 0.f; }
          const float rs = rsq(wave_sum(sum8(v)) * (1.f / 256.f) + EPS);
          if (lane < 32) {
#pragma unroll
              for (int e = 0; e < 8; ++e) v[e] = v[e] * rs * gckv[e];
              *(u32x4*)(CKV + (size_t)row * 256 + 8 * lane) = pack8(v); } }
        { f32x8 v = unpack8(rkr);
          float ss = sum8(v); ss += shx<1>(ss); ss += shx<2>(ss);
          const float rs = rsq(ss * (1.f / 32.f) + EPS);
#pragma unroll
          for (int e = 0; e < 8; ++e) v[e] = v[e] * rs * p->gk_b[l * 96 + 64 + 8 * (lane & 3) + e];
          if (isx) {
#pragma unroll
              for (int e = 0; e < 8; ++e) { const float o = shx<2>(v[e]); v[e] = (lane & 2) ? (o * snB[e] + v[e] * csB[e]) : (v[e] * csB[e] - o * snB[e]); } }
          if (lane < 4) *(u32x4*)(KR + (size_t)row * 32 + 8 * lane) = pack8(v); }
        { f32x8 sum;
#pragma unroll
          for (int e = 0; e < 8; ++e) sum[e] = 0.f;
#pragma unroll
          for (int j = 0; j < 16; ++j) sum += unpack8(pw[j]) * pvf[j];
          const float inv = 1.f / (float)(hi - lo);
          *(u32x4*)(Y + (size_t)row * 2048 + 1024 + 8 * lane) = pack8(sum * inv - unpack8(rpu)); }
        { const f32x8 pb = unpack8(rpb);
          const f32x8 uc = unpack8(rpc) * unpack8(rpx);
          const f32x8 um = unpack8(rpcm) * unpack8(rpxm) * fm, up = unpack8(rpcp) * unpack8(rpxp) * fp;
          f32x8 y;
#pragma unroll
          for (int e = 0; e < 8; ++e) y[e] = pb[e] * (um[e] * wcv[e] + uc[e] * wcv[512 + e] + up[e] * wcv[1024 + e]);
          *(u32x4*)(Y + (size_t)row * 2048 + 1536 + 8 * lane) = pack8(y); }
    }
}
__device__ __forceinline__ void prep2_phase(KP p, int l, int wv) {
    unsigned char* ws = p->ws;
    const int tid_ = otid(); const int lane = tid_ & 63, wid = tid_ >> 6;
    const int gw = blockIdx.x * 8 + wid, NGW = gridDim.x * 8;
    const bf16_t* __restrict__ QBR = (const bf16_t*)(ws + WS_QBR); const bf16_t* __restrict__ KVR = (const bf16_t*)(ws + WS_KVR); const bf16_t* __restrict__ KR = (const bf16_t*)(ws + WS_KR);
    bf16_t* __restrict__ QB = (bf16_t*)(ws + WS_QB); bf16_t* __restrict__ KB = (bf16_t*)(ws + WS_KB); bf16_t* __restrict__ VB = (bf16_t*)(ws + WS_VB);
    const int h = lane >> 3, sub = lane & 7;
    f32x8 gqn, gkn; f32x4 gqr, invB;
#pragma unroll
    for (int e = 0; e < 8; ++e) { gqn[e] = p->gq_b[l * 96 + sub * 8 + e]; gkn[e] = p->gk_b[l * 96 + sub * 8 + e]; }
#pragma unroll
    for (int e = 0; e < 4; ++e) { gqr[e] = p->gq_b[l * 96 + 64 + sub * 4 + e]; invB[e] = (sub & 1) ? INVB_REV[4 + e] : INVB_REV[e]; }
    for (int row0 = gw; row0 < MT; row0 += 3 * NGW) {
        u32x4 rqn[3], rkn[3], rvv[3]; u32x2 rqr[3], rkr[3];
#pragma unroll
        for (int q = 0; q < 3; ++q) { const int row = (row0 + q * NGW < MT) ? row0 + q * NGW : row0;
            const bf16_t* qr = QBR + (size_t)row * 768 + h * 96; const bf16_t* kr = KVR + (size_t)row * 1024 + h * 128;
            rqn[q] = ld16(qr + sub * 8); rqr[q] = *(const u32x2*)(qr + 64 + sub * 4); rkn[q] = ld16(kr + sub * 8); rvv[q] = ld16(kr + 64 + sub * 8); rkr[q] = *(const u32x2*)(KR + (size_t)row * 32 + sub * 4); }
        asm volatile("" ::: "memory");
#pragma unroll
        for (int q = 0; q < 3; ++q) { const int row = row0 + q * NGW;
            if (row < MT) {
                const bool isx = row < MX;
                const int b = isx ? (row >> 11) : ((row - MX) >> 8);
                const int t = isx ? (row & 2047) : ((row - MX) & 255);
                const int arow = isx ? CTX + t : t;
                const size_t ar = (size_t)(b * 8 + h) * TK + arow;
                f32x8 vn = unpack8(rqn[q]);
                f32x4 vr = unpack4(rqr[q]);
                float sn_ = sum8(vn); sn_ += shx<1>(sn_); sn_ += shx<2>(sn_); sn_ += shx<4>(sn_);
                float sr_ = (vr[0] * vr[0] + vr[1] * vr[1]) + (vr[2] * vr[2] + vr[3] * vr[3]); sr_ += shx<1>(sr_); sr_ += shx<2>(sr_); sr_ += shx<4>(sr_);
                const float rn = rsq(sn_ * (1.f / 64.f) + EPS), rr = rsq(sr_ * (1.f / 32.f) + EPS);
#pragma unroll
                for (int e = 0; e < 8; ++e) vn[e] = vn[e] * rn * gqn[e];
#pragma unroll
                for (int e = 0; e < 4; ++e) vr[e] = vr[e] * rr * gqr[e];
                if (isx) { const float pos = (float)((sub & 2) ? (t & 63) : (t >> 6));
#pragma unroll
                    for (int e = 0; e < 4; ++e) { const float a = pos * invB[e]; const float cs = __builtin_amdgcn_cosf(a), sn = __builtin_amdgcn_sinf(a); const float o = shx<4>(vr[e]);
                        vr[e] = (sub & 4) ? (o * sn + vr[e] * cs) : (vr[e] * cs - o * sn); } }
                *(u32x4*)(QB + ar * 96 + sub * 8) = pack8(vn);
                *(u32x2*)(QB + ar * 96 + 64 + sub * 4) = pack4(vr);
                f32x8 kn = unpack8(rkn[q]);
                float sk = sum8(kn); sk += shx<1>(sk); sk += shx<2>(sk); sk += shx<4>(sk);
                const float rk = rsq(sk * (1.f / 64.f) + EPS);
#pragma unroll
                for (int e = 0; e < 8; ++e) kn[e] = kn[e] * rk * gkn[e];
                *(u32x4*)(KB + ar * 96 + sub * 8) = pack8(kn);
                *(u32x2*)(KB + ar * 96 + 64 + sub * 4) = rkr[q];
                *(u32x4*)(VB + ar * 64 + sub * 8) = rvv[q];
            } }
    }
}

__device__ __forceinline__ void presum_phase(KP p, int nrows, int wv) {
    const bf16_t* __restrict__ Gm = (const bf16_t*)(p->ws + WS_R1);
    bf16_t* __restrict__ Sm = (bf16_t*)(p->ws + WS_MIX);
    const int gt = blockIdx.x * 512 + otid(), NT = gridDim.x * 512;
    const int total = nrows * 128;
    for (int i = gt; i < total; i += 4 * NT) {
        u32x4 a[4], b[4], c[4], d[4]; int idx[4];
#pragma unroll
        for (int q = 0; q < 4; ++q) { idx[q] = (i + q * NT < total) ? i + q * NT : i; const bf16_t* g = Gm + (size_t)(idx[q] >> 7) * 4096 + (idx[q] & 127) * 8;
            a[q] = ld16(g); b[q] = ld16(g + 1024); c[q] = ld16(g + 2048); d[q] = ld16(g + 3072); }
        asm volatile("" ::: "memory");
#pragma unroll
        for (int q = 0; q < 4; ++q) *(u32x4*)(Sm + (size_t)(idx[q] >> 7) * DM + (idx[q] & 127) * 8) = pack8((unpack8(a[q]) + unpack8(b[q])) + (unpack8(c[q]) + unpack8(d[q])));
    }
}

#define XB_TMO      128
#define XB_XCNT(j)  (256  + 64 * (j))
#define XB_XSUB(j)  (1280 + 64 * (j))
#define XB_XGEN(j)  (2304 + 64 * (j))
#define XB_TOP      3328
#define XB_TOPGEN   3392
#define XCD_BAR_WORDS 3456
#define XB_SPIN_CAP (1u << 22)
__device__ __forceinline__ unsigned xb_ld(unsigned* p)              { return __hip_atomic_load(p, __ATOMIC_RELAXED, __HIP_MEMORY_SCOPE_AGENT); }
__device__ __forceinline__ unsigned xb_add(unsigned* p, unsigned v) { return __hip_atomic_fetch_add(p, v, __ATOMIC_RELAXED, __HIP_MEMORY_SCOPE_AGENT); }
__device__ __forceinline__ unsigned xb_xcc_id() { return (unsigned)__builtin_amdgcn_s_getreg((3 << 11) | 20) & 0xFu; }
#define XB_SPIN(cond, bar) do { unsigned _sp = 0; while (cond) { __builtin_amdgcn_s_sleep(1); \
    if ((++_sp & 255u) == 0u) { if (xb_ld(&(bar)[XB_TMO])) break; if (_sp > XB_SPIN_CAP) { atomicAdd(&(bar)[XB_TMO], 1u); break; } } } } while (0)
struct XcdBarrier { unsigned* bar; unsigned x; volatile LAS unsigned* st; };
__device__ __forceinline__ XcdBarrier xcd_barrier_post(unsigned* bar, volatile LAS unsigned* st) {
    XcdBarrier b; b.bar = bar; b.x = xb_xcc_id(); b.st = st;
    if (threadIdx.x == 0) (void)xb_add(&bar[XB_XCNT(b.x)], 1u);
    return b;
}
__device__ __forceinline__ void xcd_barrier_complete(unsigned* bar, unsigned x, unsigned& nloc, unsigned& nx) {
    const unsigned G = gridDim.x * gridDim.y * gridDim.z;
    unsigned sum, cnt, mine, sp = 0u;
    for (;;) {
        sum = 0u; cnt = 0u; mine = 0u;
#pragma unroll
        for (unsigned j = 0; j < 16; ++j) { const unsigned c = xb_ld(&bar[XB_XCNT(j)]); sum += c; cnt += (c > 0u) ? 1u : 0u; mine = (j == x) ? c : mine; }
        if (sum == G) break;
        __builtin_amdgcn_s_sleep(1);
        if ((++sp & 255u) == 0u) { if (xb_ld(&bar[XB_TMO])) break; if (sp > XB_SPIN_CAP) { atomicAdd(&bar[XB_TMO], 1u); break; } }
    }
    nloc = mine > 0u ? mine : 1u; nx = cnt > 0u ? cnt : 1u;
}
__device__ __forceinline__ void xcd_barrier(const XcdBarrier& b, int wv) {
    asm volatile("s_waitcnt vmcnt(0)" ::: "memory");
    __syncthreads();
    if (otid() == 0) {
        unsigned* bar = b.bar; unsigned bx = b.x;
        asm volatile("" : "+s"(bar), "+s"(bx));
        __builtin_amdgcn_s_waitcnt(0);
        unsigned nloc = b.st[0], nx = b.st[1];
        if (nloc == 0u) { xcd_barrier_complete(bar, bx, nloc, nx); b.st[0] = nloc; b.st[1] = nx; }
        const unsigned old = xb_add(&bar[XB_XSUB(bx)], 1u);
        const unsigned gen = old / nloc;
        if (old + 1u == (gen + 1u) * nloc) {
            __builtin_amdgcn_fence(__ATOMIC_RELEASE, "agent");
            asm volatile("s_waitcnt vmcnt(0)" ::: "memory");
            const unsigned og = xb_add(&bar[XB_TOP], 1u);
            const unsigned tg = og / nx;
            if (og + 1u == (tg + 1u) * nx) xb_add(&bar[XB_TOPGEN], 1u);
            else XB_SPIN(xb_ld(&bar[XB_TOPGEN]) == tg, bar);
            __builtin_amdgcn_fence(__ATOMIC_ACQUIRE, "agent");
            xb_add(&bar[XB_XGEN(bx)], 1u);
            asm volatile("s_waitcnt vmcnt(0)" ::: "memory");
        } else {
            XB_SPIN(xb_ld(&bar[XB_XGEN(bx)]) == gen, bar);
            __builtin_amdgcn_fence(__ATOMIC_ACQUIRE, "agent");
            asm volatile("s_waitcnt vmcnt(0)" ::: "memory");
        }
    }
    __syncthreads();
}

constexpr int N_PHASES = 1 + DEPTH * 10;
constexpr int ATT_PROBE = -1;
constexpr int REP0 = 1, REP1 = 1, REP2 = 1, REP3 = 1, REP4 = 1, REP5 = 1, REP6 = 1, REP7 = 1, REP8 = 1, REP9 = 1;

#define PHASE_BEGIN KP p = (KP)__builtin_amdgcn_kernarg_segment_ptr(); asm volatile("" : "+s"(p)); unsigned char* ws = p->ws; const int G = gridDim.x, c = obid(); (void)G; (void)c; (void)ws;
__global__ void __launch_bounds__(512) mega(Params p_unused, int ph_lo, int ph_hi) {
    extern __shared__ __attribute__((aligned(16))) unsigned char lds_raw[];
    LAS unsigned char* lds = (LAS unsigned char*)lds_raw;
    cg::grid_group grid = cg::this_grid();
    const int wv = __builtin_amdgcn_readfirstlane((int)(threadIdx.x >> 6));
    { volatile LAS unsigned* st0 = (volatile LAS unsigned*)(lds + 131072); if (threadIdx.x == 0) { st0[0] = 0u; st0[1] = 0u; } __syncthreads(); }
    const XcdBarrier xbar = xcd_barrier_post((unsigned*)(((KP)__builtin_amdgcn_kernarg_segment_ptr())->ws + WS_BAR), (volatile LAS unsigned*)(lds + 131072));
    {   PHASE_BEGIN
        mod_phase(lds, p, wv);
        const int tid0 = otid();
        if (c == 0 && tid0 < 64) { const int lane = tid0;
            for (int l = 0; l < DEPTH; ++l) { const float* la = p->lam_a + l * 256; const float s1 = wave_sum(la[lane] * la[64 + lane]), s2 = wave_sum(la[128 + lane] * la[192 + lane]);
                const float li = l == 0 ? LAM_INIT[0] : (l == 1 ? LAM_INIT[1] : (l == 2 ? LAM_INIT[2] : LAM_INIT[3]));
                if (lane == 0) { ((float*)(ws + WS_LAM))[l] = __expf(s1) - __expf(s2) + li; ((float*)(ws + WS_LAM))[8 + l] = li; } } }
    }
    if (ph_hi == 0x7fffffff) grid.sync();
    xcd_barrier(xbar, wv);
    for (int l = 0; l < DEPTH; ++l) {
        const bool last = (l == DEPTH - 1);
        const int Mact = last ? MX : MT;
        for (int rep = 0; rep < REP0; ++rep) { PHASE_BEGIN
            if (rep) __syncthreads();
            convert_weights(lds, p, l, wv); bias_gemv(lds, p, l, wv); if (l == 0) init_h(p, wv); }
        xcd_barrier(xbar, wv);
        for (int rep = 0; rep < REP1; ++rep) { PHASE_BEGIN
            pg8::Gemm g{(const bf16_t*)(ws + WS_H), (const bf16_t*)(ws + WS_WIN), DM, DM, DM, 0, 0};
            pg8::Epi<1> E{(bf16_t*)(ws + WS_R1), NPM, NPM / 256, (bf16_t*)(ws + WS_R2), NPG, nullptr, nullptr, nullptr, nullptr, nullptr, nullptr, nullptr, (bf16_t*)(ws + WS_VA), nullptr, (const float*)(ws + WS_PART), (const float*)(ws + WS_BIAS1), NIN};
            pg8::StaticOrder S; S.init(MT, NIN, G, c);
            pg8::gemm_phase(lds, g, S, E, wv); }
        xcd_barrier(xbar, wv);
        for (int rep = 0; rep < REP2; ++rep) { PHASE_BEGIN prep1_phase(p, l, wv); }
        xcd_barrier(xbar, wv);
        for (int rep = 0; rep < REP3; ++rep) { PHASE_BEGIN
            { int k1 = 384; asm volatile("" : "+s"(k1));
              pg8::Gemm g{(const bf16_t*)(ws + WS_CQ), (const bf16_t*)(ws + WS_WUQ), k1, k1, k1, 0, 0};
              pg8::Epi<6> E{(bf16_t*)(ws + WS_QB), l, 0, nullptr, 0, nullptr, nullptr, nullptr, p->gq_b + l * 96, nullptr, nullptr, nullptr, nullptr, nullptr, nullptr, nullptr, 0};
              pg8::StaticOrder S; S.init(MT, 768, G, c);
              pg8::gemm_phase(lds, g, S, E, wv); }
            { int k2 = 256; asm volatile("" : "+s"(k2));
              pg8::Gemm g{(const bf16_t*)(ws + WS_CKV), (const bf16_t*)(ws + WS_WUKV), k2, k2, k2, 0, 0};
              pg8::Epi<7> E{(bf16_t*)(ws + WS_KB), l, 0, (bf16_t*)(ws + WS_VB), 0, (const bf16_t*)(ws + WS_KR), nullptr, nullptr, p->gk_b + l * 96, nullptr, nullptr, nullptr, nullptr, nullptr, nullptr, nullptr, 0};
              pg8::StaticOrder S; S.init(MT, 1024, G, (c + 40) % G);
              pg8::gemm_phase(lds, g, S, E, wv); } }
        xcd_barrier(xbar, wv);
        { PHASE_BEGIN attn_phase<0>(lds, p, l, wv); }
        if (ATT_PROBE >= 0) { PHASE_BEGIN __syncthreads(); attn_phase<(ATT_PROBE < 0 ? 0 : ATT_PROBE)>(lds, p, l, wv); }
        xcd_barrier(xbar, wv);
        for (int rep = 0; rep < REP6; ++rep) { PHASE_BEGIN
            pg8::Gemm g{(const bf16_t*)(ws + WS_Y), (const bf16_t*)(ws + WS_WBR), 512, 2048, 512, 2, 1024};
            pg8::Epi<2> E{(bf16_t*)(ws + WS_R1), 4096, 0, nullptr, 0, (const bf16_t*)(ws + WS_R2), nullptr, nullptr, nullptr, nullptr, nullptr, nullptr, nullptr, nullptr, nullptr, nullptr, 0};
            pg8::StaticOrder S; S.init(Mact, 4096, G, c);
            pg8::gemm_phase(lds, g, S, E, wv); }
        xcd_barrier(xbar, wv);
        { PHASE_BEGIN presum_phase(p, Mact, wv); }
        xcd_barrier(xbar, wv);
        for (int rep = 0; rep < REP7; ++rep) { PHASE_BEGIN
            pg8::Gemm g{(const bf16_t*)(ws + WS_MIX), (const bf16_t*)(ws + WS_WO4), DM, DM, 4096, 0, 0};
            pg8::Epi<3> E{nullptr, rep ? 12345 : 0, 0, nullptr, 0, nullptr, p->out, (float*)(ws + WS_XC), (const float*)(ws + WS_MOD) + (size_t)l * 9 * 6144 + 2 * 1024, l == 0 ? p->x : (const float*)p->out, l == 0 ? p->ctx : (const float*)(ws + WS_XC),
                          (const float*)(ws + WS_VM) + ((size_t)l * 2 + 1) * 9 * DM, (bf16_t*)(ws + WS_H), (float*)(ws + WS_PART), nullptr, nullptr, 0};
            pg8::StaticOrder S; S.init(Mact, DM, G, c);
            pg8::gemm_phase(lds, g, S, E, wv); }
        xcd_barrier(xbar, wv);
        for (int rep = 0; rep < REP8; ++rep) { PHASE_BEGIN
            pg8::Gemm g{(const bf16_t*)(ws + WS_H), (const bf16_t*)(ws + WS_WF1), DM, DM, DM, 0, 0};
            pg8::Epi<4> E{(bf16_t*)(ws + WS_R2), DFF, 0, nullptr, 0, nullptr, nullptr, nullptr, nullptr, nullptr, nullptr, nullptr, nullptr, nullptr, (const float*)(ws + WS_PART), (const float*)(ws + WS_BIAS2), DFF};
            pg8::StaticOrder S; S.init(Mact, DFF, G, c);
            pg8::gemm_phase(lds, g, S, E, wv); }
        xcd_barrier(xbar, wv);
        for (int rep = 0; rep < REP9; ++rep) { PHASE_BEGIN
            pg8::Gemm g{(const bf16_t*)(ws + WS_R2), (const bf16_t*)(ws + WS_WF2), DFF, DFF, DFF, 0, 0};
            pg8::Epi<3> E{nullptr, rep ? 12345 : 0, 0, nullptr, 0, nullptr, p->out, (float*)(ws + WS_XC), (const float*)(ws + WS_MOD) + (size_t)l * 9 * 6144 + 5 * 1024, (const float*)p->out, (const float*)(ws + WS_XC),
                          last ? nullptr : (const float*)(ws + WS_VM) + ((size_t)(l + 1) * 2 + 0) * 9 * DM, (bf16_t*)(ws + WS_H), (float*)(ws + WS_PART), nullptr, nullptr, 0};
            pg8::StaticOrder S; S.init(Mact, DM, G, c);
            pg8::gemm_phase(lds, g, S, E, wv); }
        if (!last) xcd_barrier(xbar, wv);
    }
}

extern "C" void kernel_launch(void* const* d_in, const int* in_sizes, int n_in, void* d_out, int out_size, void* d_ws, size_t ws_size, hipStream_t stream) {
    static int grid = 0;
    if (grid == 0) {
        if (n_in != 26 || out_size != MX * DM || ws_size < WS_END) { fprintf(stderr, "kernel_launch: unexpected problem (n_in %d out %d ws %zu)\n", n_in, out_size, ws_size); grid = -1; return; }
        int dev = 0, cus = 0, per_cu = 0;
        hipGetDevice(&dev); hipDeviceGetAttribute(&cus, hipDeviceAttributeMultiprocessorCount, dev);
        hipFuncSetAttribute((const void*)mega, hipFuncAttributeMaxDynamicSharedMemorySize, LDS_BYTES);
        hipOccupancyMaxActiveBlocksPerMultiprocessor(&per_cu, (const void*)mega, 512, LDS_BYTES);
        (void)hipGetLastError();
        grid = cus > 0 ? cus : 256;
        if (per_cu < 1) fprintf(stderr, "kernel_launch: occupancy query says %d blocks/CU\n", per_cu);
    }
    if (grid < 0) return;
    Params p{};
    const float** pp = (const float**)&p;
    for (int i = 0; i < 26; ++i) pp[i] = (const float*)d_in[i];
    p.out = (float*)d_out; p.ws = (unsigned char*)d_ws;
    if (hipMemsetAsync((char*)d_ws + WS_BAR, 0, XCD_BAR_WORDS * 4, stream) != hipSuccess) { fprintf(stderr, "memset failed\n"); return; }
#if MK_COOP
    int lo = 0, hi = N_PHASES;
    void* args[] = {&p, &lo, &hi};
    hipError_t e = hipLaunchCooperativeKernel((const void*)mega, dim3(grid), dim3(512), args, LDS_BYTES, stream);
    if (e != hipSuccess) fprintf(stderr, "cooperative launch failed: %s\n", hipGetErrorString(e));
#else
    for (int ph = 0; ph < N_PHASES; ++ph) hipLaunchKernelGGL(mega, dim3(grid), dim3(512), LDS_BYTES, stream, p, ph, ph + 1);
#endif
}
```

```cpp
#include <hip/hip_runtime.h>
#include <hip/hip_cooperative_groups.h>
#include <cstdio>
#include <cstdint>
namespace cg = cooperative_groups;

#ifndef PHM
#define PHM 0xffff
#endif
#ifndef MK_COOP
#define MK_COOP 1
#endif

#define LAS __attribute__((address_space(3)))
typedef unsigned short bf16_t;
typedef short bf16x8 __attribute__((ext_vector_type(8)));
typedef float f32x2 __attribute__((ext_vector_type(2)));
typedef float f32x4 __attribute__((ext_vector_type(4)));
typedef float f32x8 __attribute__((ext_vector_type(8)));
typedef float f32x16 __attribute__((ext_vector_type(16)));
typedef unsigned u32x2 __attribute__((ext_vector_type(2)));
typedef unsigned u32x4 __attribute__((ext_vector_type(4)));
typedef __bf16 bf16x2_t __attribute__((ext_vector_type(2)));

constexpr int DM = 1024, NB = 8, SEQ = 2048, DEPTH = 4, CTX = 256, TK = CTX + SEQ;
constexpr int MX = NB * SEQ, MC = NB * CTX, MT = MX + MC;
constexpr int DIN = 8352, NPM = 4352, NPG = 4096, NIN = NPM + NPG, DFF = 4096;
constexpr int NGATE0 = 4256;
constexpr float EPS = 1e-6f;
constexpr int C_Q = 0, C_K = 512, C_V = 1024, C_CQ = 1536, C_CKV = 1920, C_KR = 2176, C_POOL = 2208, C_PB = 2720, C_PC = 3232, C_PX = 3744;

constexpr size_t MiB = 1u << 20;
constexpr size_t WS_WIN = 0, WS_WUQ = 17 * MiB, WS_WUKV = 18 * MiB, WS_WBR = 19 * MiB, WS_WO4 = 23 * MiB, WS_WF1 = 31 * MiB, WS_WF2 = 39 * MiB;
constexpr size_t WS_MOD = 48 * MiB, WS_LAM = 49 * MiB, WS_KR = 50 * MiB;
constexpr size_t WS_BAR = 51 * MiB + 512 * 1024;
constexpr size_t WS_XC = 52 * MiB;
constexpr size_t WS_Y = 60 * MiB, WS_H = WS_Y;
constexpr size_t WS_MIX = WS_Y + 36 * MiB;
constexpr size_t WS_QA = 132 * MiB, WS_KA = 150 * MiB, WS_VA = 168 * MiB;
constexpr size_t WS_CQ = 186 * MiB, WS_CKV = 200 * MiB;
constexpr size_t WS_R1 = 209 * MiB;
constexpr size_t WS_QBR = WS_R1, WS_KVR = WS_R1 + 27 * MiB, WS_QB = WS_R1 + 63 * MiB, WS_KB = WS_R1 + 90 * MiB, WS_VB = WS_R1 + 117 * MiB;
constexpr size_t WS_R2 = 362 * MiB;
constexpr size_t WS_VM = 49 * MiB + 4096, WS_BIAS1 = 49 * MiB + 512 * 1024, WS_BIAS2 = 49 * MiB + 832 * 1024;
constexpr size_t WS_PART = 506 * MiB;
constexpr size_t WS_END = 508 * MiB;
constexpr int LDS_BYTES = 131072 + 1024 + 10 * 2048;

struct Params {
    const float *x, *c, *ctx, *c_ctx, *w_mod, *b_mod, *g1, *g2, *w_in, *gq_a, *gk_a, *lam_a, *g_sub, *g_cq, *w_uq, *g_ckv, *w_ukv, *gq_b, *gk_b,
        *w_pool, *s_pool, *w_conv, *w_branch, *w_o, *w_ff1, *w_ff2;
    float* out; unsigned char* ws;
};

typedef const __attribute__((address_space(4))) Params* KP;
__device__ __forceinline__ unsigned cvtpk(float lo, float hi) { f32x2 v = {lo, hi}; bf16x2_t b = __builtin_convertvector(v, bf16x2_t); return __builtin_bit_cast(unsigned, b); }
__device__ __forceinline__ f32x8 unpack8(u32x4 w) {
    f32x8 r;
    r[0] = __uint_as_float(w.x << 16); r[1] = __uint_as_float(w.x & 0xffff0000u); r[2] = __uint_as_float(w.y << 16); r[3] = __uint_as_float(w.y & 0xffff0000u);
    r[4] = __uint_as_float(w.z << 16); r[5] = __uint_as_float(w.z & 0xffff0000u); r[6] = __uint_as_float(w.w << 16); r[7] = __uint_as_float(w.w & 0xffff0000u);
    return r;
}
__device__ __forceinline__ f32x4 unpack4(u32x2 w) {
    f32x4 r; r[0] = __uint_as_float(w.x << 16); r[1] = __uint_as_float(w.x & 0xffff0000u); r[2] = __uint_as_float(w.y << 16); r[3] = __uint_as_float(w.y & 0xffff0000u); return r;
}
__device__ __forceinline__ u32x4 pack8(f32x8 v) { u32x4 w; w.x = cvtpk(v[0], v[1]); w.y = cvtpk(v[2], v[3]); w.z = cvtpk(v[4], v[5]); w.w = cvtpk(v[6], v[7]); return w; }
__device__ __forceinline__ u32x2 pack4(f32x4 v) { u32x2 w; w.x = cvtpk(v[0], v[1]); w.y = cvtpk(v[2], v[3]); return w; }
__device__ __forceinline__ u32x4 ld16(const bf16_t* p) { return *(const u32x4*)p; }
template <int O> __device__ __forceinline__ float shx(float v) {
    if constexpr (O < 32) return __builtin_bit_cast(float, __builtin_amdgcn_ds_swizzle(__builtin_bit_cast(int, v), (O << 10) | 0x1f));
    else { auto rr = __builtin_amdgcn_permlane32_swap(__builtin_bit_cast(unsigned, v), __builtin_bit_cast(unsigned, v), false, false);
           const float a = __builtin_bit_cast(float, (unsigned)rr[0]), b = __builtin_bit_cast(float, (unsigned)rr[1]); return a == v ? b : a; }
}
__device__ __forceinline__ float xsum32(float v) { auto rr = __builtin_amdgcn_permlane32_swap(__builtin_bit_cast(unsigned, v), __builtin_bit_cast(unsigned, v), false, false);
    return __builtin_bit_cast(float, (unsigned)rr[0]) + __builtin_bit_cast(float, (unsigned)rr[1]); }
__device__ __forceinline__ float xmax32(float v) { auto rr = __builtin_amdgcn_permlane32_swap(__builtin_bit_cast(unsigned, v), __builtin_bit_cast(unsigned, v), false, false);
    return fmaxf(__builtin_bit_cast(float, (unsigned)rr[0]), __builtin_bit_cast(float, (unsigned)rr[1])); }
__device__ __forceinline__ float wave_sum(float v) {
    v += shx<1>(v); v += shx<2>(v); v += shx<4>(v); v += shx<8>(v); v += shx<16>(v); return xsum32(v);
}
__device__ __forceinline__ float sum8(f32x8 v) { return ((v[0] * v[0] + v[1] * v[1]) + (v[2] * v[2] + v[3] * v[3])) + ((v[4] * v[4] + v[5] * v[5]) + (v[6] * v[6] + v[7] * v[7])); }
__device__ __forceinline__ int olane() { int l; asm volatile("v_mbcnt_lo_u32_b32 %0, -1, 0\n\tv_mbcnt_hi_u32_b32 %0, -1, %0" : "=v"(l)); return l; }
#define otid() ((wv << 6) | olane())
__device__ __forceinline__ int obid() { int t = blockIdx.x; asm volatile("" : "+s"(t)); return t; }
__device__ __forceinline__ float rsq(float x) { return __builtin_amdgcn_rsqf(x); }

__device__ constexpr float INVA_REV[16] = {1.591549431e-01f, 8.949940161e-02f, 5.032921210e-02f, 2.830219583e-02f, 1.591549431e-02f, 8.949940161e-03f, 5.032921210e-03f, 2.830219583e-03f, 1.591549431e-03f, 8.949940161e-04f, 5.032921210e-04f, 2.830219583e-04f, 1.591549431e-04f, 8.949940161e-05f, 5.032921210e-05f, 2.830219583e-05f};
__device__ constexpr float INVB_REV[8] = {1.591549431e-01f, 5.032921210e-02f, 1.591549431e-02f, 5.032921210e-03f, 1.591549431e-03f, 5.032921210e-04f, 1.591549431e-04f, 5.032921210e-05f};
__device__ constexpr float LAM_INIT[4] = {2.000000000e-01f, 3.555090676e-01f, 4.707130183e-01f, 5.560582042e-01f};

namespace pg8 {
constexpr int BM = 256, BK = 64, HALF = 128, HTB = HALF * BK * 2, STAGE_BYTES = 8 * HTB, NXCD = 8, WGM = 8;
__host__ __device__ __forceinline__ int lds_byte(int r, int c) { const int st = (r >> 4) * 2 + (c >> 5), rr = r & 15, cc = c & 31, ob = rr * 64 + cc * 2; return st * 1024 + (ob ^ (((ob >> 9) & 1) << 5)); }
__host__ __device__ __forceinline__ void stage_rc(int b, int& R, int& C) { const int st = b / 1024, sb = b % 1024, swz = sb ^ (((sb >> 9) & 1) << 5); R = (st >> 1) * 16 + swz / 64; C = (st & 1) * 32 + (swz % 64) / 2; }
__host__ __device__ __forceinline__ int perm32(int rho) { const int n = rho >> 4, i = rho & 15; return 8 * (i >> 2) + 4 * n + (i & 3); }

struct Unit { int pm, pn; };
struct Gemm { const bf16_t* A; const bf16_t* Bt; int K, lda, ldb, zshift; size_t zA; };

struct StaticOrder {
    int nM, nN, nwg, G, c;
    __device__ void init(int M, int N, int G_, int c_) { nM = M / BM; nN = N / BM; nwg = nM * nN; G = G_; c = c_; }
    __device__ bool next(int i, Unit& u) const {
        const long L = (long)i * G + c; if (L >= nwg) return false;
        int wgid = (int)L; { const int q = nwg / NXCD, r = nwg % NXCD, xcd = wgid % NXCD, off = wgid / NXCD; wgid = (xcd < r ? xcd * (q + 1) : r * (q + 1) + (xcd - r) * q) + off; }
        const int nig = WGM * nN, gid = wgid / nig, fm = gid * WGM, gsz = (nM - fm) < WGM ? (nM - fm) : WGM;
        u.pm = fm + ((wgid % nig) % gsz); u.pn = (wgid % nig) / gsz; return true;
    }
};

template <int MODE> struct Epi {
    static constexpr bool PERM = true, TAB = (MODE == 1 || MODE == 4);
    bf16_t* O; int ldc; int split_tile; bf16_t* O2; int ldc2;
    const bf16_t* gate;
    float* xo; float* xc; const float* mod; const float* xi; const float* xci;
    const float* vm; bf16_t* Hout; float* part;
    const float* partr; const float* bias; int bias_ld;
    __device__ __forceinline__ void operator()(const f32x4 (&acc)[2][2][4][2], const Unit& u, int wr, int wc, int fr, int fq, const LAS float* tab) const {
        const int ln_ = olane(); const int fr_ = ln_ & 15, fq_ = ln_ >> 4; (void)fr; (void)fq;
        const int row0 = u.pm * BM + wr * 64 + fr_;
        const int ct = u.pn * BM + wc * 32 + 8 * fq_;
        if constexpr (MODE == 0 || MODE == 1 || MODE == 4) {
            bf16_t* base = O; int ld = ldc; int c0 = ct;
            if (MODE == 1 && u.pn >= split_tile) { base = O2; ld = ldc2; c0 = ct - split_tile * BM; }
            float rs[8];
#pragma unroll
            for (int i = 0; i < 8; ++i) rs[i] = 1.f;
            if (MODE != 0) {
#pragma unroll
                for (int i = 0; i < 8; ++i) rs[i] = tab[wr * 64 + fr_ + (i >> 2) * HALF + (i & 3) * 16]; }
#pragma unroll
            for (int bj = 0; bj < 2; ++bj) {
                f32x4 b0 = {0.f, 0.f, 0.f, 0.f}, b1 = b0;
                if (MODE != 0) { const LAS float* bp = tab + 256 + wc * 32 + 8 * fq_ + bj * HALF; b0 = *(const LAS f32x4*)bp; b1 = *(const LAS f32x4*)(bp + 4); }
#pragma unroll
                for (int i = 0; i < 8; ++i) { const int ai = i >> 2, m = i & 3; bf16_t* rowp = base + (size_t)(row0 + ai * HALF + m * 16) * ld + c0;
                    if (MODE == 1 && (u.pn == 4 || u.pn == 5)) {
                        const bool isx = u.pm < MX / BM; const int bb = isx ? (u.pm >> 3) : (u.pm - MX / BM), ar0 = isx ? CTX + (u.pm & 7) * BM : 0;
                        rowp = Hout + ((size_t)(bb * 4 + 2 * (u.pn - 4) + bj) * TK + ar0 + wr * 64 + fr_ + ai * HALF + m * 16) * 128 + wc * 32 + 8 * fq_ - bj * HALF; }
                    f32x4 v0 = acc[ai][bj][m][0], v1 = acc[ai][bj][m][1];
                    if (MODE != 0) { v0 = v0 * rs[i] + b0; v1 = v1 * rs[i] + b1; }
                    if (MODE == 4) {
#pragma unroll
                        for (int e = 0; e < 4; ++e) { float a = fmaxf(v0[e], 0.f), b = fmaxf(v1[e], 0.f); v0[e] = a * a; v1[e] = b * b; } }
                    u32x4 w; w.x = cvtpk(v0[0], v0[1]); w.y = cvtpk(v0[2], v0[3]); w.z = cvtpk(v1[0], v1[1]); w.w = cvtpk(v1[2], v1[3]);
                    *(u32x4*)(rowp + bj * HALF) = w; } }
        } else if constexpr (MODE == 6 || MODE == 7) {
            LAS float* xb = (LAS float*)tab;
            const bool isx = u.pm < MX / BM;
            const int b = isx ? (u.pm >> 3) : (u.pm - MX / BM);
            const int arow0 = isx ? CTX + (u.pm & 7) * BM : 0, t0 = (u.pm & 7) * BM;
            const int lr0 = wr * 64 + fr_;
#pragma unroll
            for (int bj = 0; bj < 2; ++bj)
#pragma unroll
                for (int i = 0; i < 8; ++i) { const f32x4 v0 = acc[i >> 2][bj][i & 3][0], v1 = acc[i >> 2][bj][i & 3][1];
                    float s = ((v0[0] * v0[0] + v0[1] * v0[1]) + (v0[2] * v0[2] + v0[3] * v0[3])) + ((v1[0] * v1[0] + v1[1] * v1[1]) + (v1[2] * v1[2] + v1[3] * v1[3]));
                    s += shx<16>(s); s = xsum32(s);
                    if (fq_ == 0) xb[((lr0 + (i >> 2) * HALF + (i & 3) * 16) * 2 + bj) * 4 + wc] = s; }
            asm volatile("s_waitcnt lgkmcnt(0)" ::: "memory"); __builtin_amdgcn_s_barrier(); asm volatile("" ::: "memory");
            const bool rope_tile = (MODE == 6) && (u.pn == 2);
            const bool vwave = (MODE == 7) && (wc >= 2);
#pragma unroll
            for (int bj = 0; bj < 2; ++bj) {
                const int h = (MODE == 7) ? (2 * u.pn + bj) : (rope_tile ? (4 * bj + wc) : (4 * u.pn + 2 * bj + (wc >> 1)));
                const size_t hb = (size_t)(b * 8 + h) * TK + arow0;
                f32x8 gn;
#pragma unroll
                for (int e = 0; e < 8; ++e) gn[e] = mod[(rope_tile ? 64 : (wc & 1) * 32) + 8 * fq_ + e];
#pragma unroll
                for (int i = 0; i < 8; ++i) { const int lr = lr0 + (i >> 2) * HALF + (i & 3) * 16; const f32x4 v0 = acc[i >> 2][bj][i & 3][0], v1 = acc[i >> 2][bj][i & 3][1];
                    f32x8 v; v[0] = v0[0]; v[1] = v0[1]; v[2] = v0[2]; v[3] = v0[3]; v[4] = v1[0]; v[5] = v1[1]; v[6] = v1[2]; v[7] = v1[3];
                    if (vwave) {
                        *(u32x4*)(O2 + (hb + lr) * 64 + (wc - 2) * 32 + 8 * fq_) = pack8(v);
                        if (wc == 2) *(u32x4*)(O + (hb + lr) * 96 + 64 + 8 * fq_) = ld16(gate + (size_t)(u.pm * BM + lr) * 32 + 8 * fq_);
                    } else if (rope_tile) {
                        const float rs = rsq(xb[((lr * 2 + bj) * 4 + wc)] * (1.f / 32.f) + EPS);
#pragma unroll
                        for (int e = 0; e < 8; ++e) v[e] = v[e] * rs * gn[e];
                        if (isx) { const int t = t0 + lr; const float pos = (float)((fq_ & 1) ? (t & 63) : (t >> 6));
#pragma unroll
                            for (int e = 0; e < 8; ++e) { const float a = pos * INVB_REV[e]; const float cs = __builtin_amdgcn_cosf(a), sn = __builtin_amdgcn_sinf(a); const float o = shx<32>(v[e]);
                                v[e] = (fq_ & 2) ? (o * sn + v[e] * cs) : (v[e] * cs - o * sn); } }
                        *(u32x4*)(O + (hb + lr) * 96 + 64 + 8 * fq_) = pack8(v);
                    } else {
                        const LAS float* xp = xb + ((lr * 2 + bj) * 4 + (wc & 2));
                        const float rs = rsq((xp[0] + xp[1]) * (1.f / 64.f) + EPS);
#pragma unroll
                        for (int e = 0; e < 8; ++e) v[e] = v[e] * rs * gn[e];
                        *(u32x4*)(O + (hb + lr) * 96 + (wc & 1) * 32 + 8 * fq_) = pack8(v);
                    } } }
            asm volatile("s_waitcnt lgkmcnt(0)" ::: "memory"); __builtin_amdgcn_s_barrier(); asm volatile("" ::: "memory");
        } else if constexpr (MODE == 2) {
#pragma unroll
            for (int bj = 0; bj < 2; ++bj) {
                u32x4 gw[8];
#pragma unroll
                for (int i = 0; i < 8; ++i) gw[i] = ld16(gate + (size_t)(row0 + (i >> 2) * HALF + (i & 3) * 16) * NPG + ct + bj * HALF);
#pragma unroll
                for (int i = 0; i < 8; ++i) { const int ai = i >> 2, m = i & 3; const size_t off = (size_t)(row0 + ai * HALF + m * 16) * NPG + ct + bj * HALF;
                    const f32x8 g = unpack8(gw[i]); const f32x4 v0 = acc[ai][bj][m][0], v1 = acc[ai][bj][m][1]; f32x8 o;
#pragma unroll
                    for (int e = 0; e < 8; ++e) { const float sg = __builtin_amdgcn_rcpf(1.f + __builtin_amdgcn_exp2f(-1.4426950408889634f * g[e])); o[e] = (e < 4 ? v0[e & 3] : v1[e & 3]) * sg; }
                    *(u32x4*)(O + off) = pack8(o); } }
        } else if (MODE == 3 && ldc != 12345) {
            const int R = u.pm * BM;
            float* xb = (R < MX) ? xo + (size_t)R * DM : xc + (size_t)(R - MX) * DM;
            const float* xr = (R < MX) ? xi + (size_t)R * DM : xci + (size_t)(R - MX) * DM;
            const int mr = (R < MX) ? (R >> 11) : 8;
            float ss[8];
#pragma unroll
            for (int i = 0; i < 8; ++i) ss[i] = 0.f;
#pragma unroll
            for (int bj = 0; bj < 2; ++bj) {
                const float* gp = mod + (size_t)mr * 6144 + ct + bj * HALF; const f32x4 g0 = *(const f32x4*)gp, g1 = *(const f32x4*)(gp + 4);
                f32x4 w0 = {0.f, 0.f, 0.f, 0.f}, w1 = w0;
                if (vm) { const float* vp = vm + (size_t)mr * DM + ct + bj * HALF; w0 = *(const f32x4*)vp; w1 = *(const f32x4*)(vp + 4); }
#pragma unroll
                for (int hb = 0; hb < 2; ++hb) {
                    f32x4 xa[4], xbv[4];
#pragma unroll
                    for (int q = 0; q < 4; ++q) { const int i = hb * 4 + q; const int lr = wr * 64 + fr_ + (i >> 2) * HALF + (i & 3) * 16; const float* xp = xr + (size_t)lr * DM + ct + bj * HALF; xa[q] = *(const f32x4*)xp; xbv[q] = *(const f32x4*)(xp + 4); }
#pragma unroll
                    for (int q = 0; q < 4; ++q) { const int i = hb * 4 + q; const int ai = i >> 2, m = i & 3; const int lr = wr * 64 + fr_ + ai * HALF + m * 16; float* xp = xb + (size_t)lr * DM + ct + bj * HALF;
                        f32x4 xv0 = xa[q] + g0 * acc[ai][bj][m][0], xv1 = xbv[q] + g1 * acc[ai][bj][m][1];
                        *(f32x4*)xp = xv0; *(f32x4*)(xp + 4) = xv1;
                        if (vm) { ss[i] += ((xv0[0] * xv0[0] + xv0[1] * xv0[1]) + (xv0[2] * xv0[2] + xv0[3] * xv0[3])) + ((xv1[0] * xv1[0] + xv1[1] * xv1[1]) + (xv1[2] * xv1[2] + xv1[3] * xv1[3]));
                            const f32x4 h0 = xv0 * w0, h1 = xv1 * w1; u32x4 w; w.x = cvtpk(h0[0], h0[1]); w.y = cvtpk(h0[2], h0[3]); w.z = cvtpk(h1[0], h1[1]); w.w = cvtpk(h1[2], h1[3]);
                            *(u32x4*)(Hout + (size_t)(R + lr) * DM + ct + bj * HALF) = w; } } } }
            if (vm) {
#pragma unroll
                for (int i = 0; i < 8; ++i) { float s = ss[i]; s += shx<16>(s); s = xsum32(s); const int lr = wr * 64 + fr_ + (i >> 2) * HALF + (i & 3) * 16;
                    if (fq_ == 0) part[(size_t)(R + lr) * 16 + u.pn * 4 + wc] = s; } }
        }
    }
};

template <class EpiT, class Sched>
__device__ __forceinline__ void gemm_phase(LAS unsigned char* lds, const Gemm g, const Sched& S, const EpiT& E, int wv) {
    LAS float* tab = (LAS float*)(lds + STAGE_BYTES + 1024);
    const int tid = otid(), wid = __builtin_amdgcn_readfirstlane(tid >> 6), lane = tid & 63, wr = wid >> 2, wc = wid & 3, fr = lane & 15, fq = lane >> 4;
    const int K = g.K, nt = K / BK;
    unsigned voffA[2], voffB[2];
#pragma unroll
    for (int i = 0; i < 2; ++i) { int R, C; stage_rc(tid * 16 + i * 8192, R, C); const int Rb = EpiT::PERM ? ((R & ~31) + perm32(R & 31)) : R;
        voffA[i] = (unsigned)(R * g.lda + C) * 2u; voffB[i] = (unsigned)(Rb * g.ldb + C) * 2u; }
    const size_t kstep = (size_t)(BK * 2);
    const size_t hstepA = (size_t)HALF * g.lda * 2, hstepB = (size_t)HALF * g.ldb * 2;
    const size_t tstepA = 2 * hstepA, tstepB = 2 * hstepB;
    const unsigned ldsw = (unsigned)wid * 1024u;
    const int foff = lds_byte(fr, fq * 8);
    const int aoff = wr * 8192 + foff, boff = wc * 4096 + foff;
#define PG8_SA(b, h) (((b) * 2 + (h)) * HTB)
#define PG8_SB(b, h) ((4 + (b) * 2 + (h)) * HTB)
#define PG8_STAGE(bufoff, gbase, voff) do { _Pragma("unroll") for (int _i = 0; _i < 2; ++_i) \
        __builtin_amdgcn_global_load_lds((const unsigned*)((const char*)(gbase) + (voff)[_i]), (LAS unsigned*)(lds + (bufoff) + ldsw + _i * 8192), 16, 0, 0); } while (0)
#define PG8_LDA(dst, b, h) do { _Pragma("unroll") for (int m = 0; m < 4; ++m) _Pragma("unroll") for (int k = 0; k < 2; ++k) dst[m][k] = *(const LAS bf16x8*)(lds + PG8_SA(b, h) + aoff + m * 2048 + k * 1024); } while (0)
#define PG8_LDB(dst, b, h) do { _Pragma("unroll") for (int n = 0; n < 2; ++n) _Pragma("unroll") for (int k = 0; k < 2; ++k) dst[n][k] = *(const LAS bf16x8*)(lds + PG8_SB(b, h) + boff + n * 2048 + k * 1024); } while (0)
#define PG8_MMA(ai, bj, At, Bt) do { __builtin_amdgcn_s_setprio(1); _Pragma("unroll") for (int m = 0; m < 4; ++m) _Pragma("unroll") for (int n = 0; n < 2; ++n) _Pragma("unroll") for (int k = 0; k < 2; ++k) \
        acc[ai][bj][m][n] = __builtin_amdgcn_mfma_f32_16x16x32_bf16(Bt[n][k], At[m][k], acc[ai][bj][m][n], 0, 0, 0); __builtin_amdgcn_s_setprio(0); } while (0)
#define PG8_WAIT_V(n) asm volatile("s_waitcnt vmcnt(" #n ")" ::: "memory")
#define PG8_WAIT_L(n) asm volatile("s_waitcnt lgkmcnt(" #n ")" ::: "memory")
#define PG8_BAR __builtin_amdgcn_s_barrier()
#define PG8_SCHED __builtin_amdgcn_sched_barrier(0)
    Unit cur, nxt; int ui = 0;
    if (!S.next(0, cur)) return;
    if constexpr (EpiT::TAB) {
        Unit tu;
        for (int i = 0; S.next(i, tu); ++i) {
            if (tid < 256) { const f32x4* pp = (const f32x4*)(E.partr + (size_t)(tu.pm * BM + tid) * 16); const f32x4 p0 = pp[0], p1 = pp[1], p2 = pp[2], p3 = pp[3];
                const f32x4 ps = (p0 + p1) + (p2 + p3); tab[i * 512 + tid] = rsq(((ps[0] + ps[1]) + (ps[2] + ps[3])) * (1.f / DM) + EPS); }
            else { const int mr = (tu.pm * BM < MX) ? ((tu.pm * BM) >> 11) : 8; tab[i * 512 + tid] = E.bias[(size_t)mr * E.bias_ld + tu.pn * BM + (tid - 256)]; }
        }
        __syncthreads();
    }
    f32x4 acc[2][2][4][2];
#pragma unroll
    for (int a = 0; a < 2; ++a)
#pragma unroll
        for (int b = 0; b < 2; ++b)
#pragma unroll
            for (int m = 0; m < 4; ++m)
#pragma unroll
                for (int n = 0; n < 2; ++n) acc[a][b][m][n] = (f32x4){0.f, 0.f, 0.f, 0.f};
    bf16x8 At[4][2], B0[2][2], B1[2][2];
    const char* cA = (const char*)g.A + (size_t)cur.pm * tstepA + (size_t)(cur.pn >> g.zshift) * g.zA; const char* cB = (const char*)g.Bt + (size_t)cur.pn * tstepB;
    PG8_STAGE(PG8_SB(0, 0), cB, voffB); PG8_STAGE(PG8_SB(0, 1), cB + hstepB, voffB); PG8_STAGE(PG8_SA(0, 0), cA, voffA); PG8_STAGE(PG8_SA(0, 1), cA + hstepA, voffA);
    if (wr == 1) PG8_BAR;
    PG8_WAIT_V(2); PG8_BAR;
    PG8_STAGE(PG8_SB(1, 0), cB + kstep, voffB); PG8_STAGE(PG8_SA(1, 0), cA + kstep, voffA); PG8_STAGE(PG8_SB(1, 1), cB + hstepB + kstep, voffB);
    PG8_WAIT_V(6); PG8_BAR;
    for (;;) {
        const bool has_next = S.next(ui + 1, nxt);
        const char* nA = has_next ? (const char*)g.A + (size_t)nxt.pm * tstepA + (size_t)(nxt.pn >> g.zshift) * g.zA : cA; const char* nB = has_next ? (const char*)g.Bt + (size_t)nxt.pn * tstepB : cB;
        for (int t = 0; t < nt; t += 2) {
            const bool last = (t == nt - 2);
            const char* a1 = cA + (size_t)(t + 1) * kstep;
            const char* a2 = last ? nA : cA + (size_t)(t + 2) * kstep; const char* b2 = last ? nB : cB + (size_t)(t + 2) * kstep;
            const char* a3 = a2 + kstep; const char* b3 = b2 + kstep;
            PG8_LDB(B0, 0, 0); PG8_LDB(B1, 0, 1); PG8_SCHED; PG8_LDA(At, 0, 0); PG8_STAGE(PG8_SA(1, 1), a1 + hstepA, voffA);
            PG8_WAIT_V(8); PG8_WAIT_L(0); PG8_BAR; PG8_MMA(0, 0, At, B0); PG8_MMA(0, 1, At, B1); PG8_BAR; PG8_SCHED;
            PG8_LDA(At, 0, 1); PG8_STAGE(PG8_SB(0, 0), b2, voffB); PG8_STAGE(PG8_SB(0, 1), b2 + hstepB, voffB); PG8_STAGE(PG8_SA(0, 0), a2, voffA);
            PG8_WAIT_V(8); PG8_WAIT_L(0); PG8_BAR; PG8_MMA(1, 0, At, B0); PG8_MMA(1, 1, At, B1); PG8_BAR; PG8_SCHED;
            PG8_LDB(B0, 1, 0); PG8_LDB(B1, 1, 1); PG8_SCHED; PG8_LDA(At, 1, 0); PG8_STAGE(PG8_SA(0, 1), a2 + hstepA, voffA);
            PG8_WAIT_V(8); PG8_WAIT_L(0); PG8_BAR; PG8_MMA(0, 0, At, B0); PG8_MMA(0, 1, At, B1); PG8_BAR; PG8_SCHED;
            PG8_LDA(At, 1, 1); PG8_STAGE(PG8_SB(1, 0), b3, voffB); PG8_STAGE(PG8_SB(1, 1), b3 + hstepB, voffB); PG8_STAGE(PG8_SA(1, 0), a3, voffA);
            PG8_WAIT_V(8); PG8_WAIT_L(0); PG8_BAR; PG8_MMA(1, 0, At, B0); PG8_MMA(1, 1, At, B1); PG8_BAR; PG8_SCHED;
        }
        if (wr == 0) PG8_BAR;
        E(acc, cur, wr, wc, fr, fq, EpiT::TAB ? tab + ui * 512 : tab);
        if (!has_next) break;
#pragma unroll
        for (int a = 0; a < 2; ++a)
#pragma unroll
            for (int b = 0; b < 2; ++b)
#pragma unroll
                for (int m = 0; m < 4; ++m)
#pragma unroll
                    for (int n = 0; n < 2; ++n) acc[a][b][m][n] = (f32x4){0.f, 0.f, 0.f, 0.f};
        cur = nxt; cA = nA; cB = nB; ++ui;
        if (wr == 1) PG8_BAR;
    }
    PG8_WAIT_V(0);
    PG8_BAR;
#undef PG8_SA
#undef PG8_SB
#undef PG8_STAGE
#undef PG8_LDA
#undef PG8_LDB
#undef PG8_MMA
#undef PG8_WAIT_V
#undef PG8_WAIT_L
#undef PG8_BAR
#undef PG8_SCHED
}
}

#define MFMA32(a, b, c) __builtin_amdgcn_mfma_f32_32x32x16_bf16((a), (b), (c), 0, 0, 0)
constexpr int ATT_BUF = 32768, ATT_VOFF = 13312, ATT_VP = 136;

template <int DK, int DV, int VAR>
__device__ __forceinline__ void attn_pass(LAS unsigned char* lds, const bf16_t* Qg, const bf16_t* Kg, const bf16_t* Vg, int ntiles, float cs, f32x16 (&O)[DV / 32], float& lsum, int wv) {
    constexpr int KP = DK * 2 + 16, KCH = DK / 8, NKC = 64 * KCH;
    const int tid = otid(), lane = tid & 63, wid = tid >> 6, l32 = lane & 31, hf = lane >> 5;
    bf16x8 qf[DK / 16];
    { const bf16_t* qrow = Qg + (size_t)(wid * 32 + l32) * DK + hf * 8;
#pragma unroll
      for (int kk = 0; kk < DK / 16; ++kk) qf[kk] = *(const bf16x8*)(qrow + kk * 16); }
    const int kc0 = tid, kc1 = tid + 512;
    const int kr0 = kc0 / KCH, kq0 = kc0 % KCH, kr1 = kc1 / KCH, kq1 = kc1 % KCH;
    const bool k1on = (kc1 < NKC);
    const int kp = (DV == 128 ? (wid >> 2) : ((wid >> 1) & 1)) * 16 + (lane & 15);
    const int vch = (DV == 128 ? (wid & 3) : (wid & 1)) * 4 + (lane >> 4);
    const bool von = (DV == 128) || (wid < 4);
    const bf16_t* kg0 = Kg + kr0 * DK + kq0 * 8; const bf16_t* kg1 = Kg + kr1 * DK + kq1 * 8;
    const bf16_t* vg0 = Vg + (size_t)(2 * kp) * DV + vch * 8;
    const unsigned kl0 = kr0 * KP + kq0 * 16, kl1 = kr1 * KP + kq1 * 16, vl0 = ATT_VOFF + (vch * 8) * ATT_VP + kp * 4;
    u32x4 ka0, ka1, va0, va1;
    { unsigned z0 = 0u; asm volatile("" : "+v"(z0)); ka1 = (u32x4){z0, z0, z0, z0}; } va0 = ka1; va1 = ka1; ka0 = ka1;
#define ATT_LOADK(t, r0, r1) do { r0 = *(const u32x4*)(kg0 + (size_t)(t) * 64 * DK); if (k1on) r1 = *(const u32x4*)(kg1 + (size_t)(t) * 64 * DK); } while (0)
#define ATT_LOADV(t, r0, r1) do { if (von) { r0 = *(const u32x4*)(vg0 + (size_t)(t) * 64 * DV); r1 = *(const u32x4*)(vg0 + (size_t)(t) * 64 * DV + DV); } } while (0)
#define ATT_STOREK(bi, r0, r1) do { LAS unsigned char* kb_ = lds + (bi) * ATT_BUF; *(LAS u32x4*)(kb_ + kl0) = r0; if (k1on) *(LAS u32x4*)(kb_ + kl1) = r1; } while (0)
#define ATT_STOREV(bi, r0, r1) do { if (von) { LAS unsigned char* vb_ = lds + (bi) * ATT_BUF + vl0; \
            *(LAS unsigned*)(vb_ + 0 * ATT_VP) = (r0.x & 0xffffu) | (r1.x << 16); *(LAS unsigned*)(vb_ + 1 * ATT_VP) = (r0.x >> 16) | (r1.x & 0xffff0000u); \
            *(LAS unsigned*)(vb_ + 2 * ATT_VP) = (r0.y & 0xffffu) | (r1.y << 16); *(LAS unsigned*)(vb_ + 3 * ATT_VP) = (r0.y >> 16) | (r1.y & 0xffff0000u); \
            *(LAS unsigned*)(vb_ + 4 * ATT_VP) = (r0.z & 0xffffu) | (r1.z << 16); *(LAS unsigned*)(vb_ + 5 * ATT_VP) = (r0.z >> 16) | (r1.z & 0xffff0000u); \
            *(LAS unsigned*)(vb_ + 6 * ATT_VP) = (r0.w & 0xffffu) | (r1.w << 16); *(LAS unsigned*)(vb_ + 7 * ATT_VP) = (r0.w >> 16) | (r1.w & 0xffff0000u); } } while (0)
#define ATT_QK(bi, S0, S1) do { const unsigned ka_ = (unsigned)(unsigned long long)(lds + (bi) * ATT_BUF + l32 * KP + hf * 16); \
        bf16x8 kfa[DK / 16], kfb[DK / 16]; \
          \
        if constexpr (DK == 64) { \
            asm volatile("ds_read_b128 %0, %8\n\tds_read_b128 %1, %8 offset:%9\n\tds_read_b128 %2, %8 offset:32\n\tds_read_b128 %3, %8 offset:%10\n\t" \
                         "ds_read_b128 %4, %8 offset:64\n\tds_read_b128 %5, %8 offset:%11\n\tds_read_b128 %6, %8 offset:96\n\tds_read_b128 %7, %8 offset:%12\n\ts_waitcnt lgkmcnt(0)" \
                         : "=&v"(kfa[0]), "=&v"(kfb[0]), "=&v"(kfa[1]), "=&v"(kfb[1]), "=&v"(kfa[2]), "=&v"(kfb[2]), "=&v"(kfa[3]), "=&v"(kfb[3]) \
                         : "v"(ka_), "n"(32 * KP), "n"(32 * KP + 32), "n"(32 * KP + 64), "n"(32 * KP + 96) : "memory"); \
        } else { \
            asm volatile("ds_read_b128 %0, %12\n\tds_read_b128 %1, %12 offset:%13\n\tds_read_b128 %2, %12 offset:32\n\tds_read_b128 %3, %12 offset:%14\n\t" \
                         "ds_read_b128 %4, %12 offset:64\n\tds_read_b128 %5, %12 offset:%15\n\tds_read_b128 %6, %12 offset:96\n\tds_read_b128 %7, %12 offset:%16\n\t" \
                         "ds_read_b128 %8, %12 offset:128\n\tds_read_b128 %9, %12 offset:%17\n\tds_read_b128 %10, %12 offset:160\n\tds_read_b128 %11, %12 offset:%18\n\ts_waitcnt lgkmcnt(0)" \
                         : "=&v"(kfa[0]), "=&v"(kfb[0]), "=&v"(kfa[1]), "=&v"(kfb[1]), "=&v"(kfa[2]), "=&v"(kfb[2]), "=&v"(kfa[3]), "=&v"(kfb[3]), "=&v"(kfa[DK / 16 - 2]), "=&v"(kfb[DK / 16 - 2]), "=&v"(kfa[DK / 16 - 1]), "=&v"(kfb[DK / 16 - 1]) \
                         : "v"(ka_), "n"(32 * KP), "n"(32 * KP + 32), "n"(32 * KP + 64), "n"(32 * KP + 96), "n"(32 * KP + 128), "n"(32 * KP + 160) : "memory"); \
        } \
        _Pragma("unroll") for (int i = 0; i < 16; ++i) { S0[i] = 0.f; S1[i] = 0.f; } \
        _Pragma("unroll") for (int kk = 0; kk < DK / 16; ++kk) { S0 = MFMA32(kfa[kk], qf[kk], S0); S1 = MFMA32(kfb[kk], qf[kk], S1); } } while (0)
#define ATT_VISSUE(vl, vh, base) asm volatile("ds_read_b64 %0, %16\n\tds_read_b64 %1, %16 offset:16\n\tds_read_b64 %2, %16 offset:32\n\tds_read_b64 %3, %16 offset:48\n\t" \
                         "ds_read_b64 %4, %16 offset:64\n\tds_read_b64 %5, %16 offset:80\n\tds_read_b64 %6, %16 offset:96\n\tds_read_b64 %7, %16 offset:112\n\t" \
                         "ds_read_b64 %8, %16 offset:%17\n\tds_read_b64 %9, %16 offset:%18\n\tds_read_b64 %10, %16 offset:%19\n\tds_read_b64 %11, %16 offset:%20\n\t" \
                         "ds_read_b64 %12, %16 offset:%21\n\tds_read_b64 %13, %16 offset:%22\n\tds_read_b64 %14, %16 offset:%23\n\tds_read_b64 %15, %16 offset:%24" \
                         : "=&v"(vl[0]), "=&v"(vh[0]), "=&v"(vl[1]), "=&v"(vh[1]), "=&v"(vl[2]), "=&v"(vh[2]), "=&v"(vl[3]), "=&v"(vh[3]), \
                           "=&v"(vl[4]), "=&v"(vh[4]), "=&v"(vl[5]), "=&v"(vh[5]), "=&v"(vl[6]), "=&v"(vh[6]), "=&v"(vl[7]), "=&v"(vh[7]) \
                         : "v"(base), "n"(32 * ATT_VP), "n"(32 * ATT_VP + 16), "n"(32 * ATT_VP + 32), "n"(32 * ATT_VP + 48), "n"(32 * ATT_VP + 64), "n"(32 * ATT_VP + 80), "n"(32 * ATT_VP + 96), "n"(32 * ATT_VP + 112) : "memory")
#define ATT_VWAIT(vl, vh) asm volatile("s_waitcnt lgkmcnt(0)" : "+v"(vl[0]), "+v"(vh[0]), "+v"(vl[1]), "+v"(vh[1]), "+v"(vl[2]), "+v"(vh[2]), "+v"(vl[3]), "+v"(vh[3]), \
                           "+v"(vl[4]), "+v"(vh[4]), "+v"(vl[5]), "+v"(vh[5]), "+v"(vl[6]), "+v"(vh[6]), "+v"(vl[7]), "+v"(vh[7]) :: "memory")
#define ATT_VFRAG(vl, vh, i) __builtin_bit_cast(bf16x8, (u32x4){vl[i].x, vl[i].y, vh[i].x, vh[i].y})
#define ATT_SOFTMAX_PV(bi, S0, S1) do { \
        const unsigned va_ = (unsigned)(unsigned long long)(lds + (bi) * ATT_BUF + ATT_VOFF + l32 * ATT_VP + 8 * hf); \
        u32x2 vl[8], vh[8]; \
        if (VAR != 4) ATT_VISSUE(vl, vh, va_);                        \
        float mx = fmaxf(fmaxf(S0[0], S1[0]), fmaxf(S0[1], S1[1])); \
        _Pragma("unroll") for (int i = 2; i < 16; i += 2) mx = fmaxf(mx, fmaxf(fmaxf(S0[i], S1[i]), fmaxf(S0[i + 1], S1[i + 1]))); \
        mx = xmax32(mx); \
        if (__builtin_amdgcn_ballot_w64((mx - mrun) * cs > 8.f) != 0ull) { const float mnew = fmaxf(mrun, mx); const float alpha = __builtin_amdgcn_exp2f((mrun - mnew) * cs); mrun = mnew; lrun *= alpha; \
            _Pragma("unroll") for (int tt = 0; tt < DV / 32; ++tt) O[tt] *= alpha; } \
        const float mc = mrun * cs; const f32x2 cs2 = {cs, cs}, mc2 = {mc, mc}; f32x2 ps2 = {0.f, 0.f}; \
        _Pragma("unroll") for (int i = 0; i < 16; i += 2) { f32x2 a = {S0[i], S0[i + 1]}, c = {S1[i], S1[i + 1]}; a = a * cs2 - mc2; c = c * cs2 - mc2; \
            if (VAR != 2) { a.x = __builtin_amdgcn_exp2f(a.x); a.y = __builtin_amdgcn_exp2f(a.y); c.x = __builtin_amdgcn_exp2f(c.x); c.y = __builtin_amdgcn_exp2f(c.y); } ps2 += a; ps2 += c; \
            S0[i] = a.x; S0[i + 1] = a.y; S1[i] = c.x; S1[i + 1] = c.y; } \
        lrun += ps2.x + ps2.y; \
        bf16x8 pf[4]; \
        _Pragma("unroll") for (int j = 0; j < 4; ++j) { u32x4 w; \
            if (j < 2) { w.x = cvtpk(S0[8 * j + 0], S0[8 * j + 1]); w.y = cvtpk(S0[8 * j + 2], S0[8 * j + 3]); w.z = cvtpk(S0[8 * j + 4], S0[8 * j + 5]); w.w = cvtpk(S0[8 * j + 6], S0[8 * j + 7]); } \
            else { const int jj = j - 2; w.x = cvtpk(S1[8 * jj + 0], S1[8 * jj + 1]); w.y = cvtpk(S1[8 * jj + 2], S1[8 * jj + 3]); w.z = cvtpk(S1[8 * jj + 4], S1[8 * jj + 5]); w.w = cvtpk(S1[8 * jj + 6], S1[8 * jj + 7]); } \
            pf[j] = __builtin_bit_cast(bf16x8, w); } \
        if (VAR == 4) { _Pragma("unroll") for (int tt = 0; tt < DV / 32; ++tt) _Pragma("unroll") for (int j = 0; j < 4; ++j) O[tt][j] += __builtin_bit_cast(float, (int)pf[j][0]); } else { \
            ATT_VWAIT(vl, vh); \
            _Pragma("unroll") for (int j = 0; j < 4; ++j) O[0] = MFMA32(ATT_VFRAG(vl, vh, j), pf[j], O[0]); \
            _Pragma("unroll") for (int j = 0; j < 4; ++j) O[1] = MFMA32(ATT_VFRAG(vl, vh, 4 + j), pf[j], O[1]); \
            if constexpr (DV == 128) { const unsigned vc_ = va_ + 64 * ATT_VP; u32x2 wl[8], wh[8]; ATT_VISSUE(wl, wh, vc_); ATT_VWAIT(wl, wh); \
                _Pragma("unroll") for (int j = 0; j < 4; ++j) O[2] = MFMA32(ATT_VFRAG(wl, wh, j), pf[j], O[2]); \
                _Pragma("unroll") for (int j = 0; j < 4; ++j) O[3] = MFMA32(ATT_VFRAG(wl, wh, 4 + j), pf[j], O[3]); } } } while (0)
#pragma unroll
    for (int t = 0; t < DV / 32; ++t)
#pragma unroll
        for (int i = 0; i < 16; ++i) O[t][i] = 0.f;
    float mrun = -1e30f, lrun = 0.f;
    f32x16 Sa0, Sa1;
    __syncthreads();
    ATT_LOADK(0, ka0, ka1); ATT_LOADV(0, va0, va1);
    for (int t = 0; t < ntiles; ++t) {
        if (VAR != 1 || t < 2) { ATT_STOREK(t & 1, ka0, ka1); ATT_STOREV(t & 1, va0, va1); }
        __syncthreads();
        if (VAR != 1) { if (t + 1 < ntiles) { ATT_LOADK(t + 1, ka0, ka1); ATT_LOADV(t + 1, va0, va1); } }
        if (VAR != 3) { ATT_QK(t & 1, Sa0, Sa1); } else {
#pragma unroll
            for (int i = 0; i < 16; ++i) { Sa0[i] = (float)(t + i) * 1e-3f; Sa1[i] = (float)(t - i) * 1e-3f; } }
        ATT_SOFTMAX_PV(t & 1, Sa0, Sa1);
    }
    lsum = xsum32(lrun);
#undef ATT_LOADK
#undef ATT_LOADV
#undef ATT_STOREK
#undef ATT_STOREV
#undef ATT_QK
#undef ATT_SOFTMAX_PV
#undef ATT_VISSUE
#undef ATT_VWAIT
#undef ATT_VFRAG
}

template <int VAR> __device__ __forceinline__ void attn_unit_a(LAS unsigned char* lds, KP p, int l, int bh, int qb, int wv) {
    unsigned char* ws = p->ws;
    const int b = bh >> 2, h = bh & 3;
    const int tid_ = otid(); const int lane = tid_ & 63, wid = tid_ >> 6, l32 = lane & 31, hf = lane >> 5;
    const int ntiles = qb == 0 ? CTX / 64 : TK / 64;
    const int q0 = qb == 0 ? 0 : CTX + (qb - 1) * 256;
    const bf16_t* QA = (const bf16_t*)(ws + WS_QA); const bf16_t* KA = (const bf16_t*)(ws + WS_KA); const bf16_t* VA = (const bf16_t*)(ws + WS_VA);
    const float cs = 0.125f * 1.4426950408889634f;
    const float lam = ((const float*)(ws + WS_LAM))[l];
    const float lam_init = ((const float*)(ws + WS_LAM))[8 + l];
    f32x16 O[4]; float lsum;
    const bf16_t* Vg = VA + (size_t)(b * 4 + h) * TK * 128;
    attn_pass<64, 128, VAR>(lds, QA + ((size_t)(b * 8 + h * 2 + 0) * TK + q0) * 64, KA + (size_t)(b * 8 + h * 2 + 0) * TK * 64, Vg, ntiles, cs, O, lsum, wv);
    LAS unsigned* o0 = (LAS unsigned*)(lds + 65536 + wid * 8192) + lane;
    { const float inv = 1.f / lsum;
#pragma unroll
      for (int t = 0; t < 4; ++t)
#pragma unroll
          for (int i = 0; i < 8; ++i) o0[(t * 8 + i) * 64] = cvtpk(O[t][2 * i] * inv, O[t][2 * i + 1] * inv); }
    attn_pass<64, 128, VAR>(lds, QA + ((size_t)(b * 8 + h * 2 + 1) * TK + q0) * 64, KA + (size_t)(b * 8 + h * 2 + 1) * TK * 64, Vg, ntiles, cs, O, lsum, wv);
    const float inv1 = lam / lsum;
    float ss = 0.f;
#pragma unroll
    for (int t = 0; t < 4; ++t)
#pragma unroll
        for (int i = 0; i < 8; ++i) { const unsigned ow = o0[(t * 8 + i) * 64]; const float a = __uint_as_float(ow << 16) - O[t][2 * i] * inv1, c = __uint_as_float(ow & 0xffff0000u) - O[t][2 * i + 1] * inv1;
            O[t][2 * i] = a; O[t][2 * i + 1] = c; ss += a * a + c * c; }
    ss = xsum32(ss);
    const float rs = rsq(ss * (1.f / 128.f) + EPS) * (1.f - lam_init);
    const int row = (qb == 0 ? MX + b * CTX : b * SEQ + (qb - 1) * 256) + wid * 32 + l32;
    if (VAR != 0 && rs != 12345.f) return;
    bf16_t* yp = (bf16_t*)(ws + WS_Y) + (size_t)row * 2048 + h * 128 + 4 * hf;
    const float* gs = p->g_sub + l * 128 + 4 * hf;
#pragma unroll
    for (int t = 0; t < 4; ++t)
#pragma unroll
        for (int i4 = 0; i4 < 4; ++i4) { const f32x4 g = *(const f32x4*)(gs + 32 * t + 8 * i4);
            f32x4 v; v[0] = O[t][4 * i4] * rs * g[0]; v[1] = O[t][4 * i4 + 1] * rs * g[1]; v[2] = O[t][4 * i4 + 2] * rs * g[2]; v[3] = O[t][4 * i4 + 3] * rs * g[3];
            *(u32x2*)(yp + 32 * t + 8 * i4) = pack4(v); }
}
template <int VAR> __device__ __forceinline__ void attn_unit_b(LAS unsigned char* lds, KP p, int bh, int qb, int wv) {
    unsigned char* ws = p->ws;
    const int b = bh >> 3, h = bh & 7;
    const int tid_ = otid(); const int lane = tid_ & 63, wid = tid_ >> 6, l32 = lane & 31, hf = lane >> 5;
    const int ntiles = qb == 0 ? CTX / 64 : TK / 64;
    const int q0 = qb == 0 ? 0 : CTX + (qb - 1) * 256;
    const bf16_t* QB = (const bf16_t*)(ws + WS_QB); const bf16_t* KB = (const bf16_t*)(ws + WS_KB); const bf16_t* VB = (const bf16_t*)(ws + WS_VB);
    const float cs = 0.10206207261596577f * 1.4426950408889634f;
    f32x16 O[2]; float lsum;
    attn_pass<96, 64, VAR>(lds, QB + ((size_t)bh * TK + q0) * 96, KB + (size_t)bh * TK * 96, VB + (size_t)bh * TK * 64, ntiles, cs, O, lsum, wv);
    const float inv = 1.f / lsum;
    const int row = (qb == 0 ? MX + b * CTX : b * SEQ + (qb - 1) * 256) + wid * 32 + l32;
    if (VAR != 0 && inv != 12345.f) return;
    bf16_t* yp = (bf16_t*)(ws + WS_Y) + (size_t)row * 2048 + 512 + h * 64 + 4 * hf;
#pragma unroll
    for (int t = 0; t < 2; ++t)
#pragma unroll
        for (int i4 = 0; i4 < 4; ++i4) { f32x4 v; v[0] = O[t][4 * i4] * inv; v[1] = O[t][4 * i4 + 1] * inv; v[2] = O[t][4 * i4 + 2] * inv; v[3] = O[t][4 * i4 + 3] * inv;
            *(u32x2*)(yp + 32 * t + 8 * i4) = pack4(v); }
}
template <int VAR> __device__ __forceinline__ void attn_phase(LAS unsigned char* lds, KP p, int l, int wv) {
    const int G = gridDim.x, c = blockIdx.x;
    const int NU = (l == DEPTH - 1) ? 768 : 864;
    for (int u = c; u < NU; u += G) {
        if (u < 256) { const int xcd = u & 7, j = u >> 3; attn_unit_a<VAR>(lds, p, l, xcd * 4 + (j >> 3), 1 + (j & 7), wv); }
        else if (u < 768) { const int u2 = u - 256, r = u2 >> 8, c2 = u2 & 255, xcd = c2 & 7, j = c2 >> 3; attn_unit_b<VAR>(lds, p, xcd * 8 + (j >> 3) * 2 + r, 1 + (j & 7), wv); }
        else { const int u3 = u - 768; if (u3 < 32) attn_unit_a<VAR>(lds, p, l, u3, 0, wv); else attn_unit_b<VAR>(lds, p, u3 - 32, 0, wv); }
    }
}

__device__ __forceinline__ void tr_item(const float* W, int N, bf16_t* WT, int ldk, int row_off, int split, int shift, int ncopy, int copy_stride, LAS float* scr, int item, int lane) {
    const int nblk = N / 32, kb = item / nblk, nb = item % nblk, k0 = 64 * kb, n0 = 32 * nb;
    float wv_[32];
#pragma unroll
    for (int i = 0; i < 32; ++i) wv_[i] = W[(size_t)(k0 + 2 * i + (lane >> 5)) * N + n0 + (lane & 31)];
#pragma unroll
    for (int i = 0; i < 32; ++i) scr[(2 * i + (lane >> 5)) * 33 + (lane & 31)] = wv_[i];
    asm volatile("s_waitcnt lgkmcnt(0)" ::: "memory");
    const int c = lane & 7;
    const int rsh = row_off + n0 + (n0 >= split ? shift : 0);
#pragma unroll
    for (int j = 0; j < 4; ++j) { const int n = (lane >> 3) + 8 * j; const LAS float* s = scr + (8 * c) * 33 + n;
        u32x4 o; o.x = cvtpk(s[0 * 33], s[1 * 33]); o.y = cvtpk(s[2 * 33], s[3 * 33]); o.z = cvtpk(s[4 * 33], s[5 * 33]); o.w = cvtpk(s[6 * 33], s[7 * 33]);
        for (int cp = 0; cp < ncopy; ++cp) *(u32x4*)(WT + (size_t)(rsh + n) * ldk + cp * copy_stride + k0 + 8 * c) = o; }
    asm volatile("s_waitcnt lgkmcnt(0)" ::: "memory");
}
__device__ __forceinline__ void convert_weights(LAS unsigned char* lds, KP p, int l, int wv) {
    unsigned char* ws = p->ws;
    const int tid_ = otid(); const int lane = tid_ & 63, wid = tid_ >> 6;
    LAS float* scr = (LAS float*)(lds + wid * 8704);
    const int gw = blockIdx.x * 8 + wid, NGW = gridDim.x * 8;
    constexpr int I_IN = 16 * (DIN / 32), I_UQ = 6 * 24, I_UKV = 4 * 32, I_BR = 8 * 32, I_O = 16 * 32, I_F1 = 16 * 128, I_F2 = 64 * 32;
    constexpr int NIT = I_IN + I_UQ + I_UKV + 3 * I_BR + I_O + I_F1 + I_F2;
    const int BIG = 1 << 30;
    for (int it = gw; it < NIT; it += NGW) {
        int r = it;
        if (r < I_IN) { tr_item(p->w_in + (size_t)l * DM * DIN, DIN, (bf16_t*)(ws + WS_WIN), DM, 0, NGATE0, NPM - NGATE0, 1, 0, scr, r, lane); continue; } r -= I_IN;
        if (r < I_UQ) { const int nb = r % 24, hh = nb / 3, part = nb % 3, dest = part < 2 ? (2 * hh + part) * 32 : 512 + 32 * hh;
            tr_item(p->w_uq + (size_t)l * 384 * 768, 768, (bf16_t*)(ws + WS_WUQ), 384, dest - 32 * nb, BIG, 0, 1, 0, scr, r, lane); continue; } r -= I_UQ;
        if (r < I_UKV) { tr_item(p->w_ukv + (size_t)l * 256 * 1024, 1024, (bf16_t*)(ws + WS_WUKV), 256, 0, BIG, 0, 1, 0, scr, r, lane); continue; } r -= I_UKV;
        if (r < 3 * I_BR) { const int z3 = r / I_BR, z = z3 == 2 ? 3 : z3; tr_item(p->w_branch + ((size_t)l * 4 + z) * 512 * 1024, 1024, (bf16_t*)(ws + WS_WBR), 512, z * 1024, BIG, 0, 1, 0, scr, r % I_BR, lane); continue; } r -= 3 * I_BR;
        if (r < I_O) { tr_item(p->w_o + (size_t)l * DM * DM, DM, (bf16_t*)(ws + WS_WO4), 4096, 0, BIG, 0, 1, 0, scr, r, lane); continue; } r -= I_O;
        if (r < I_F1) { tr_item(p->w_ff1 + (size_t)l * DM * DFF, DFF, (bf16_t*)(ws + WS_WF1), DM, 0, BIG, 0, 1, 0, scr, r, lane); continue; } r -= I_F1;
        tr_item(p->w_ff2 + (size_t)l * DFF * DM, DM, (bf16_t*)(ws + WS_WF2), DFF, 0, BIG, 0, 1, 0, scr, r, lane);
    }
    { const int gt = blockIdx.x * 512 + otid(), NT = gridDim.x * 512; u32x4* z = (u32x4*)((bf16_t*)(ws + WS_WIN) + (size_t)NGATE0 * DM);
      unsigned z0 = 0u; asm volatile("" : "+v"(z0));
      for (int i = gt; i < (NPM - NGATE0) * DM / 8; i += NT) z[i] = (u32x4){z0, z0, z0, z0}; }
    { const float* wp = p->w_pool + (size_t)l * 4 * 128 * 128; const float* sp = p->s_pool + l * 512; const float* wb = p->w_branch + ((size_t)l * 4 + 2) * 512 * 1024;
      bf16_t* dst = (bf16_t*)(ws + WS_WBR) + (size_t)2048 * 512;
      LAS float* As = (LAS float*)lds;
      const int tid = otid();
      int gcur = -1;
      for (int it = blockIdx.x; it < 4 * 256; it += gridDim.x) {
          const int gi = it >> 8, d0 = (it & 255) * 4;
          if (gi != gcur) { __syncthreads();
              for (int i = tid; i < 128 * 128; i += 512) { const int cl = i >> 7, j = i & 127; As[cl * 129 + j] = wp[(size_t)gi * 16384 + i] * sp[gi * 128 + j]; }
              __syncthreads(); gcur = gi; }
          const int cl = tid & 127, d = d0 + __builtin_amdgcn_readfirstlane(tid >> 7);
          const float* br = wb + (size_t)gi * 128 * 1024 + d;
          float a = 0.f;
#pragma unroll 8
          for (int j = 0; j < 128; ++j) a += As[cl * 129 + j] * br[(size_t)j * 1024];
          dst[(size_t)d * 512 + gi * 128 + cl] = (bf16_t)(cvtpk(a, 0.f) & 0xffffu);
      }
      __syncthreads(); }
}
__device__ __forceinline__ void mod_phase(LAS unsigned char* lds, KP p, int wv) {
    LAS float* sv = (LAS float*)lds;
    LAS float* red = (LAS float*)(lds + 9 * 1024 * 4);
    const int tid = otid(), lane = tid & 63, wid = tid >> 6;
    for (int i = tid; i < 9 * 1024; i += 512) { const float v = i < 8192 ? p->c[i] : p->c_ctx[i - 8192]; sv[i] = v / (1.f + __expf(-v)); }
    __syncthreads();
    float* mod = (float*)(p->ws + WS_MOD);
    for (int it = blockIdx.x; it < DEPTH * 96; it += gridDim.x) {
        const int l = it / 96, n0 = (it % 96) * 64;
        const float* W = p->w_mod + (size_t)l * DM * 6144 + n0 + lane;
        float a[9];
#pragma unroll
        for (int r = 0; r < 9; ++r) a[r] = 0.f;
        for (int k = wid * 128; k < wid * 128 + 128; k += 8) { float w[8];
#pragma unroll
            for (int j = 0; j < 8; ++j) w[j] = W[(size_t)(k + j) * 6144];
#pragma unroll
            for (int r = 0; r < 9; ++r) { const f32x4 s0 = *(const LAS f32x4*)(sv + r * 1024 + k), s1 = *(const LAS f32x4*)(sv + r * 1024 + k + 4);
                a[r] += ((s0[0] * w[0] + s0[1] * w[1]) + (s0[2] * w[2] + s0[3] * w[3])) + ((s1[0] * w[4] + s1[1] * w[5]) + (s1[2] * w[6] + s1[3] * w[7])); } }
#pragma unroll
        for (int r = 0; r < 9; ++r) red[(wid * 9 + r) * 64 + lane] = a[r];
        __syncthreads();
        for (int o = tid; o < 9 * 64; o += 512) { const int r = o >> 6, n = o & 63; float s = p->b_mod[l * 6144 + n0 + n];
#pragma unroll
            for (int w = 0; w < 8; ++w) s += red[(w * 9 + r) * 64 + n];
            mod[((size_t)l * 9 + r) * 6144 + n0 + n] = s;
            const int nn = n0 + n, ch = nn >> 10, cc = nn & 1023;
            if (ch == 1) ((float*)(p->ws + WS_VM))[(((size_t)l * 2 + 0) * 9 + r) * DM + cc] = p->g1[l * DM + cc] * (1.f + s);
            if (ch == 4) ((float*)(p->ws + WS_VM))[(((size_t)l * 2 + 1) * 9 + r) * DM + cc] = p->g2[l * DM + cc] * (1.f + s); }
        __syncthreads();
    }
}
__device__ __forceinline__ void bias_gemv(LAS unsigned char* lds, KP p, int l, int wv) {
    LAS float* sv = (LAS float*)lds;
    LAS float* red = (LAS float*)(lds + 2 * 9 * 1024 * 4);
    const int tid = otid(), lane = tid & 63, wid = tid >> 6;
    const float* mod = (const float*)(p->ws + WS_MOD) + (size_t)l * 9 * 6144;
    __syncthreads();
    for (int i = tid; i < 2 * 9 * 1024; i += 512) { const int which = i / 9216, r = (i % 9216) >> 10, k = i & 1023; sv[i] = mod[(size_t)r * 6144 + (which ? 3 : 0) * 1024 + k]; }
    __syncthreads();
    constexpr int IT1 = (DIN + 63) / 64, IT2 = DFF / 64;
    for (int it = blockIdx.x; it < IT1 + IT2; it += gridDim.x) {
        const bool second = it >= IT1; const int n0 = (second ? it - IT1 : it) * 64; const int N = second ? DFF : DIN;
        const int col = n0 + lane; const bool on = col < N;
        const float* W = (second ? p->w_ff1 + (size_t)l * DM * DFF : p->w_in + (size_t)l * DM * DIN) + (on ? col : 0);
        const LAS float* s9 = sv + (second ? 9216 : 0);
        float a[9];
#pragma unroll
        for (int r = 0; r < 9; ++r) a[r] = 0.f;
        for (int k = wid * 128; k < wid * 128 + 128; k += 8) { float w[8];
#pragma unroll
            for (int j = 0; j < 8; ++j) w[j] = W[(size_t)(k + j) * N];
#pragma unroll
            for (int r = 0; r < 9; ++r) { const f32x4 s0 = *(const LAS f32x4*)(s9 + r * 1024 + k), s1 = *(const LAS f32x4*)(s9 + r * 1024 + k + 4);
                a[r] += ((s0[0] * w[0] + s0[1] * w[1]) + (s0[2] * w[2] + s0[3] * w[3])) + ((s1[0] * w[4] + s1[1] * w[5]) + (s1[2] * w[6] + s1[3] * w[7])); } }
#pragma unroll
        for (int r = 0; r < 9; ++r) red[(wid * 9 + r) * 64 + lane] = a[r];
        __syncthreads();
        for (int o = tid; o < 9 * 64; o += 512) { const int r = o >> 6, n = o & 63; const int c = n0 + n;
            if (c < N) { float s = 0.f;
#pragma unroll
                for (int w = 0; w < 8; ++w) s += red[(w * 9 + r) * 64 + n];
                if (second) ((float*)(p->ws + WS_BIAS2))[(size_t)r * DFF + c] = s;
                else ((float*)(p->ws + WS_BIAS1))[(size_t)r * NIN + (c < NGATE0 ? c : c + (NPM - NGATE0))] = s; } }
        __syncthreads();
    }
}
__device__ __forceinline__ void init_h(KP p, int wv) {
    const int tid_ = otid(); const int lane = tid_ & 63, wid = tid_ >> 6;
    const int gw = blockIdx.x * 8 + wid, NGW = gridDim.x * 8;
    const float* vm = (const float*)(p->ws + WS_VM);
    bf16_t* H = (bf16_t*)(p->ws + WS_H); float* part = (float*)(p->ws + WS_PART);
    for (int row = gw; row < MT; row += NGW) {
        const float* xr = row < MX ? p->x + (size_t)row * DM : p->ctx + (size_t)(row - MX) * DM;
        const float* vr = vm + (size_t)(row < MX ? (row >> 11) : 8) * DM;
        float s = 0.f;
#pragma unroll
        for (int j = 0; j < 4; ++j) { const int col = 4 * lane + 256 * j; const f32x4 v = *(const f32x4*)(xr + col); s += (v[0] * v[0] + v[1] * v[1]) + (v[2] * v[2] + v[3] * v[3]);
            *(u32x2*)(H + (size_t)row * DM + col) = pack4(v * *(const f32x4*)(vr + col)); }
        s = wave_sum(s);
        if (lane < 16) part[(size_t)row * 16 + lane] = lane == 0 ? s : 0.f;
    }
}
__device__ __forceinline__ void norm_phase(KP p, int l, int chunk, int nrows, int wv) {
    const int tid_ = otid(); const int lane = tid_ & 63, wid = tid_ >> 6;
    const int gw = blockIdx.x * 8 + wid, NGW = gridDim.x * 8;
    const float* g = (chunk == 0 ? p->g1 : p->g2) + l * DM;
    const float* mod = (const float*)(p->ws + WS_MOD) + (size_t)l * 9 * 6144;
    bf16_t* H = (bf16_t*)(p->ws + WS_H);
    for (int row = gw; row < nrows; row += NGW) {
        const float* xr = row < MX ? p->out + (size_t)row * DM : (const float*)(p->ws + WS_XC) + (size_t)(row - MX) * DM;
        const float* mr = mod + (size_t)(row < MX ? (row >> 11) : 8) * 6144 + chunk * 1024;
        f32x4 v[4]; float s = 0.f;
#pragma unroll
        for (int j = 0; j < 4; ++j) { v[j] = *(const f32x4*)(xr + 4 * lane + 256 * j); s += (v[j][0] * v[j][0] + v[j][1] * v[j][1]) + (v[j][2] * v[j][2] + v[j][3] * v[j][3]); }
        const float rs = rsq(wave_sum(s) * (1.f / DM) + EPS);
#pragma unroll
        for (int j = 0; j < 4; ++j) { const int col = 4 * lane + 256 * j; const f32x4 gv = *(const f32x4*)(g + col), sh = *(const f32x4*)(mr + col), sc = *(const f32x4*)(mr + 1024 + col);
            f32x4 o = (v[j] * rs * gv) * (1.f + sc) + sh; *(u32x2*)(H + (size_t)row * DM + col) = pack4(o); }
    }
}

__device__ __forceinline__ void prep1_phase(KP p, int l, int wv) {
    unsigned char* ws = p->ws;
    const int tid_ = otid(); const int lane = tid_ & 63, wid = tid_ >> 6;
    const int gw = blockIdx.x * 8 + wid, NGW = gridDim.x * 8;
    const bf16_t* __restrict__ Pm = (const bf16_t*)(ws + WS_R1);
    bf16_t* __restrict__ QA = (bf16_t*)(ws + WS_QA); bf16_t* __restrict__ KA = (bf16_t*)(ws + WS_KA); bf16_t* __restrict__ VA = (bf16_t*)(ws + WS_VA);
    bf16_t* __restrict__ CQ = (bf16_t*)(ws + WS_CQ); bf16_t* __restrict__ CKV = (bf16_t*)(ws + WS_CKV); bf16_t* __restrict__ KR = (bf16_t*)(ws + WS_KR); bf16_t* __restrict__ Y = (bf16_t*)(ws + WS_Y);
    f32x8 invA, invB, gq, gk, gcq, gckv, gkr;
#pragma unroll
    for (int e = 0; e < 8; ++e) { invA[e] = (lane & 1) ? INVA_REV[8 + e] : INVA_REV[e]; invB[e] = INVB_REV[e];
        gq[e] = p->gq_a[l * 64 + (lane & 7) * 8 + e]; gk[e] = p->gk_a[l * 64 + (lane & 7) * 8 + e];
        gcq[e] = lane < 48 ? p->g_cq[l * 384 + 8 * lane + e] : 0.f; gckv[e] = lane < 32 ? p->g_ckv[l * 256 + 8 * lane + e] : 0.f; gkr[e] = lane < 4 ? p->gk_b[l * 96 + 64 + 8 * lane + e] : 0.f; }
    const float* wcv = p->w_conv + (size_t)l * 3 * 512 + 8 * lane;
#pragma unroll 2
    for (int row = gw; row < MT; row += NGW) {
        const bool isx = row < MX;
        const int b = isx ? (row >> 11) : ((row - MX) >> 8);
        const int t = isx ? (row & 2047) : ((row - MX) & 255);
        const int S = isx ? SEQ : CTX;
        const int arow = isx ? CTX + t : t;
        const bf16_t* pr = Pm + (size_t)row * NPM;
        f32x8 csA, snA, csB, snB;
        if (isx) { const float posA = (float)((lane & 2) ? (t & 63) : (t >> 6)); const float posB = (float)((lane & 1) ? (t & 63) : (t >> 6));
#pragma unroll
            for (int e = 0; e < 8; ++e) { const float a = posA * invA[e]; csA[e] = __builtin_amdgcn_cosf(a); snA[e] = __builtin_amdgcn_sinf(a); const float bq = posB * invB[e]; csB[e] = __builtin_amdgcn_cosf(bq); snB[e] = __builtin_amdgcn_sinf(bq); } }
        const u32x4 rq = ld16(pr + C_Q + 8 * lane), rk = ld16(pr + C_K + 8 * lane);
        const u32x4 rcq = ld16(pr + C_CQ + 8 * min(lane, 47)), rckv = ld16(pr + C_CKV + 8 * (lane & 31)), rkr = ld16(pr + C_KR + 8 * (lane & 3));
        const u32x4 rpb = ld16(pr + C_PB + 8 * lane), rpc = ld16(pr + C_PC + 8 * lane), rpx = ld16(pr + C_PX + 8 * lane);
        const bf16_t* prm = (t > 0) ? pr - NPM : pr; const bf16_t* prp = (t < S - 1) ? pr + NPM : pr;
        const float fm = (t > 0) ? 1.f : 0.f, fp = (t < S - 1) ? 1.f : 0.f;
        const u32x4 rpcm = ld16(prm + C_PC + 8 * lane), rpxm = ld16(prm + C_PX + 8 * lane), rpcp = ld16(prp + C_PC + 8 * lane), rpxp = ld16(prp + C_PX + 8 * lane);
        const int hw = 1 << (lane >> 4); const int lo = max(t - hw, 0), hi = min(t + hw, S);
        const bf16_t* pp = pr + C_POOL + 8 * lane;
        u32x4 pw[16]; float pvf[16];
#pragma unroll
        for (int j = 0; j < 16; ++j) { const int o = j - 8; const int tt = t + o; const bool v = (o >= -hw) && (o < hw) && (tt >= 0) && (tt < S); pw[j] = ld16(pp + (ptrdiff_t)(v ? o : 0) * NPM); pvf[j] = v ? 1.f : 0.f; }
        const u32x4 rpu = ld16(pp);
        asm volatile("" ::: "memory");
#pragma unroll
        for (int which = 0; which < 2; ++which) {
            f32x8 v = unpack8(which == 0 ? rq : rk);
            float ss = sum8(v); ss += shx<1>(ss); ss += shx<2>(ss); ss += shx<4>(ss);
            const float rs = rsq(ss * (1.f / 64.f) + EPS);
#pragma unroll
            for (int e = 0; e < 8; ++e) v[e] = v[e] * rs * (which == 0 ? gq[e] : gk[e]);
            if (isx) {
#pragma unroll
                for (int e = 0; e < 8; ++e) { const float o = shx<4>(v[e]); v[e] = (lane & 4) ? (o * snA[e] + v[e] * csA[e]) : (v[e] * csA[e] - o * snA[e]); } }
            bf16_t* dst = (which == 0 ? QA : KA) + ((size_t)(b * 8 + (lane >> 3)) * TK + arow) * 64 + (lane & 7) * 8;
            *(u32x4*)dst = pack8(v);
        }
        { f32x8 v = unpack8(rcq);
          if (lane >= 48) {
#pragma unroll
              for (int e = 0; e < 8; ++e) v[e] = 0.f; }
          const float rs = rsq(wave_sum(sum8(v)) * (1.f / 384.f) + EPS);
          if (lane < 48) {
#pragma unroll
              for (int e = 0; e < 8; ++e) v[e] = v[e] * rs * gcq[e];
              *(u32x4*)(CQ + (size_t)row * 384 + 8 * lane) = pack8(v); } }
        { f32x8 v = unpack8(rckv);
          if (lane >= 32) {
#pragma unroll
              for (int e = 0; e < 8; ++e) v[e] = 0.f; }
          const float rs = rsq(wave_sum(sum8(v)) * (1.f / 256.f) + EPS);
          if (lane < 32) {
#pragma unroll
              for (int e = 0; e < 8; ++e) v[e] = v[e] * rs * gckv[e];
              *(u32x4*)(CKV + (size_t)row * 256 + 8 * lane) = pack8(v); } }
        { f32x8 v = unpack8(rkr);
          float ss = sum8(v); ss += shx<1>(ss); ss += shx<2>(ss);
          const float rs = rsq(ss * (1.f / 32.f) + EPS);
#pragma unroll
          for (int e = 0; e < 8; ++e) v[e] = v[e] * rs * p->gk_b[l * 96 + 64 + 8 * (lane & 3) + e];
          if (isx) {
#pragma unroll
              for (int e = 0; e < 8; ++e) { const float o = shx<2>(v[e]); v[e] = (lane & 2) ? (o * snB[e] + v[e] * csB[e]) : (v[e] * csB[e] - o * snB[e]); } }
          if (lane < 4) *(u32x4*)(KR + (size_t)row * 32 + 8 * lane) = pack8(v); }
        { f32x8 sum;
#pragma unroll
          for (int e = 0; e < 8; ++e) sum[e] = 0.f;
#pragma unroll
          for (int j = 0; j < 16; ++j) sum += unpack8(pw[j]) * pvf[j];
          const float inv = 1.f / (float)(hi - lo);
          *(u32x4*)(Y + (size_t)row * 2048 + 1024 + 8 * lane) = pack8(sum * inv - unpack8(rpu)); }
        { const f32x8 pb = unpack8(rpb);
          const f32x8 uc = unpack8(rpc) * unpack8(rpx);
          const f32x8 um = unpack8(rpcm) * unpack8(rpxm) * fm, up = unpack8(rpcp) * unpack8(rpxp) * fp;
          f32x8 y;
#pragma unroll
          for (int e = 0; e < 8; ++e) y[e] = pb[e] * (um[e] * wcv[e] + uc[e] * wcv[512 + e] + up[e] * wcv[1024 + e]);
          *(u32x4*)(Y + (size_t)row * 2048 + 1536 + 8 * lane) = pack8(y); }
    }
}
__device__ __forceinline__ void prep2_phase(KP p, int l, int wv) {
    unsigned char* ws = p->ws;
    const int tid_ = otid(); const int lane = tid_ & 63, wid = tid_ >> 6;
    const int gw = blockIdx.x * 8 + wid, NGW = gridDim.x * 8;
    const bf16_t* __restrict__ QBR = (const bf16_t*)(ws + WS_QBR); const bf16_t* __restrict__ KVR = (const bf16_t*)(ws + WS_KVR); const bf16_t* __restrict__ KR = (const bf16_t*)(ws + WS_KR);
    bf16_t* __restrict__ QB = (bf16_t*)(ws + WS_QB); bf16_t* __restrict__ KB = (bf16_t*)(ws + WS_KB); bf16_t* __restrict__ VB = (bf16_t*)(ws + WS_VB);
    const int h = lane >> 3, sub = lane & 7;
    f32x8 gqn, gkn; f32x4 gqr, invB;
#pragma unroll
    for (int e = 0; e < 8; ++e) { gqn[e] = p->gq_b[l * 96 + sub * 8 + e]; gkn[e] = p->gk_b[l * 96 + sub * 8 + e]; }
#pragma unroll
    for (int e = 0; e < 4; ++e) { gqr[e] = p->gq_b[l * 96 + 64 + sub * 4 + e]; invB[e] = (sub & 1) ? INVB_REV[4 + e] : INVB_REV[e]; }
    for (int row0 = gw; row0 < MT; row0 += 3 * NGW) {
        u32x4 rqn[3], rkn[3], rvv[3]; u32x2 rqr[3], rkr[3];
#pragma unroll
        for (int q = 0; q < 3; ++q) { const int row = (row0 + q * NGW < MT) ? row0 + q * NGW : row0;
            const bf16_t* qr = QBR + (size_t)row * 768 + h * 96; const bf16_t* kr = KVR + (size_t)row * 1024 + h * 128;
            rqn[q] = ld16(qr + sub * 8); rqr[q] = *(const u32x2*)(qr + 64 + sub * 4); rkn[q] = ld16(kr + sub * 8); rvv[q] = ld16(kr + 64 + sub * 8); rkr[q] = *(const u32x2*)(KR + (size_t)row * 32 + sub * 4); }
        asm volatile("" ::: "memory");
#pragma unroll
        for (int q = 0; q < 3; ++q) { const int row = row0 + q * NGW;
            if (row < MT) {
                const bool isx = row < MX;
                const int b = isx ? (row >> 11) : ((row - MX) >> 8);
                const int t = isx ? (row & 2047) : ((row - MX) & 255);
                const int arow = isx ? CTX + t : t;
                const size_t ar = (size_t)(b * 8 + h) * TK + arow;
                f32x8 vn = unpack8(rqn[q]);
                f32x4 vr = unpack4(rqr[q]);
                float sn_ = sum8(vn); sn_ += shx<1>(sn_); sn_ += shx<2>(sn_); sn_ += shx<4>(sn_);
                float sr_ = (vr[0] * vr[0] + vr[1] * vr[1]) + (vr[2] * vr[2] + vr[3] * vr[3]); sr_ += shx<1>(sr_); sr_ += shx<2>(sr_); sr_ += shx<4>(sr_);
                const float rn = rsq(sn_ * (1.f / 64.f) + EPS), rr = rsq(sr_ * (1.f / 32.f) + EPS);
#pragma unroll
                for (int e = 0; e < 8; ++e) vn[e] = vn[e] * rn * gqn[e];
#pragma unroll
                for (int e = 0; e < 4; ++e) vr[e] = vr[e] * rr * gqr[e];
                if (isx) { const float pos = (float)((sub & 2) ? (t & 63) : (t >> 6));
#pragma unroll
                    for (int e = 0; e < 4; ++e) { const float a = pos * invB[e]; const float cs = __builtin_amdgcn_cosf(a), sn = __builtin_amdgcn_sinf(a); const float o = shx<4>(vr[e]);
                        vr[e] = (sub & 4) ? (o * sn + vr[e] * cs) : (vr[e] * cs - o * sn); } }
                *(u32x4*)(QB + ar * 96 + sub * 8) = pack8(vn);
                *(u32x2*)(QB + ar * 96 + 64 + sub * 4) = pack4(vr);
                f32x8 kn = unpack8(rkn[q]);
                float sk = sum8(kn); sk += shx<1>(sk); sk += shx<2>(sk); sk += shx<4>(sk);
                const float rk = rsq(sk * (1.f / 64.f) + EPS);
#pragma unroll
                for (int e = 0; e < 8; ++e) kn[e] = kn[e] * rk * gkn[e];
                *(u32x4*)(KB + ar * 96 + sub * 8) = pack8(kn);
                *(u32x2*)(KB + ar * 96 + 64 + sub * 4) = rkr[q];
                *(u32x4*)(VB + ar * 64 + sub * 8) = rvv[q];
            } }
    }
}

__device__ __forceinline__ void presum_phase(KP p, int nrows, int wv) {
    const bf16_t* __restrict__ Gm = (const bf16_t*)(p->ws + WS_R1);
    bf16_t* __restrict__ Sm = (bf16_t*)(p->ws + WS_MIX);
    const int gt = blockIdx.x * 512 + otid(), NT = gridDim.x * 512;
    const int total = nrows * 128;
    for (int i = gt; i < total; i += 4 * NT) {
        u32x4 a[4], b[4], c[4], d[4]; int idx[4];
#pragma unroll
        for (int q = 0; q < 4; ++q) { idx[q] = (i + q * NT < total) ? i + q * NT : i; const bf16_t* g = Gm + (size_t)(idx[q] >> 7) * 4096 + (idx[q] & 127) * 8;
            a[q] = ld16(g); b[q] = ld16(g + 1024); c[q] = ld16(g + 2048); d[q] = ld16(g + 3072); }
        asm volatile("" ::: "memory");
#pragma unroll
        for (int q = 0; q < 4; ++q) *(u32x4*)(Sm + (size_t)(idx[q] >> 7) * DM + (idx[q] & 127) * 8) = pack8((unpack8(a[q]) + unpack8(b[q])) + (unpack8(c[q]) + unpack8(d[q])));
    }
}

#define XB_TMO      128
#define XB_XCNT(j)  (256  + 64 * (j))
#define XB_XSUB(j)  (1280 + 64 * (j))
#define XB_XGEN(j)  (2304 + 64 * (j))
#define XB_TOP      3328
#define XB_TOPGEN   3392
#define XCD_BAR_WORDS 3456
#define XB_SPIN_CAP (1u << 22)
__device__ __forceinline__ unsigned xb_ld(unsigned* p)              { return __hip_atomic_load(p, __ATOMIC_RELAXED, __HIP_MEMORY_SCOPE_AGENT); }
__device__ __forceinline__ unsigned xb_add(unsigned* p, unsigned v) { return __hip_atomic_fetch_add(p, v, __ATOMIC_RELAXED, __HIP_MEMORY_SCOPE_AGENT); }
__device__ __forceinline__ unsigned xb_xcc_id() { return (unsigned)__builtin_amdgcn_s_getreg((3 << 11) | 20) & 0xFu; }
#define XB_SPIN(cond, bar) do { unsigned _sp = 0; while (cond) { __builtin_amdgcn_s_sleep(1); \
    if ((++_sp & 255u) == 0u) { if (xb_ld(&(bar)[XB_TMO])) break; if (_sp > XB_SPIN_CAP) { atomicAdd(&(bar)[XB_TMO], 1u); break; } } } } while (0)
struct XcdBarrier { unsigned* bar; unsigned x; volatile LAS unsigned* st; };
__device__ __forceinline__ XcdBarrier xcd_barrier_post(unsigned* bar, volatile LAS unsigned* st) {
    XcdBarrier b; b.bar = bar; b.x = xb_xcc_id(); b.st = st;
    if (threadIdx.x == 0) (void)xb_add(&bar[XB_XCNT(b.x)], 1u);
    return b;
}
__device__ __forceinline__ void xcd_barrier_complete(unsigned* bar, unsigned x, unsigned& nloc, unsigned& nx) {
    const unsigned G = gridDim.x * gridDim.y * gridDim.z;
    unsigned sum, cnt, mine, sp = 0u;
    for (;;) {
        sum = 0u; cnt = 0u; mine = 0u;
#pragma unroll
        for (unsigned j = 0; j < 16; ++j) { const unsigned c = xb_ld(&bar[XB_XCNT(j)]); sum += c; cnt += (c > 0u) ? 1u : 0u; mine = (j == x) ? c : mine; }
        if (sum == G) break;
        __builtin_amdgcn_s_sleep(1);
        if ((++sp & 255u) == 0u) { if (xb_ld(&bar[XB_TMO])) break; if (sp > XB_SPIN_CAP) { atomicAdd(&bar[XB_TMO], 1u); break; } }
    }
    nloc = mine > 0u ? mine : 1u; nx = cnt > 0u ? cnt : 1u;
}
__device__ __forceinline__ void xcd_barrier(const XcdBarrier& b, int wv) {
    asm volatile("s_waitcnt vmcnt(0)" ::: "memory");
    __syncthreads();
    if (otid() == 0) {
        unsigned* bar = b.bar; unsigned bx = b.x;
        asm volatile("" : "+s"(bar), "+s"(bx));
        __builtin_amdgcn_s_waitcnt(0);
        unsigned nloc = b.st[0], nx = b.st[1];
        if (nloc == 0u) { xcd_barrier_complete(bar, bx, nloc, nx); b.st[0] = nloc; b.st[1] = nx; }
        const unsigned old = xb_add(&bar[XB_XSUB(bx)], 1u);
        const unsigned gen = old / nloc;
        if (old + 1u == (gen + 1u) * nloc) {
            __builtin_amdgcn_fence(__ATOMIC_RELEASE, "agent");
            asm volatile("s_waitcnt vmcnt(0)" ::: "memory");
            const unsigned og = xb_add(&bar[XB_TOP], 1u);
            const unsigned tg = og / nx;
            if (og + 1u == (tg + 1u) * nx) xb_add(&bar[XB_TOPGEN], 1u);
            else XB_SPIN(xb_ld(&bar[XB_TOPGEN]) == tg, bar);
            __builtin_amdgcn_fence(__ATOMIC_ACQUIRE, "agent");
            xb_add(&bar[XB_XGEN(bx)], 1u);
            asm volatile("s_waitcnt vmcnt(0)" ::: "memory");
        } else {
            XB_SPIN(xb_ld(&bar[XB_XGEN(bx)]) == gen, bar);
            __builtin_amdgcn_fence(__ATOMIC_ACQUIRE, "agent");
            asm volatile("s_waitcnt vmcnt(0)" ::: "memory");
        }
    }
    __syncthreads();
}

constexpr int N_PHASES = 1 + DEPTH * 10;
constexpr int ATT_PROBE = -1;
constexpr int REP0 = 1, REP1 = 1, REP2 = 1, REP3 = 1, REP4 = 1, REP5 = 1, REP6 = 1, REP7 = 1, REP8 = 1, REP9 = 1;

#define PHASE_BEGIN KP p = (KP)__builtin_amdgcn_kernarg_segment_ptr(); asm volatile("" : "+s"(p)); unsigned char* ws = p->ws; const int G = gridDim.x, c = obid(); (void)G; (void)c; (void)ws;
__global__ void __launch_bounds__(512) mega(Params p_unused, int ph_lo, int ph_hi) {
    extern __shared__ __attribute__((aligned(16))) unsigned char lds_raw[];
    LAS unsigned char* lds = (LAS unsigned char*)lds_raw;
    cg::grid_group grid = cg::this_grid();
    const int wv = __builtin_amdgcn_readfirstlane((int)(threadIdx.x >> 6));
    { volatile LAS unsigned* st0 = (volatile LAS unsigned*)(lds + 131072); if (threadIdx.x == 0) { st0[0] = 0u; st0[1] = 0u; } __syncthreads(); }
    const XcdBarrier xbar = xcd_barrier_post((unsigned*)(((KP)__builtin_amdgcn_kernarg_segment_ptr())->ws + WS_BAR), (volatile LAS unsigned*)(lds + 131072));
    {   PHASE_BEGIN
        mod_phase(lds, p, wv);
        const int tid0 = otid();
        if (c == 0 && tid0 < 64) { const int lane = tid0;
            for (int l = 0; l < DEPTH; ++l) { const float* la = p->lam_a + l * 256; const float s1 = wave_sum(la[lane] * la[64 + lane]), s2 = wave_sum(la[128 + lane] * la[192 + lane]);
                const float li = l == 0 ? LAM_INIT[0] : (l == 1 ? LAM_INIT[1] : (l == 2 ? LAM_INIT[2] : LAM_INIT[3]));
                if (lane == 0) { ((float*)(ws + WS_LAM))[l] = __expf(s1) - __expf(s2) + li; ((float*)(ws + WS_LAM))[8 + l] = li; } } }
    }
    if (ph_hi == 0x7fffffff) grid.sync();
    xcd_barrier(xbar, wv);
    for (int l = 0; l < DEPTH; ++l) {
        const bool last = (l == DEPTH - 1);
        const int Mact = last ? MX : MT;
        for (int rep = 0; rep < REP0; ++rep) { PHASE_BEGIN
            if (rep) __syncthreads();
            convert_weights(lds, p, l, wv); bias_gemv(lds, p, l, wv); if (l == 0) init_h(p, wv); }
        xcd_barrier(xbar, wv);
        for (int rep = 0; rep < REP1; ++rep) { PHASE_BEGIN
            pg8::Gemm g{(const bf16_t*)(ws + WS_H), (const bf16_t*)(ws + WS_WIN), DM, DM, DM, 0, 0};
            pg8::Epi<1> E{(bf16_t*)(ws + WS_R1), NPM, NPM / 256, (bf16_t*)(ws + WS_R2), NPG, nullptr, nullptr, nullptr, nullptr, nullptr, nullptr, nullptr, (bf16_t*)(ws + WS_VA), nullptr, (const float*)(ws + WS_PART), (const float*)(ws + WS_BIAS1), NIN};
            pg8::StaticOrder S; S.init(MT, NIN, G, c);
            pg8::gemm_phase(lds, g, S, E, wv); }
        xcd_barrier(xbar, wv);
        for (int rep = 0; rep < REP2; ++rep) { PHASE_BEGIN prep1_phase(p, l, wv); }
        xcd_barrier(xbar, wv);
        for (int rep = 0; rep < REP3; ++rep) { PHASE_BEGIN
            { int k1 = 384; asm volatile("" : "+s"(k1));
              pg8::Gemm g{(const bf16_t*)(ws + WS_CQ), (const bf16_t*)(ws + WS_WUQ), k1, k1, k1, 0, 0};
              pg8::Epi<6> E{(bf16_t*)(ws + WS_QB), l, 0, nullptr, 0, nullptr, nullptr, nullptr, p->gq_b + l * 96, nullptr, nullptr, nullptr, nullptr, nullptr, nullptr, nullptr, 0};
              pg8::StaticOrder S; S.init(MT, 768, G, c);
              pg8::gemm_phase(lds, g, S, E, wv); }
            { int k2 = 256; asm volatile("" : "+s"(k2));
              pg8::Gemm g{(const bf16_t*)(ws + WS_CKV), (const bf16_t*)(ws + WS_WUKV), k2, k2, k2, 0, 0};
              pg8::Epi<7> E{(bf16_t*)(ws + WS_KB), l, 0, (bf16_t*)(ws + WS_VB), 0, (const bf16_t*)(ws + WS_KR), nullptr, nullptr, p->gk_b + l * 96, nullptr, nullptr, nullptr, nullptr, nullptr, nullptr, nullptr, 0};
              pg8::StaticOrder S; S.init(MT, 1024, G, (c + 40) % G);
              pg8::gemm_phase(lds, g, S, E, wv); } }
        xcd_barrier(xbar, wv);
        { PHASE_BEGIN attn_phase<0>(lds, p, l, wv); }
        if (ATT_PROBE >= 0) { PHASE_BEGIN __syncthreads(); attn_phase<(ATT_PROBE < 0 ? 0 : ATT_PROBE)>(lds, p, l, wv); }
        xcd_barrier(xbar, wv);
        for (int rep = 0; rep < REP6; ++rep) { PHASE_BEGIN
            pg8::Gemm g{(const bf16_t*)(ws + WS_Y), (const bf16_t*)(ws + WS_WBR), 512, 2048, 512, 2, 1024};
            pg8::Epi<2> E{(bf16_t*)(ws + WS_R1), 4096, 0, nullptr, 0, (const bf16_t*)(ws + WS_R2), nullptr, nullptr, nullptr, nullptr, nullptr, nullptr, nullptr, nullptr, nullptr, nullptr, 0};
            pg8::StaticOrder S; S.init(Mact, 4096, G, c);
            pg8::gemm_phase(lds, g, S, E, wv); }
        xcd_barrier(xbar, wv);
        { PHASE_BEGIN presum_phase(p, Mact, wv); }
        xcd_barrier(xbar, wv);
        for (int rep = 0; rep < REP7; ++rep) { PHASE_BEGIN
            pg8::Gemm g{(const bf16_t*)(ws + WS_MIX), (const bf16_t*)(ws + WS_WO4), DM, DM, 4096, 0, 0};
            pg8::Epi<3> E{nullptr, rep ? 12345 : 0, 0, nullptr, 0, nullptr, p->out, (float*)(ws + WS_XC), (const float*)(ws + WS_MOD) + (size_t)l * 9 * 6144 + 2 * 1024, l == 0 ? p->x : (const float*)p->out, l == 0 ? p->ctx : (const float*)(ws + WS_XC),
                          (const float*)(ws + WS_VM) + ((size_t)l * 2 + 1) * 9 * DM, (bf16_t*)(ws + WS_H), (float*)(ws + WS_PART), nullptr, nullptr, 0};
            pg8::StaticOrder S; S.init(Mact, DM, G, c);
            pg8::gemm_phase(lds, g, S, E, wv); }
        xcd_barrier(xbar, wv);
        for (int rep = 0; rep < REP8; ++rep) { PHASE_BEGIN
            pg8::Gemm g{(const bf16_t*)(ws + WS_H), (const bf16_t*)(ws + WS_WF1), DM, DM, DM, 0, 0};
            pg8::Epi<4> E{(bf16_t*)(ws + WS_R2), DFF, 0, nullptr, 0, nullptr, nullptr, nullptr, nullptr, nullptr, nullptr, nullptr, nullptr, nullptr, (const float*)(ws + WS_PART), (const float*)(ws + WS_BIAS2), DFF};
            pg8::StaticOrder S; S.init(Mact, DFF, G, c);
            pg8::gemm_phase(lds, g, S, E, wv); }
        xcd_barrier(xbar, wv);
        for (int rep = 0; rep < REP9; ++rep) { PHASE_BEGIN
            pg8::Gemm g{(const bf16_t*)(ws + WS_R2), (const bf16_t*)(ws + WS_WF2), DFF, DFF, DFF, 0, 0};
            pg8::Epi<3> E{nullptr, rep ? 12345 : 0, 0, nullptr, 0, nullptr, p->out, (float*)(ws + WS_XC), (const float*)(ws + WS_MOD) + (size_t)l * 9 * 6144 + 5 * 1024, (const float*)p->out, (const float*)(ws + WS_XC),
                          last ? nullptr : (const float*)(ws + WS_VM) + ((size_t)(l + 1) * 2 + 0) * 9 * DM, (bf16_t*)(ws + WS_H), (float*)(ws + WS_PART), nullptr, nullptr, 0};
            pg8::StaticOrder S; S.init(Mact, DM, G, c);
            pg8::gemm_phase(lds, g, S, E, wv); }
        if (!last) xcd_barrier(xbar, wv);
    }
}

extern "C" void kernel_launch(void* const* d_in, const int* in_sizes, int n_in, void* d_out, int out_size, void* d_ws, size_t ws_size, hipStream_t stream) {
    static int grid = 0;
    if (grid == 0) {
        if (n_in != 26 || out_size != MX * DM || ws_size < WS_END) { fprintf(stderr, "kernel_launch: unexpected problem (n_in %d out %d ws %zu)\n", n_in, out_size, ws_size); grid = -1; return; }
        int dev = 0, cus = 0, per_cu = 0;
        hipGetDevice(&dev); hipDeviceGetAttribute(&cus, hipDeviceAttributeMultiprocessorCount, dev);
        hipFuncSetAttribute((const void*)mega, hipFuncAttributeMaxDynamicSharedMemorySize, LDS_BYTES);
        hipOccupancyMaxActiveBlocksPerMultiprocessor(&per_cu, (const void*)mega, 512, LDS_BYTES);
        (void)hipGetLastError();
        grid = cus > 0 ? cus : 256;
        if (per_cu < 1) fprintf(stderr, "kernel_launch: occupancy query says %d blocks/CU\n", per_cu);
    }
    if (grid < 0) return;
    Params p{};
    const float** pp = (const float**)&p;
    for (int i = 0; i < 26; ++i) pp[i] = (const float*)d_in[i];
    p.out = (float*)d_out; p.ws = (unsigned char*)d_ws;
    if (hipMemsetAsync((char*)d_ws + WS_BAR, 0, XCD_BAR_WORDS * 4, stream) != hipSuccess) { fprintf(stderr, "memset failed\n"); return; }
#if MK_COOP
    int lo = 0, hi = N_PHASES;
    void* args[] = {&p, &lo, &hi};
    hipError_t e = hipLaunchCooperativeKernel((const void*)mega, dim3(grid), dim3(512), args, LDS_BYTES, stream);
    if (e != hipSuccess) fprintf(stderr, "cooperative launch failed: %s\n", hipGetErrorString(e));
#else
    for (int ph = 0; ph < N_PHASES; ++ph) hipLaunchKernelGGL(mega, dim3(grid), dim3(512), LDS_BYTES, stream, p, ph, ph + 1);
#endif
}
```

```cpp
#include <hip/hip_runtime.h>
#include <hip/hip_cooperative_groups.h>
#include <cstdio>
#include <cstdint>
namespace cg = cooperative_groups;

#ifndef PHM
#define PHM 0xffff
#endif
#ifndef MK_COOP
#define MK_COOP 1
#endif

#define LAS __attribute__((address_space(3)))
typedef unsigned short bf16_t;
typedef short bf16x8 __attribute__((ext_vector_type(8)));
typedef float f32x2 __attribute__((ext_vector_type(2)));
typedef float f32x4 __attribute__((ext_vector_type(4)));
typedef float f32x8 __attribute__((ext_vector_type(8)));
typedef float f32x16 __attribute__((ext_vector_type(16)));
typedef unsigned u32x2 __attribute__((ext_vector_type(2)));
typedef unsigned u32x4 __attribute__((ext_vector_type(4)));
typedef __bf16 bf16x2_t __attribute__((ext_vector_type(2)));

constexpr int DM = 1024, NB = 8, SEQ = 2048, DEPTH = 4, CTX = 256, TK = CTX + SEQ;
constexpr int MX = NB * SEQ, MC = NB * CTX, MT = MX + MC;
constexpr int DIN = 8352, NPM = 4352, NPG = 4096, NIN = NPM + NPG, DFF = 4096;
constexpr int NGATE0 = 4256;
constexpr float EPS = 1e-6f;
constexpr int C_Q = 0, C_K = 512, C_V = 1024, C_CQ = 1536, C_CKV = 1920, C_KR = 2176, C_POOL = 2208, C_PB = 2720, C_PC = 3232, C_PX = 3744;

constexpr size_t MiB = 1u << 20;
constexpr size_t WS_WIN = 0, WS_WUQ = 17 * MiB, WS_WUKV = 18 * MiB, WS_WBR = 19 * MiB, WS_WO4 = 23 * MiB, WS_WF1 = 31 * MiB, WS_WF2 = 39 * MiB;
constexpr size_t WS_MOD = 48 * MiB, WS_LAM = 49 * MiB, WS_KR = 50 * MiB;
constexpr size_t WS_BAR = 51 * MiB + 512 * 1024;
constexpr size_t WS_XC = 52 * MiB;
constexpr size_t WS_Y = 60 * MiB, WS_H = WS_Y;
constexpr size_t WS_MIX = WS_Y + 36 * MiB;
constexpr size_t WS_QA = 132 * MiB, WS_KA = 150 * MiB, WS_VA = 168 * MiB;
constexpr size_t WS_CQ = 186 * MiB, WS_CKV = 200 * MiB;
constexpr size_t WS_R1 = 209 * MiB;
constexpr size_t WS_QBR = WS_R1, WS_KVR = WS_R1 + 27 * MiB, WS_QB = WS_R1 + 63 * MiB, WS_KB = WS_R1 + 90 * MiB, WS_VB = WS_R1 + 117 * MiB;
constexpr size_t WS_R2 = 362 * MiB;
constexpr size_t WS_VM = 49 * MiB + 4096, WS_BIAS1 = 49 * MiB + 512 * 1024, WS_BIAS2 = 49 * MiB + 832 * 1024;
constexpr size_t WS_PART = 506 * MiB;
constexpr size_t WS_END = 508 * MiB;
constexpr int LDS_BYTES = 131072 + 1024 + 10 * 2048;

struct Params {
    const float *x, *c, *ctx, *c_ctx, *w_mod, *b_mod, *g1, *g2, *w_in, *gq_a, *gk_a, *lam_a, *g_sub, *g_cq, *w_uq, *g_ckv, *w_ukv, *gq_b, *gk_b,
        *w_pool, *s_pool, *w_conv, *w_branch, *w_o, *w_ff1, *w_ff2;
    float* out; unsigned char* ws;
};

typedef const __attribute__((address_space(4))) Params* KP;
__device__ __forceinline__ unsigned cvtpk(float lo, float hi) { f32x2 v = {lo, hi}; bf16x2_t b = __builtin_convertvector(v, bf16x2_t); return __builtin_bit_cast(unsigned, b); }
__device__ __forceinline__ f32x8 unpack8(u32x4 w) {
    f32x8 r;
    r[0] = __uint_as_float(w.x << 16); r[1] = __uint_as_float(w.x & 0xffff0000u); r[2] = __uint_as_float(w.y << 16); r[3] = __uint_as_float(w.y & 0xffff0000u);
    r[4] = __uint_as_float(w.z << 16); r[5] = __uint_as_float(w.z & 0xffff0000u); r[6] = __uint_as_float(w.w << 16); r[7] = __uint_as_float(w.w & 0xffff0000u);
    return r;
}
__device__ __forceinline__ f32x4 unpack4(u32x2 w) {
    f32x4 r; r[0] = __uint_as_float(w.x << 16); r[1] = __uint_as_float(w.x & 0xffff0000u); r[2] = __uint_as_float(w.y << 16); r[3] = __uint_as_float(w.y & 0xffff0000u); return r;
}
__device__ __forceinline__ u32x4 pack8(f32x8 v) { u32x4 w; w.x = cvtpk(v[0], v[1]); w.y = cvtpk(v[2], v[3]); w.z = cvtpk(v[4], v[5]); w.w = cvtpk(v[6], v[7]); return w; }
__device__ __forceinline__ u32x2 pack4(f32x4 v) { u32x2 w; w.x = cvtpk(v[0], v[1]); w.y = cvtpk(v[2], v[3]); return w; }
__device__ __forceinline__ u32x4 ld16(const bf16_t* p) { return *(const u32x4*)p; }
template <int O> __device__ __forceinline__ float shx(float v) {
    if constexpr (O < 32) return __builtin_bit_cast(float, __builtin_amdgcn_ds_swizzle(__builtin_bit_cast(int, v), (O << 10) | 0x1f));
    else { auto rr = __builtin_amdgcn_permlane32_swap(__builtin_bit_cast(unsigned, v), __builtin_bit_cast(unsigned, v), false, false);
           const float a = __builtin_bit_cast(float, (unsigned)rr[0]), b = __builtin_bit_cast(float, (unsigned)rr[1]); return a == v ? b : a; }
}
__device__ __forceinline__ float xsum32(float v) { auto rr = __builtin_amdgcn_permlane32_swap(__builtin_bit_cast(unsigned, v), __builtin_bit_cast(unsigned, v), false, false);
    return __builtin_bit_cast(float, (unsigned)rr[0]) + __builtin_bit_cast(float, (unsigned)rr[1]); }
__device__ __forceinline__ float xmax32(float v) { auto rr = __builtin_amdgcn_permlane32_swap(__builtin_bit_cast(unsigned, v), __builtin_bit_cast(unsigned, v), false, false);
    return fmaxf(__builtin_bit_cast(float, (unsigned)rr[0]), __builtin_bit_cast(float, (unsigned)rr[1])); }
__device__ __forceinline__ float wave_sum(float v) {
    v += shx<1>(v); v += shx<2>(v); v += shx<4>(v); v += shx<8>(v); v += shx<16>(v); return xsum32(v);
}
__device__ __forceinline__ float sum8(f32x8 v) { return ((v[0] * v[0] + v[1] * v[1]) + (v[2] * v[2] + v[3] * v[3])) + ((v[4] * v[4] + v[5] * v[5]) + (v[6] * v[6] + v[7] * v[7])); }
__device__ __forceinline__ int olane() { int l; asm volatile("v_mbcnt_lo_u32_b32 %0, -1, 0\n\tv_mbcnt_hi_u32_b32 %0, -1, %0" : "=v"(l)); return l; }
#define otid() ((wv << 6) | olane())
__device__ __forceinline__ int obid() { int t = blockIdx.x; asm volatile("" : "+s"(t)); return t; }
__device__ __forceinline__ float rsq(float x) { return __builtin_amdgcn_rsqf(x); }

__device__ constexpr float INVA_REV[16] = {1.591549431e-01f, 8.949940161e-02f, 5.032921210e-02f, 2.830219583e-02f, 1.591549431e-02f, 8.949940161e-03f, 5.032921210e-03f, 2.830219583e-03f, 1.591549431e-03f, 8.949940161e-04f, 5.032921210e-04f, 2.830219583e-04f, 1.591549431e-04f, 8.949940161e-05f, 5.032921210e-05f, 2.830219583e-05f};
__device__ constexpr float INVB_REV[8] = {1.591549431e-01f, 5.032921210e-02f, 1.591549431e-02f, 5.032921210e-03f, 1.591549431e-03f, 5.032921210e-04f, 1.591549431e-04f, 5.032921210e-05f};
__device__ constexpr float LAM_INIT[4] = {2.000000000e-01f, 3.555090676e-01f, 4.707130183e-01f, 5.560582042e-01f};

constexpr float CS_A = 0.125f * 1.4426950408889634f, CS_B = 0.10206207261596577f * 1.4426950408889634f;

namespace pg8 {
constexpr int BM = 256, BK = 64, HALF = 128, HTB = HALF * BK * 2, STAGE_BYTES = 8 * HTB, NXCD = 8, WGM = 8;
__host__ __device__ __forceinline__ int lds_byte(int r, int c) { const int st = (r >> 4) * 2 + (c >> 5), rr = r & 15, cc = c & 31, ob = rr * 64 + cc * 2; return st * 1024 + (ob ^ (((ob >> 9) & 1) << 5)); }
__host__ __device__ __forceinline__ void stage_rc(int b, int& R, int& C) { const int st = b / 1024, sb = b % 1024, swz = sb ^ (((sb >> 9) & 1) << 5); R = (st >> 1) * 16 + swz / 64; C = (st & 1) * 32 + (swz % 64) / 2; }
__host__ __device__ __forceinline__ int perm32(int rho) { const int n = rho >> 4, i = rho & 15; return 8 * (i >> 2) + 4 * n + (i & 3); }

struct Unit { int pm, pn; };
struct Gemm { const bf16_t* A; const bf16_t* Bt; int K, lda, ldb, zshift; size_t zA; };

struct StaticOrder {
    int nM, nN, nwg, G, c;
    __device__ void init(int M, int N, int G_, int c_) { nM = M / BM; nN = N / BM; nwg = nM * nN; G = G_; c = c_; }
    __device__ bool next(int i, Unit& u) const {
        const long L = (long)i * G + c; if (L >= nwg) return false;
        int wgid = (int)L; { const int q = nwg / NXCD, r = nwg % NXCD, xcd = wgid % NXCD, off = wgid / NXCD; wgid = (xcd < r ? xcd * (q + 1) : r * (q + 1) + (xcd - r) * q) + off; }
        const int nig = WGM * nN, gid = wgid / nig, fm = gid * WGM, gsz = (nM - fm) < WGM ? (nM - fm) : WGM;
        u.pm = fm + ((wgid % nig) % gsz); u.pn = (wgid % nig) / gsz; return true;
    }
};

template <int MODE> struct Epi {
    static constexpr bool PERM = true, TAB = (MODE == 1 || MODE == 4);
    bf16_t* O; int ldc; int split_tile; bf16_t* O2; int ldc2;
    const bf16_t* gate;
    float* xo; float* xc; const float* mod; const float* xi; const float* xci;
    const float* vm; bf16_t* Hout; float* part;
    const float* partr; const float* bias; int bias_ld;
    __device__ __forceinline__ void operator()(const f32x4 (&acc)[2][2][4][2], const Unit& u, int wr, int wc, int fr, int fq, const LAS float* tab) const {
        const int ln_ = olane(); const int fr_ = ln_ & 15, fq_ = ln_ >> 4; (void)fr; (void)fq;
        const int row0 = u.pm * BM + wr * 64 + fr_;
        const int ct = u.pn * BM + wc * 32 + 8 * fq_;
        if constexpr (MODE == 0 || MODE == 1 || MODE == 4) {
            bf16_t* base = O; int ld = ldc; int c0 = ct;
            if (MODE == 1 && u.pn >= split_tile) { base = O2; ld = ldc2; c0 = ct - split_tile * BM; }
            float rs[8];
#pragma unroll
            for (int i = 0; i < 8; ++i) rs[i] = 1.f;
            if (MODE != 0) {
#pragma unroll
                for (int i = 0; i < 8; ++i) rs[i] = tab[wr * 64 + fr_ + (i >> 2) * HALF + (i & 3) * 16]; }
#pragma unroll
            for (int bj = 0; bj < 2; ++bj) {
                f32x4 b0 = {0.f, 0.f, 0.f, 0.f}, b1 = b0;
                if (MODE != 0) { const LAS float* bp = tab + 256 + wc * 32 + 8 * fq_ + bj * HALF; b0 = *(const LAS f32x4*)bp; b1 = *(const LAS f32x4*)(bp + 4); }
#pragma unroll
                for (int i = 0; i < 8; ++i) { const int ai = i >> 2, m = i & 3; bf16_t* rowp = base + (size_t)(row0 + ai * HALF + m * 16) * ld + c0;
                    if (MODE == 1 && (u.pn == 4 || u.pn == 5)) {
                        const bool isx = u.pm < MX / BM; const int bb = isx ? (u.pm >> 3) : (u.pm - MX / BM), ar0 = isx ? CTX + (u.pm & 7) * BM : 0;
                        rowp = Hout + ((size_t)(bb * 4 + 2 * (u.pn - 4) + bj) * TK + ar0 + wr * 64 + fr_ + ai * HALF + m * 16) * 128 + wc * 32 + 8 * fq_ - bj * HALF; }
                    f32x4 v0 = acc[ai][bj][m][0], v1 = acc[ai][bj][m][1];
                    if (MODE != 0) { v0 = v0 * rs[i] + b0; v1 = v1 * rs[i] + b1; }
                    if (MODE == 4) {
#pragma unroll
                        for (int e = 0; e < 4; ++e) { float a = fmaxf(v0[e], 0.f), b = fmaxf(v1[e], 0.f); v0[e] = a * a; v1[e] = b * b; } }
                    u32x4 w; w.x = cvtpk(v0[0], v0[1]); w.y = cvtpk(v0[2], v0[3]); w.z = cvtpk(v1[0], v1[1]); w.w = cvtpk(v1[2], v1[3]);
                    *(u32x4*)(rowp + bj * HALF) = w; } }
        } else if constexpr (MODE == 6 || MODE == 7) {
            LAS float* xb = (LAS float*)tab;
            const bool isx = u.pm < MX / BM;
            const int b = isx ? (u.pm >> 3) : (u.pm - MX / BM);
            const int arow0 = isx ? CTX + (u.pm & 7) * BM : 0, t0 = (u.pm & 7) * BM;
            const int lr0 = wr * 64 + fr_;
#pragma unroll
            for (int bj = 0; bj < 2; ++bj)
#pragma unroll
                for (int i = 0; i < 8; ++i) { const f32x4 v0 = acc[i >> 2][bj][i & 3][0], v1 = acc[i >> 2][bj][i & 3][1];
                    float s = ((v0[0] * v0[0] + v0[1] * v0[1]) + (v0[2] * v0[2] + v0[3] * v0[3])) + ((v1[0] * v1[0] + v1[1] * v1[1]) + (v1[2] * v1[2] + v1[3] * v1[3]));
                    s += shx<16>(s); s = xsum32(s);
                    if (fq_ == 0) xb[((lr0 + (i >> 2) * HALF + (i & 3) * 16) * 2 + bj) * 4 + wc] = s; }
            asm volatile("s_waitcnt lgkmcnt(0)" ::: "memory"); __builtin_amdgcn_s_barrier(); asm volatile("" ::: "memory");
            const bool rope_tile = (MODE == 6) && (u.pn == 2);
            const bool vwave = (MODE == 7) && (wc >= 2);
#pragma unroll
            for (int bj = 0; bj < 2; ++bj) {
                const int h = (MODE == 7) ? (2 * u.pn + bj) : (rope_tile ? (4 * bj + wc) : (4 * u.pn + 2 * bj + (wc >> 1)));
                const size_t hb = (size_t)(b * 8 + h) * TK + arow0;
                f32x8 gn;
#pragma unroll
                for (int e = 0; e < 8; ++e) gn[e] = mod[(rope_tile ? 64 : (wc & 1) * 32) + 8 * fq_ + e] * (MODE == 6 ? CS_B : 1.f);
#pragma unroll
                for (int i = 0; i < 8; ++i) { const int lr = lr0 + (i >> 2) * HALF + (i & 3) * 16; const f32x4 v0 = acc[i >> 2][bj][i & 3][0], v1 = acc[i >> 2][bj][i & 3][1];
                    f32x8 v; v[0] = v0[0]; v[1] = v0[1]; v[2] = v0[2]; v[3] = v0[3]; v[4] = v1[0]; v[5] = v1[1]; v[6] = v1[2]; v[7] = v1[3];
                    if (vwave) {
                        *(u32x4*)(O2 + (hb + lr) * 64 + (wc - 2) * 32 + 8 * fq_) = pack8(v);
                        if (wc == 2) *(u32x4*)(O + (hb + lr) * 96 + 64 + 8 * fq_) = ld16(gate + (size_t)(u.pm * BM + lr) * 32 + 8 * fq_);
                    } else if (rope_tile) {
                        const float rs = rsq(xb[((lr * 2 + bj) * 4 + wc)] * (1.f / 32.f) + EPS);
#pragma unroll
                        for (int e = 0; e < 8; ++e) v[e] = v[e] * rs * gn[e];
                        if (isx) { const int t = t0 + lr; const float pos = (float)((fq_ & 1) ? (t & 63) : (t >> 6));
#pragma unroll
                            for (int e = 0; e < 8; ++e) { const float a = pos * INVB_REV[e]; const float cs = __builtin_amdgcn_cosf(a), sn = __builtin_amdgcn_sinf(a); const float o = shx<32>(v[e]);
                                v[e] = (fq_ & 2) ? (o * sn + v[e] * cs) : (v[e] * cs - o * sn); } }
                        *(u32x4*)(O + (hb + lr) * 96 + 64 + 8 * fq_) = pack8(v);
                    } else {
                        const LAS float* xp = xb + ((lr * 2 + bj) * 4 + (wc & 2));
                        const float rs = rsq((xp[0] + xp[1]) * (1.f / 64.f) + EPS);
#pragma unroll
                        for (int e = 0; e < 8; ++e) v[e] = v[e] * rs * gn[e];
                        *(u32x4*)(O + (hb + lr) * 96 + (wc & 1) * 32 + 8 * fq_) = pack8(v);
                    } } }
            asm volatile("s_waitcnt lgkmcnt(0)" ::: "memory"); __builtin_amdgcn_s_barrier(); asm volatile("" ::: "memory");
        } else if constexpr (MODE == 2) {
#pragma unroll
            for (int bj = 0; bj < 2; ++bj) {
                u32x4 gw[8];
#pragma unroll
                for (int i = 0; i < 8; ++i) gw[i] = ld16(gate + (size_t)(row0 + (i >> 2) * HALF + (i & 3) * 16) * NPG + ct + bj * HALF);
#pragma unroll
                for (int i = 0; i < 8; ++i) { const int ai = i >> 2, m = i & 3; const size_t off = (size_t)(row0 + ai * HALF + m * 16) * NPG + ct + bj * HALF;
                    const f32x8 g = unpack8(gw[i]); const f32x4 v0 = acc[ai][bj][m][0], v1 = acc[ai][bj][m][1]; f32x8 o;
#pragma unroll
                    for (int e = 0; e < 8; ++e) { const float sg = __builtin_amdgcn_rcpf(1.f + __builtin_amdgcn_exp2f(-1.4426950408889634f * g[e])); o[e] = (e < 4 ? v0[e & 3] : v1[e & 3]) * sg; }
                    *(u32x4*)(O + off) = pack8(o); } }
        } else if (MODE == 3 && ldc != 12345) {
            const int R = u.pm * BM;
            float* xb = (R < MX) ? xo + (size_t)R * DM : xc + (size_t)(R - MX) * DM;
            const float* xr = (R < MX) ? xi + (size_t)R * DM : xci + (size_t)(R - MX) * DM;
            const int mr = (R < MX) ? (R >> 11) : 8;
            float ss[8];
#pragma unroll
            for (int i = 0; i < 8; ++i) ss[i] = 0.f;
#pragma unroll
            for (int bj = 0; bj < 2; ++bj) {
                const float* gp = mod + (size_t)mr * 6144 + ct + bj * HALF; const f32x4 g0 = *(const f32x4*)gp, g1 = *(const f32x4*)(gp + 4);
                f32x4 w0 = {0.f, 0.f, 0.f, 0.f}, w1 = w0;
                if (vm) { const float* vp = vm + (size_t)mr * DM + ct + bj * HALF; w0 = *(const f32x4*)vp; w1 = *(const f32x4*)(vp + 4); }
#pragma unroll
                for (int hb = 0; hb < 2; ++hb) {
                    f32x4 xa[4], xbv[4];
#pragma unroll
                    for (int q = 0; q < 4; ++q) { const int i = hb * 4 + q; const int lr = wr * 64 + fr_ + (i >> 2) * HALF + (i & 3) * 16; const float* xp = xr + (size_t)lr * DM + ct + bj * HALF; xa[q] = *(const f32x4*)xp; xbv[q] = *(const f32x4*)(xp + 4); }
#pragma unroll
                    for (int q = 0; q < 4; ++q) { const int i = hb * 4 + q; const int ai = i >> 2, m = i & 3; const int lr = wr * 64 + fr_ + ai * HALF + m * 16; float* xp = xb + (size_t)lr * DM + ct + bj * HALF;
                        f32x4 xv0 = xa[q] + g0 * acc[ai][bj][m][0], xv1 = xbv[q] + g1 * acc[ai][bj][m][1];
                        *(f32x4*)xp = xv0; *(f32x4*)(xp + 4) = xv1;
                        if (vm) { ss[i] += ((xv0[0] * xv0[0] + xv0[1] * xv0[1]) + (xv0[2] * xv0[2] + xv0[3] * xv0[3])) + ((xv1[0] * xv1[0] + xv1[1] * xv1[1]) + (xv1[2] * xv1[2] + xv1[3] * xv1[3]));
                            const f32x4 h0 = xv0 * w0, h1 = xv1 * w1; u32x4 w; w.x = cvtpk(h0[0], h0[1]); w.y = cvtpk(h0[2], h0[3]); w.z = cvtpk(h1[0], h1[1]); w.w = cvtpk(h1[2], h1[3]);
                            *(u32x4*)(Hout + (size_t)(R + lr) * DM + ct + bj * HALF) = w; } } } }
            if (vm) {
#pragma unroll
                for (int i = 0; i < 8; ++i) { float s = ss[i]; s += shx<16>(s); s = xsum32(s); const int lr = wr * 64 + fr_ + (i >> 2) * HALF + (i & 3) * 16;
                    if (fq_ == 0) part[(size_t)(R + lr) * 16 + u.pn * 4 + wc] = s; } }
        }
    }
};

template <class EpiT, class Sched>
__device__ __forceinline__ void gemm_phase(LAS unsigned char* lds, const Gemm g, const Sched& S, const EpiT& E, int wv) {
    LAS float* tab = (LAS float*)(lds + STAGE_BYTES + 1024);
    const int tid = otid(), wid = __builtin_amdgcn_readfirstlane(tid >> 6), lane = tid & 63, wr = wid >> 2, wc = wid & 3, fr = lane & 15, fq = lane >> 4;
    const int K = g.K, nt = K / BK;
    unsigned voffA[2], voffB[2];
#pragma unroll
    for (int i = 0; i < 2; ++i) { int R, C; stage_rc(tid * 16 + i * 8192, R, C); const int Rb = EpiT::PERM ? ((R & ~31) + perm32(R & 31)) : R;
        voffA[i] = (unsigned)(R * g.lda + C) * 2u; voffB[i] = (unsigned)(Rb * g.ldb + C) * 2u; }
    const size_t kstep = (size_t)(BK * 2);
    const size_t hstepA = (size_t)HALF * g.lda * 2, hstepB = (size_t)HALF * g.ldb * 2;
    const size_t tstepA = 2 * hstepA, tstepB = 2 * hstepB;
    const unsigned ldsw = (unsigned)wid * 1024u;
    const int foff = lds_byte(fr, fq * 8);
    const int aoff = wr * 8192 + foff, boff = wc * 4096 + foff;
#define PG8_SA(b, h) (((b) * 2 + (h)) * HTB)
#define PG8_SB(b, h) ((4 + (b) * 2 + (h)) * HTB)
#define PG8_STAGE(bufoff, gbase, voff) do { _Pragma("unroll") for (int _i = 0; _i < 2; ++_i) \
        __builtin_amdgcn_global_load_lds((const unsigned*)((const char*)(gbase) + (voff)[_i]), (LAS unsigned*)(lds + (bufoff) + ldsw + _i * 8192), 16, 0, 0); } while (0)
#define PG8_LDA(dst, b, h) do { _Pragma("unroll") for (int m = 0; m < 4; ++m) _Pragma("unroll") for (int k = 0; k < 2; ++k) dst[m][k] = *(const LAS bf16x8*)(lds + PG8_SA(b, h) + aoff + m * 2048 + k * 1024); } while (0)
#define PG8_LDB(dst, b, h) do { _Pragma("unroll") for (int n = 0; n < 2; ++n) _Pragma("unroll") for (int k = 0; k < 2; ++k) dst[n][k] = *(const LAS bf16x8*)(lds + PG8_SB(b, h) + boff + n * 2048 + k * 1024); } while (0)
#define PG8_MMA(ai, bj, At, Bt) do { __builtin_amdgcn_s_setprio(1); _Pragma("unroll") for (int m = 0; m < 4; ++m) _Pragma("unroll") for (int n = 0; n < 2; ++n) _Pragma("unroll") for (int k = 0; k < 2; ++k) \
        acc[ai][bj][m][n] = __builtin_amdgcn_mfma_f32_16x16x32_bf16(Bt[n][k], At[m][k], acc[ai][bj][m][n], 0, 0, 0); __builtin_amdgcn_s_setprio(0); } while (0)
#define PG8_WAIT_V(n) asm volatile("s_waitcnt vmcnt(" #n ")" ::: "memory")
#define PG8_WAIT_L(n) asm volatile("s_waitcnt lgkmcnt(" #n ")" ::: "memory")
#define PG8_BAR __builtin_amdgcn_s_barrier()
#define PG8_SCHED __builtin_amdgcn_sched_barrier(0)
    Unit cur, nxt; int ui = 0;
    if (!S.next(0, cur)) return;
    if constexpr (EpiT::TAB) {
        Unit tu;
        for (int i = 0; S.next(i, tu); ++i) {
            if (tid < 256) { const f32x4* pp = (const f32x4*)(E.partr + (size_t)(tu.pm * BM + tid) * 16); const f32x4 p0 = pp[0], p1 = pp[1], p2 = pp[2], p3 = pp[3];
                const f32x4 ps = (p0 + p1) + (p2 + p3); tab[i * 512 + tid] = rsq(((ps[0] + ps[1]) + (ps[2] + ps[3])) * (1.f / DM) + EPS); }
            else { const int mr = (tu.pm * BM < MX) ? ((tu.pm * BM) >> 11) : 8; tab[i * 512 + tid] = E.bias[(size_t)mr * E.bias_ld + tu.pn * BM + (tid - 256)]; }
        }
        __syncthreads();
    }
    f32x4 acc[2][2][4][2];
#pragma unroll
    for (int a = 0; a < 2; ++a)
#pragma unroll
        for (int b = 0; b < 2; ++b)
#pragma unroll
            for (int m = 0; m < 4; ++m)
#pragma unroll
                for (int n = 0; n < 2; ++n) acc[a][b][m][n] = (f32x4){0.f, 0.f, 0.f, 0.f};
    bf16x8 At[4][2], B0[2][2], B1[2][2];
    const char* cA = (const char*)g.A + (size_t)cur.pm * tstepA + (size_t)(cur.pn >> g.zshift) * g.zA; const char* cB = (const char*)g.Bt + (size_t)cur.pn * tstepB;
    PG8_STAGE(PG8_SB(0, 0), cB, voffB); PG8_STAGE(PG8_SB(0, 1), cB + hstepB, voffB); PG8_STAGE(PG8_SA(0, 0), cA, voffA); PG8_STAGE(PG8_SA(0, 1), cA + hstepA, voffA);
    if (wr == 1) PG8_BAR;
    PG8_WAIT_V(2); PG8_BAR;
    PG8_STAGE(PG8_SB(1, 0), cB + kstep, voffB); PG8_STAGE(PG8_SA(1, 0), cA + kstep, voffA); PG8_STAGE(PG8_SB(1, 1), cB + hstepB + kstep, voffB);
    PG8_WAIT_V(6); PG8_BAR;
    for (;;) {
        const bool has_next = S.next(ui + 1, nxt);
        const char* nA = has_next ? (const char*)g.A + (size_t)nxt.pm * tstepA + (size_t)(nxt.pn >> g.zshift) * g.zA : cA; const char* nB = has_next ? (const char*)g.Bt + (size_t)nxt.pn * tstepB : cB;
        for (int t = 0; t < nt; t += 2) {
            const bool last = (t == nt - 2);
            const char* a1 = cA + (size_t)(t + 1) * kstep;
            const char* a2 = last ? nA : cA + (size_t)(t + 2) * kstep; const char* b2 = last ? nB : cB + (size_t)(t + 2) * kstep;
            const char* a3 = a2 + kstep; const char* b3 = b2 + kstep;
            PG8_LDB(B0, 0, 0); PG8_LDB(B1, 0, 1); PG8_SCHED; PG8_LDA(At, 0, 0); PG8_STAGE(PG8_SA(1, 1), a1 + hstepA, voffA);
            PG8_WAIT_V(8); PG8_WAIT_L(0); PG8_BAR; PG8_MMA(0, 0, At, B0); PG8_MMA(0, 1, At, B1); PG8_BAR; PG8_SCHED;
            PG8_LDA(At, 0, 1); PG8_STAGE(PG8_SB(0, 0), b2, voffB); PG8_STAGE(PG8_SB(0, 1), b2 + hstepB, voffB); PG8_STAGE(PG8_SA(0, 0), a2, voffA);
            PG8_WAIT_V(8); PG8_WAIT_L(0); PG8_BAR; PG8_MMA(1, 0, At, B0); PG8_MMA(1, 1, At, B1); PG8_BAR; PG8_SCHED;
            PG8_LDB(B0, 1, 0); PG8_LDB(B1, 1, 1); PG8_SCHED; PG8_LDA(At, 1, 0); PG8_STAGE(PG8_SA(0, 1), a2 + hstepA, voffA);
            PG8_WAIT_V(8); PG8_WAIT_L(0); PG8_BAR; PG8_MMA(0, 0, At, B0); PG8_MMA(0, 1, At, B1); PG8_BAR; PG8_SCHED;
            PG8_LDA(At, 1, 1); PG8_STAGE(PG8_SB(1, 0), b3, voffB); PG8_STAGE(PG8_SB(1, 1), b3 + hstepB, voffB); PG8_STAGE(PG8_SA(1, 0), a3, voffA);
            PG8_WAIT_V(8); PG8_WAIT_L(0); PG8_BAR; PG8_MMA(1, 0, At, B0); PG8_MMA(1, 1, At, B1); PG8_BAR; PG8_SCHED;
        }
        if (wr == 0) PG8_BAR;
        E(acc, cur, wr, wc, fr, fq, EpiT::TAB ? tab + ui * 512 : tab);
        if (!has_next) break;
#pragma unroll
        for (int a = 0; a < 2; ++a)
#pragma unroll
            for (int b = 0; b < 2; ++b)
#pragma unroll
                for (int m = 0; m < 4; ++m)
#pragma unroll
                    for (int n = 0; n < 2; ++n) acc[a][b][m][n] = (f32x4){0.f, 0.f, 0.f, 0.f};
        cur = nxt; cA = nA; cB = nB; ++ui;
        if (wr == 1) PG8_BAR;
    }
    PG8_WAIT_V(0);
    PG8_BAR;
#undef PG8_SA
#undef PG8_SB
#undef PG8_STAGE
#undef PG8_LDA
#undef PG8_LDB
#undef PG8_MMA
#undef PG8_WAIT_V
#undef PG8_WAIT_L
#undef PG8_BAR
#undef PG8_SCHED
}
}

#define MFMA32(a, b, c) __builtin_amdgcn_mfma_f32_32x32x16_bf16((a), (b), (c), 0, 0, 0)
constexpr int ATT_BUF = 32768, ATT_VOFF = 13312, ATT_VP = 136;

template <int DK, int DV, int VAR>
__device__ __forceinline__ void attn_pass(LAS unsigned char* lds, const bf16_t* Qg, const bf16_t* Kg, const bf16_t* Vg, int ntiles, float cs, f32x16 (&O)[DV / 32], float& lsum, int wv) {
    constexpr int KP = DK * 2 + 16, KCH = DK / 8, NKC = 64 * KCH;
    const int tid = otid(), lane = tid & 63, wid = tid >> 6, l32 = lane & 31, hf = lane >> 5;
    bf16x8 qf[DK / 16];
    { const bf16_t* qrow = Qg + (size_t)(wid * 32 + l32) * DK + hf * 8;
#pragma unroll
      for (int kk = 0; kk < DK / 16; ++kk) qf[kk] = *(const bf16x8*)(qrow + kk * 16); }
    const int kc0 = tid, kc1 = tid + 512;
    const int kr0 = kc0 / KCH, kq0 = kc0 % KCH, kr1 = kc1 / KCH, kq1 = kc1 % KCH;
    const bool k1on = (kc1 < NKC);
    const int kp = (DV == 128 ? (wid >> 2) : ((wid >> 1) & 1)) * 16 + (lane & 15);
    const int vch = (DV == 128 ? (wid & 3) : (wid & 1)) * 4 + (lane >> 4);
    const bool von = (DV == 128) || (wid < 4);
    const bf16_t* kg0 = Kg + kr0 * DK + kq0 * 8; const bf16_t* kg1 = Kg + kr1 * DK + kq1 * 8;
    const bf16_t* vg0 = Vg + (size_t)(2 * kp) * DV + vch * 8;
    const unsigned kl0 = kr0 * KP + kq0 * 16, kl1 = kr1 * KP + kq1 * 16, vl0 = ATT_VOFF + (vch * 8) * ATT_VP + kp * 4;
    u32x4 ka0, ka1, va0, va1;
    { unsigned z0 = 0u; asm volatile("" : "+v"(z0)); ka1 = (u32x4){z0, z0, z0, z0}; } va0 = ka1; va1 = ka1; ka0 = ka1;
#define ATT_LOADK(t, r0, r1) do { r0 = *(const u32x4*)(kg0 + (size_t)(t) * 64 * DK); if (k1on) r1 = *(const u32x4*)(kg1 + (size_t)(t) * 64 * DK); } while (0)
#define ATT_LOADV(t, r0, r1) do { if (von) { r0 = *(const u32x4*)(vg0 + (size_t)(t) * 64 * DV); r1 = *(const u32x4*)(vg0 + (size_t)(t) * 64 * DV + DV); } } while (0)
#define ATT_STOREK(bi, r0, r1) do { LAS unsigned char* kb_ = lds + (bi) * ATT_BUF; *(LAS u32x4*)(kb_ + kl0) = r0; if (k1on) *(LAS u32x4*)(kb_ + kl1) = r1; } while (0)
#define ATT_STOREV(bi, r0, r1) do { if (von) { LAS unsigned char* vb_ = lds + (bi) * ATT_BUF + vl0; \
            *(LAS unsigned*)(vb_ + 0 * ATT_VP) = (r0.x & 0xffffu) | (r1.x << 16); *(LAS unsigned*)(vb_ + 1 * ATT_VP) = (r0.x >> 16) | (r1.x & 0xffff0000u); \
            *(LAS unsigned*)(vb_ + 2 * ATT_VP) = (r0.y & 0xffffu) | (r1.y << 16); *(LAS unsigned*)(vb_ + 3 * ATT_VP) = (r0.y >> 16) | (r1.y & 0xffff0000u); \
            *(LAS unsigned*)(vb_ + 4 * ATT_VP) = (r0.z & 0xffffu) | (r1.z << 16); *(LAS unsigned*)(vb_ + 5 * ATT_VP) = (r0.z >> 16) | (r1.z & 0xffff0000u); \
            *(LAS unsigned*)(vb_ + 6 * ATT_VP) = (r0.w & 0xffffu) | (r1.w << 16); *(LAS unsigned*)(vb_ + 7 * ATT_VP) = (r0.w >> 16) | (r1.w & 0xffff0000u); } } while (0)
#define ATT_QK(bi, S0, S1) do { const unsigned ka_ = (unsigned)(unsigned long long)(lds + (bi) * ATT_BUF + l32 * KP + hf * 16); \
        bf16x8 kfa[DK / 16], kfb[DK / 16]; \
          \
        if constexpr (DK == 64) { \
            asm volatile("ds_read_b128 %0, %8\n\tds_read_b128 %1, %8 offset:%9\n\tds_read_b128 %2, %8 offset:32\n\tds_read_b128 %3, %8 offset:%10\n\t" \
                         "ds_read_b128 %4, %8 offset:64\n\tds_read_b128 %5, %8 offset:%11\n\tds_read_b128 %6, %8 offset:96\n\tds_read_b128 %7, %8 offset:%12\n\ts_waitcnt lgkmcnt(0)" \
                         : "=&v"(kfa[0]), "=&v"(kfb[0]), "=&v"(kfa[1]), "=&v"(kfb[1]), "=&v"(kfa[2]), "=&v"(kfb[2]), "=&v"(kfa[3]), "=&v"(kfb[3]) \
                         : "v"(ka_), "n"(32 * KP), "n"(32 * KP + 32), "n"(32 * KP + 64), "n"(32 * KP + 96) : "memory"); \
        } else { \
            asm volatile("ds_read_b128 %0, %12\n\tds_read_b128 %1, %12 offset:%13\n\tds_read_b128 %2, %12 offset:32\n\tds_read_b128 %3, %12 offset:%14\n\t" \
                         "ds_read_b128 %4, %12 offset:64\n\tds_read_b128 %5, %12 offset:%15\n\tds_read_b128 %6, %12 offset:96\n\tds_read_b128 %7, %12 offset:%16\n\t" \
                         "ds_read_b128 %8, %12 offset:128\n\tds_read_b128 %9, %12 offset:%17\n\tds_read_b128 %10, %12 offset:160\n\tds_read_b128 %11, %12 offset:%18\n\ts_waitcnt lgkmcnt(0)" \
                         : "=&v"(kfa[0]), "=&v"(kfb[0]), "=&v"(kfa[1]), "=&v"(kfb[1]), "=&v"(kfa[2]), "=&v"(kfb[2]), "=&v"(kfa[3]), "=&v"(kfb[3]), "=&v"(kfa[DK / 16 - 2]), "=&v"(kfb[DK / 16 - 2]), "=&v"(kfa[DK / 16 - 1]), "=&v"(kfb[DK / 16 - 1]) \
                         : "v"(ka_), "n"(32 * KP), "n"(32 * KP + 32), "n"(32 * KP + 64), "n"(32 * KP + 96), "n"(32 * KP + 128), "n"(32 * KP + 160) : "memory"); \
        } \
        S0 = MFMA32(kfa[0], qf[0], negm); S1 = MFMA32(kfb[0], qf[0], negm);                \
        _Pragma("unroll") for (int kk = 1; kk < DK / 16; ++kk) { S0 = MFMA32(kfa[kk], qf[kk], S0); S1 = MFMA32(kfb[kk], qf[kk], S1); } } while (0)
#define ATT_VISSUE(vl, vh, base) asm volatile("ds_read_b64 %0, %16\n\tds_read_b64 %1, %16 offset:16\n\tds_read_b64 %2, %16 offset:32\n\tds_read_b64 %3, %16 offset:48\n\t" \
                         "ds_read_b64 %4, %16 offset:64\n\tds_read_b64 %5, %16 offset:80\n\tds_read_b64 %6, %16 offset:96\n\tds_read_b64 %7, %16 offset:112\n\t" \
                         "ds_read_b64 %8, %16 offset:%17\n\tds_read_b64 %9, %16 offset:%18\n\tds_read_b64 %10, %16 offset:%19\n\tds_read_b64 %11, %16 offset:%20\n\t" \
                         "ds_read_b64 %12, %16 offset:%21\n\tds_read_b64 %13, %16 offset:%22\n\tds_read_b64 %14, %16 offset:%23\n\tds_read_b64 %15, %16 offset:%24" \
                         : "=&v"(vl[0]), "=&v"(vh[0]), "=&v"(vl[1]), "=&v"(vh[1]), "=&v"(vl[2]), "=&v"(vh[2]), "=&v"(vl[3]), "=&v"(vh[3]), \
                           "=&v"(vl[4]), "=&v"(vh[4]), "=&v"(vl[5]), "=&v"(vh[5]), "=&v"(vl[6]), "=&v"(vh[6]), "=&v"(vl[7]), "=&v"(vh[7]) \
                         : "v"(base), "n"(32 * ATT_VP), "n"(32 * ATT_VP + 16), "n"(32 * ATT_VP + 32), "n"(32 * ATT_VP + 48), "n"(32 * ATT_VP + 64), "n"(32 * ATT_VP + 80), "n"(32 * ATT_VP + 96), "n"(32 * ATT_VP + 112) : "memory")
#define ATT_VWAIT(vl, vh) asm volatile("s_waitcnt lgkmcnt(0)" : "+v"(vl[0]), "+v"(vh[0]), "+v"(vl[1]), "+v"(vh[1]), "+v"(vl[2]), "+v"(vh[2]), "+v"(vl[3]), "+v"(vh[3]), \
                           "+v"(vl[4]), "+v"(vh[4]), "+v"(vl[5]), "+v"(vh[5]), "+v"(vl[6]), "+v"(vh[6]), "+v"(vl[7]), "+v"(vh[7]) :: "memory")
#define ATT_VFRAG(vl, vh, i) __builtin_bit_cast(bf16x8, (u32x4){vl[i].x, vl[i].y, vh[i].x, vh[i].y})
#define ATT_SOFTMAX_PV(bi, S0, S1) do { \
        const unsigned va_ = (unsigned)(unsigned long long)(lds + (bi) * ATT_BUF + ATT_VOFF + l32 * ATT_VP + 8 * hf); \
        u32x2 vl[8], vh[8]; \
        if (VAR != 4) ATT_VISSUE(vl, vh, va_);                        \
        float mx = fmaxf(fmaxf(S0[0], S1[0]), fmaxf(S0[1], S1[1])); \
        _Pragma("unroll") for (int i = 2; i < 16; i += 2) mx = fmaxf(mx, fmaxf(fmaxf(S0[i], S1[i]), fmaxf(S0[i + 1], S1[i + 1]))); \
        mx = xmax32(mx); \
        if (t == 0 || __builtin_amdgcn_ballot_w64(mx > 8.f) != 0ull) {          \
            const float dm = (t == 0) ? mx : fmaxf(mx, 0.f); \
            if (t != 0) { const float alpha = __builtin_amdgcn_exp2f(-dm); lrun *= alpha; _Pragma("unroll") for (int tt = 0; tt < DV / 32; ++tt) O[tt] *= alpha; } \
            mrun += dm; \
            _Pragma("unroll") for (int i = 0; i < 16; ++i) { negm[i] = -mrun; S0[i] -= dm; S1[i] -= dm; } } \
        f32x2 ps2 = {0.f, 0.f}; \
        _Pragma("unroll") for (int i = 0; i < 16; i += 2) { f32x2 a = {S0[i], S0[i + 1]}, c = {S1[i], S1[i + 1]}; \
            if (VAR != 2) { a.x = __builtin_amdgcn_exp2f(a.x); a.y = __builtin_amdgcn_exp2f(a.y); c.x = __builtin_amdgcn_exp2f(c.x); c.y = __builtin_amdgcn_exp2f(c.y); } ps2 += a; ps2 += c; \
            S0[i] = a.x; S0[i + 1] = a.y; S1[i] = c.x; S1[i + 1] = c.y; } \
        lrun += ps2.x + ps2.y; \
        bf16x8 pf[4]; \
        _Pragma("unroll") for (int j = 0; j < 4; ++j) { u32x4 w; \
            if (j < 2) { w.x = cvtpk(S0[8 * j + 0], S0[8 * j + 1]); w.y = cvtpk(S0[8 * j + 2], S0[8 * j + 3]); w.z = cvtpk(S0[8 * j + 4], S0[8 * j + 5]); w.w = cvtpk(S0[8 * j + 6], S0[8 * j + 7]); } \
            else { const int jj = j - 2; w.x = cvtpk(S1[8 * jj + 0], S1[8 * jj + 1]); w.y = cvtpk(S1[8 * jj + 2], S1[8 * jj + 3]); w.z = cvtpk(S1[8 * jj + 4], S1[8 * jj + 5]); w.w = cvtpk(S1[8 * jj + 6], S1[8 * jj + 7]); } \
            pf[j] = __builtin_bit_cast(bf16x8, w); } \
        if (VAR == 4) { _Pragma("unroll") for (int tt = 0; tt < DV / 32; ++tt) _Pragma("unroll") for (int j = 0; j < 4; ++j) O[tt][j] += __builtin_bit_cast(float, (int)pf[j][0]); } else { \
            ATT_VWAIT(vl, vh); \
            _Pragma("unroll") for (int j = 0; j < 4; ++j) O[0] = MFMA32(ATT_VFRAG(vl, vh, j), pf[j], O[0]); \
            _Pragma("unroll") for (int j = 0; j < 4; ++j) O[1] = MFMA32(ATT_VFRAG(vl, vh, 4 + j), pf[j], O[1]); \
            if constexpr (DV == 128) { const unsigned vc_ = va_ + 64 * ATT_VP; u32x2 wl[8], wh[8]; ATT_VISSUE(wl, wh, vc_); ATT_VWAIT(wl, wh); \
                _Pragma("unroll") for (int j = 0; j < 4; ++j) O[2] = MFMA32(ATT_VFRAG(wl, wh, j), pf[j], O[2]); \
                _Pragma("unroll") for (int j = 0; j < 4; ++j) O[3] = MFMA32(ATT_VFRAG(wl, wh, 4 + j), pf[j], O[3]); } } } while (0)
#pragma unroll
    for (int t = 0; t < DV / 32; ++t)
#pragma unroll
        for (int i = 0; i < 16; ++i) O[t][i] = 0.f;
    float mrun = 0.f, lrun = 0.f; (void)cs;
    f32x16 Sa0, Sa1, negm;
#pragma unroll
    for (int i = 0; i < 16; ++i) negm[i] = 0.f;
    __syncthreads();
    ATT_LOADK(0, ka0, ka1); ATT_LOADV(0, va0, va1);
    for (int t = 0; t < ntiles; ++t) {
        if (VAR != 1 || t < 2) { ATT_STOREK(t & 1, ka0, ka1); ATT_STOREV(t & 1, va0, va1); }
        __syncthreads();
        if (VAR != 1) { if (t + 1 < ntiles) { ATT_LOADK(t + 1, ka0, ka1); ATT_LOADV(t + 1, va0, va1); } }
        if (VAR != 3) { ATT_QK(t & 1, Sa0, Sa1); } else {
#pragma unroll
            for (int i = 0; i < 16; ++i) { Sa0[i] = (float)(t + i) * 1e-3f; Sa1[i] = (float)(t - i) * 1e-3f; } }
        ATT_SOFTMAX_PV(t & 1, Sa0, Sa1);
    }
    lsum = xsum32(lrun);
#undef ATT_LOADK
#undef ATT_LOADV
#undef ATT_STOREK
#undef ATT_STOREV
#undef ATT_QK
#undef ATT_SOFTMAX_PV
#undef ATT_VISSUE
#undef ATT_VWAIT
#undef ATT_VFRAG
}

template <int VAR> __device__ __forceinline__ void attn_unit_a(LAS unsigned char* lds, KP p, int l, int bh, int qb, int wv) {
    unsigned char* ws = p->ws;
    const int b = bh >> 2, h = bh & 3;
    const int tid_ = otid(); const int lane = tid_ & 63, wid = tid_ >> 6, l32 = lane & 31, hf = lane >> 5;
    const int ntiles = qb == 0 ? CTX / 64 : TK / 64;
    const int q0 = qb == 0 ? 0 : CTX + (qb - 1) * 256;
    const bf16_t* QA = (const bf16_t*)(ws + WS_QA); const bf16_t* KA = (const bf16_t*)(ws + WS_KA); const bf16_t* VA = (const bf16_t*)(ws + WS_VA);
    const float cs = 0.125f * 1.4426950408889634f;
    const float lam = ((const float*)(ws + WS_LAM))[l];
    const float lam_init = ((const float*)(ws + WS_LAM))[8 + l];
    f32x16 O[4]; float lsum;
    const bf16_t* Vg = VA + (size_t)(b * 4 + h) * TK * 128;
    attn_pass<64, 128, VAR>(lds, QA + ((size_t)(b * 8 + h * 2 + 0) * TK + q0) * 64, KA + (size_t)(b * 8 + h * 2 + 0) * TK * 64, Vg, ntiles, cs, O, lsum, wv);
    LAS unsigned* o0 = (LAS unsigned*)(lds + 65536 + wid * 8192) + lane;
    { const float inv = 1.f / lsum;
#pragma unroll
      for (int t = 0; t < 4; ++t)
#pragma unroll
          for (int i = 0; i < 8; ++i) o0[(t * 8 + i) * 64] = cvtpk(O[t][2 * i] * inv, O[t][2 * i + 1] * inv); }
    attn_pass<64, 128, VAR>(lds, QA + ((size_t)(b * 8 + h * 2 + 1) * TK + q0) * 64, KA + (size_t)(b * 8 + h * 2 + 1) * TK * 64, Vg, ntiles, cs, O, lsum, wv);
    const float inv1 = lam / lsum;
    float ss = 0.f;
#pragma unroll
    for (int t = 0; t < 4; ++t)
#pragma unroll
        for (int i = 0; i < 8; ++i) { const unsigned ow = o0[(t * 8 + i) * 64]; const float a = __uint_as_float(ow << 16) - O[t][2 * i] * inv1, c = __uint_as_float(ow & 0xffff0000u) - O[t][2 * i + 1] * inv1;
            O[t][2 * i] = a; O[t][2 * i + 1] = c; ss += a * a + c * c; }
    ss = xsum32(ss);
    const float rs = rsq(ss * (1.f / 128.f) + EPS) * (1.f - lam_init);
    const int row = (qb == 0 ? MX + b * CTX : b * SEQ + (qb - 1) * 256) + wid * 32 + l32;
    if (VAR != 0 && rs != 12345.f) return;
    bf16_t* yp = (bf16_t*)(ws + WS_Y) + (size_t)row * 2048 + h * 128 + 4 * hf;
    const float* gs = p->g_sub + l * 128 + 4 * hf;
#pragma unroll
    for (int t = 0; t < 4; ++t)
#pragma unroll
        for (int i4 = 0; i4 < 4; ++i4) { const f32x4 g = *(const f32x4*)(gs + 32 * t + 8 * i4);
            f32x4 v; v[0] = O[t][4 * i4] * rs * g[0]; v[1] = O[t][4 * i4 + 1] * rs * g[1]; v[2] = O[t][4 * i4 + 2] * rs * g[2]; v[3] = O[t][4 * i4 + 3] * rs * g[3];
            *(u32x2*)(yp + 32 * t + 8 * i4) = pack4(v); }
}
template <int VAR> __device__ __forceinline__ void attn_unit_b(LAS unsigned char* lds, KP p, int bh, int qb, int wv) {
    unsigned char* ws = p->ws;
    const int b = bh >> 3, h = bh & 7;
    const int tid_ = otid(); const int lane = tid_ & 63, wid = tid_ >> 6, l32 = lane & 31, hf = lane >> 5;
    const int ntiles = qb == 0 ? CTX / 64 : TK / 64;
    const int q0 = qb == 0 ? 0 : CTX + (qb - 1) * 256;
    const bf16_t* QB = (const bf16_t*)(ws + WS_QB); const bf16_t* KB = (const bf16_t*)(ws + WS_KB); const bf16_t* VB = (const bf16_t*)(ws + WS_VB);
    const float cs = 0.10206207261596577f * 1.4426950408889634f;
    f32x16 O[2]; float lsum;
    attn_pass<96, 64, VAR>(lds, QB + ((size_t)bh * TK + q0) * 96, KB + (size_t)bh * TK * 96, VB + (size_t)bh * TK * 64, ntiles, cs, O, lsum, wv);
    const float inv = 1.f / lsum;
    const int row = (qb == 0 ? MX + b * CTX : b * SEQ + (qb - 1) * 256) + wid * 32 + l32;
    if (VAR != 0 && inv != 12345.f) return;
    bf16_t* yp = (bf16_t*)(ws + WS_Y) + (size_t)row * 2048 + 512 + h * 64 + 4 * hf;
#pragma unroll
    for (int t = 0; t < 2; ++t)
#pragma unroll
        for (int i4 = 0; i4 < 4; ++i4) { f32x4 v; v[0] = O[t][4 * i4] * inv; v[1] = O[t][4 * i4 + 1] * inv; v[2] = O[t][4 * i4 + 2] * inv; v[3] = O[t][4 * i4 + 3] * inv;
            *(u32x2*)(yp + 32 * t + 8 * i4) = pack4(v); }
}
template <int VAR> __device__ __forceinline__ void attn_phase(LAS unsigned char* lds, KP p, int l, int wv) {
    const int G = gridDim.x, c = blockIdx.x;
    const int NU = (l == DEPTH - 1) ? 768 : 864;
    for (int u = c; u < NU; u += G) {
        if (u < 256) { const int xcd = u & 7, j = u >> 3; attn_unit_a<VAR>(lds, p, l, xcd * 4 + (j >> 3), 1 + (j & 7), wv); }
        else if (u < 768) { const int u2 = u - 256, r = u2 >> 8, c2 = u2 & 255, xcd = c2 & 7, j = c2 >> 3; attn_unit_b<VAR>(lds, p, xcd * 8 + (j >> 3) * 2 + r, 1 + (j & 7), wv); }
        else { const int u3 = u - 768; if (u3 < 32) attn_unit_a<VAR>(lds, p, l, u3, 0, wv); else attn_unit_b<VAR>(lds, p, u3 - 32, 0, wv); }
    }
}

__device__ __forceinline__ void tr_item(const float* W, int N, bf16_t* WT, int ldk, int row_off, int split, int shift, int ncopy, int copy_stride, LAS float* scr, int item, int lane) {
    const int nblk = N / 32, kb = item / nblk, nb = item % nblk, k0 = 64 * kb, n0 = 32 * nb;
    float wv_[32];
#pragma unroll
    for (int i = 0; i < 32; ++i) wv_[i] = W[(size_t)(k0 + 2 * i + (lane >> 5)) * N + n0 + (lane & 31)];
#pragma unroll
    for (int i = 0; i < 32; ++i) scr[(2 * i + (lane >> 5)) * 33 + (lane & 31)] = wv_[i];
    asm volatile("s_waitcnt lgkmcnt(0)" ::: "memory");
    const int c = lane & 7;
    const int rsh = row_off + n0 + (n0 >= split ? shift : 0);
#pragma unroll
    for (int j = 0; j < 4; ++j) { const int n = (lane >> 3) + 8 * j; const LAS float* s = scr + (8 * c) * 33 + n;
        u32x4 o; o.x = cvtpk(s[0 * 33], s[1 * 33]); o.y = cvtpk(s[2 * 33], s[3 * 33]); o.z = cvtpk(s[4 * 33], s[5 * 33]); o.w = cvtpk(s[6 * 33], s[7 * 33]);
        for (int cp = 0; cp < ncopy; ++cp) *(u32x4*)(WT + (size_t)(rsh + n) * ldk + cp * copy_stride + k0 + 8 * c) = o; }
    asm volatile("s_waitcnt lgkmcnt(0)" ::: "memory");
}
__device__ __forceinline__ void convert_weights(LAS unsigned char* lds, KP p, int l, int wv) {
    unsigned char* ws = p->ws;
    const int tid_ = otid(); const int lane = tid_ & 63, wid = tid_ >> 6;
    LAS float* scr = (LAS float*)(lds + wid * 8704);
    const int gw = blockIdx.x * 8 + wid, NGW = gridDim.x * 8;
    constexpr int I_IN = 16 * (DIN / 32), I_UQ = 6 * 24, I_UKV = 4 * 32, I_BR = 8 * 32, I_O = 16 * 32, I_F1 = 16 * 128, I_F2 = 64 * 32;
    constexpr int NIT = I_IN + I_UQ + I_UKV + 3 * I_BR + I_O + I_F1 + I_F2;
    const int BIG = 1 << 30;
    for (int it = gw; it < NIT; it += NGW) {
        int r = it;
        if (r < I_IN) { tr_item(p->w_in + (size_t)l * DM * DIN, DIN, (bf16_t*)(ws + WS_WIN), DM, 0, NGATE0, NPM - NGATE0, 1, 0, scr, r, lane); continue; } r -= I_IN;
        if (r < I_UQ) { const int nb = r % 24, hh = nb / 3, part = nb % 3, dest = part < 2 ? (2 * hh + part) * 32 : 512 + 32 * hh;
            tr_item(p->w_uq + (size_t)l * 384 * 768, 768, (bf16_t*)(ws + WS_WUQ), 384, dest - 32 * nb, BIG, 0, 1, 0, scr, r, lane); continue; } r -= I_UQ;
        if (r < I_UKV) { tr_item(p->w_ukv + (size_t)l * 256 * 1024, 1024, (bf16_t*)(ws + WS_WUKV), 256, 0, BIG, 0, 1, 0, scr, r, lane); continue; } r -= I_UKV;
        if (r < 3 * I_BR) { const int z3 = r / I_BR, z = z3 == 2 ? 3 : z3; tr_item(p->w_branch + ((size_t)l * 4 + z) * 512 * 1024, 1024, (bf16_t*)(ws + WS_WBR), 512, z * 1024, BIG, 0, 1, 0, scr, r % I_BR, lane); continue; } r -= 3 * I_BR;
        if (r < I_O) { tr_item(p->w_o + (size_t)l * DM * DM, DM, (bf16_t*)(ws + WS_WO4), 4096, 0, BIG, 0, 1, 0, scr, r, lane); continue; } r -= I_O;
        if (r < I_F1) { tr_item(p->w_ff1 + (size_t)l * DM * DFF, DFF, (bf16_t*)(ws + WS_WF1), DM, 0, BIG, 0, 1, 0, scr, r, lane); continue; } r -= I_F1;
        tr_item(p->w_ff2 + (size_t)l * DFF * DM, DM, (bf16_t*)(ws + WS_WF2), DFF, 0, BIG, 0, 1, 0, scr, r, lane);
    }
    { const int gt = blockIdx.x * 512 + otid(), NT = gridDim.x * 512; u32x4* z = (u32x4*)((bf16_t*)(ws + WS_WIN) + (size_t)NGATE0 * DM);
      unsigned z0 = 0u; asm volatile("" : "+v"(z0));
      for (int i = gt; i < (NPM - NGATE0) * DM / 8; i += NT) z[i] = (u32x4){z0, z0, z0, z0}; }
    { const float* wp = p->w_pool + (size_t)l * 4 * 128 * 128; const float* sp = p->s_pool + l * 512; const float* wb = p->w_branch + ((size_t)l * 4 + 2) * 512 * 1024;
      bf16_t* dst = (bf16_t*)(ws + WS_WBR) + (size_t)2048 * 512;
      LAS float* As = (LAS float*)lds;
      const int tid = otid();
      int gcur = -1;
      for (int it = blockIdx.x; it < 4 * 256; it += gridDim.x) {
          const int gi = it >> 8, d0 = (it & 255) * 4;
          if (gi != gcur) { __syncthreads();
              for (int i = tid; i < 128 * 128; i += 512) { const int cl = i >> 7, j = i & 127; As[cl * 129 + j] = wp[(size_t)gi * 16384 + i] * sp[gi * 128 + j]; }
              __syncthreads(); gcur = gi; }
          const int cl = tid & 127, d = d0 + __builtin_amdgcn_readfirstlane(tid >> 7);
          const float* br = wb + (size_t)gi * 128 * 1024 + d;
          float a = 0.f;
#pragma unroll 8
          for (int j = 0; j < 128; ++j) a += As[cl * 129 + j] * br[(size_t)j * 1024];
          dst[(size_t)d * 512 + gi * 128 + cl] = (bf16_t)(cvtpk(a, 0.f) & 0xffffu);
      }
      __syncthreads(); }
}
__device__ __forceinline__ void mod_phase(LAS unsigned char* lds, KP p, int wv) {
    LAS float* sv = (LAS float*)lds;
    LAS float* red = (LAS float*)(lds + 9 * 1024 * 4);
    const int tid = otid(), lane = tid & 63, wid = tid >> 6;
    for (int i = tid; i < 9 * 1024; i += 512) { const float v = i < 8192 ? p->c[i] : p->c_ctx[i - 8192]; sv[i] = v / (1.f + __expf(-v)); }
    __syncthreads();
    float* mod = (float*)(p->ws + WS_MOD);
    for (int it = blockIdx.x; it < DEPTH * 96; it += gridDim.x) {
        const int l = it / 96, n0 = (it % 96) * 64;
        const float* W = p->w_mod + (size_t)l * DM * 6144 + n0 + lane;
        float a[9];
#pragma unroll
        for (int r = 0; r < 9; ++r) a[r] = 0.f;
        for (int k = wid * 128; k < wid * 128 + 128; k += 8) { float w[8];
#pragma unroll
            for (int j = 0; j < 8; ++j) w[j] = W[(size_t)(k + j) * 6144];
#pragma unroll
            for (int r = 0; r < 9; ++r) { const f32x4 s0 = *(const LAS f32x4*)(sv + r * 1024 + k), s1 = *(const LAS f32x4*)(sv + r * 1024 + k + 4);
                a[r] += ((s0[0] * w[0] + s0[1] * w[1]) + (s0[2] * w[2] + s0[3] * w[3])) + ((s1[0] * w[4] + s1[1] * w[5]) + (s1[2] * w[6] + s1[3] * w[7])); } }
#pragma unroll
        for (int r = 0; r < 9; ++r) red[(wid * 9 + r) * 64 + lane] = a[r];
        __syncthreads();
        for (int o = tid; o < 9 * 64; o += 512) { const int r = o >> 6, n = o & 63; float s = p->b_mod[l * 6144 + n0 + n];
#pragma unroll
            for (int w = 0; w < 8; ++w) s += red[(w * 9 + r) * 64 + n];
            mod[((size_t)l * 9 + r) * 6144 + n0 + n] = s;
            const int nn = n0 + n, ch = nn >> 10, cc = nn & 1023;
            if (ch == 1) ((float*)(p->ws + WS_VM))[(((size_t)l * 2 + 0) * 9 + r) * DM + cc] = p->g1[l * DM + cc] * (1.f + s);
            if (ch == 4) ((float*)(p->ws + WS_VM))[(((size_t)l * 2 + 1) * 9 + r) * DM + cc] = p->g2[l * DM + cc] * (1.f + s); }
        __syncthreads();
    }
}
__device__ __forceinline__ void bias_gemv(LAS unsigned char* lds, KP p, int l, int wv) {
    LAS float* sv = (LAS float*)lds;
    LAS float* red = (LAS float*)(lds + 2 * 9 * 1024 * 4);
    const int tid = otid(), lane = tid & 63, wid = tid >> 6;
    const float* mod = (const float*)(p->ws + WS_MOD) + (size_t)l * 9 * 6144;
    __syncthreads();
    for (int i = tid; i < 2 * 9 * 1024; i += 512) { const int which = i / 9216, r = (i % 9216) >> 10, k = i & 1023; sv[i] = mod[(size_t)r * 6144 + (which ? 3 : 0) * 1024 + k]; }
    __syncthreads();
    constexpr int IT1 = (DIN + 63) / 64, IT2 = DFF / 64;
    for (int it = blockIdx.x; it < IT1 + IT2; it += gridDim.x) {
        const bool second = it >= IT1; const int n0 = (second ? it - IT1 : it) * 64; const int N = second ? DFF : DIN;
        const int col = n0 + lane; const bool on = col < N;
        const float* W = (second ? p->w_ff1 + (size_t)l * DM * DFF : p->w_in + (size_t)l * DM * DIN) + (on ? col : 0);
        const LAS float* s9 = sv + (second ? 9216 : 0);
        float a[9];
#pragma unroll
        for (int r = 0; r < 9; ++r) a[r] = 0.f;
        for (int k = wid * 128; k < wid * 128 + 128; k += 8) { float w[8];
#pragma unroll
            for (int j = 0; j < 8; ++j) w[j] = W[(size_t)(k + j) * N];
#pragma unroll
            for (int r = 0; r < 9; ++r) { const f32x4 s0 = *(const LAS f32x4*)(s9 + r * 1024 + k), s1 = *(const LAS f32x4*)(s9 + r * 1024 + k + 4);
                a[r] += ((s0[0] * w[0] + s0[1] * w[1]) + (s0[2] * w[2] + s0[3] * w[3])) + ((s1[0] * w[4] + s1[1] * w[5]) + (s1[2] * w[6] + s1[3] * w[7])); } }
#pragma unroll
        for (int r = 0; r < 9; ++r) red[(wid * 9 + r) * 64 + lane] = a[r];
        __syncthreads();
        for (int o = tid; o < 9 * 64; o += 512) { const int r = o >> 6, n = o & 63; const int c = n0 + n;
            if (c < N) { float s = 0.f;
#pragma unroll
                for (int w = 0; w < 8; ++w) s += red[(w * 9 + r) * 64 + n];
                if (second) ((float*)(p->ws + WS_BIAS2))[(size_t)r * DFF + c] = s;
                else ((float*)(p->ws + WS_BIAS1))[(size_t)r * NIN + (c < NGATE0 ? c : c + (NPM - NGATE0))] = s; } }
        __syncthreads();
    }
}
__device__ __forceinline__ void init_h(KP p, int wv) {
    const int tid_ = otid(); const int lane = tid_ & 63, wid = tid_ >> 6;
    const int gw = blockIdx.x * 8 + wid, NGW = gridDim.x * 8;
    const float* vm = (const float*)(p->ws + WS_VM);
    bf16_t* H = (bf16_t*)(p->ws + WS_H); float* part = (float*)(p->ws + WS_PART);
    for (int row = gw; row < MT; row += NGW) {
        const float* xr = row < MX ? p->x + (size_t)row * DM : p->ctx + (size_t)(row - MX) * DM;
        const float* vr = vm + (size_t)(row < MX ? (row >> 11) : 8) * DM;
        float s = 0.f;
#pragma unroll
        for (int j = 0; j < 4; ++j) { const int col = 4 * lane + 256 * j; const f32x4 v = *(const f32x4*)(xr + col); s += (v[0] * v[0] + v[1] * v[1]) + (v[2] * v[2] + v[3] * v[3]);
            *(u32x2*)(H + (size_t)row * DM + col) = pack4(v * *(const f32x4*)(vr + col)); }
        s = wave_sum(s);
        if (lane < 16) part[(size_t)row * 16 + lane] = lane == 0 ? s : 0.f;
    }
}
__device__ __forceinline__ void norm_phase(KP p, int l, int chunk, int nrows, int wv) {
    const int tid_ = otid(); const int lane = tid_ & 63, wid = tid_ >> 6;
    const int gw = blockIdx.x * 8 + wid, NGW = gridDim.x * 8;
    const float* g = (chunk == 0 ? p->g1 : p->g2) + l * DM;
    const float* mod = (const float*)(p->ws + WS_MOD) + (size_t)l * 9 * 6144;
    bf16_t* H = (bf16_t*)(p->ws + WS_H);
    for (int row = gw; row < nrows; row += NGW) {
        const float* xr = row < MX ? p->out + (size_t)row * DM : (const float*)(p->ws + WS_XC) + (size_t)(row - MX) * DM;
        const float* mr = mod + (size_t)(row < MX ? (row >> 11) : 8) * 6144 + chunk * 1024;
        f32x4 v[4]; float s = 0.f;
#pragma unroll
        for (int j = 0; j < 4; ++j) { v[j] = *(const f32x4*)(xr + 4 * lane + 256 * j); s += (v[j][0] * v[j][0] + v[j][1] * v[j][1]) + (v[j][2] * v[j][2] + v[j][3] * v[j][3]); }
        const float rs = rsq(wave_sum(s) * (1.f / DM) + EPS);
#pragma unroll
        for (int j = 0; j < 4; ++j) { const int col = 4 * lane + 256 * j; const f32x4 gv = *(const f32x4*)(g + col), sh = *(const f32x4*)(mr + col), sc = *(const f32x4*)(mr + 1024 + col);
            f32x4 o = (v[j] * rs * gv) * (1.f + sc) + sh; *(u32x2*)(H + (size_t)row * DM + col) = pack4(o); }
    }
}

__device__ __forceinline__ void prep1_phase(KP p, int l, int wv) {
    unsigned char* ws = p->ws;
    const int tid_ = otid(); const int lane = tid_ & 63, wid = tid_ >> 6;
    const int gw = blockIdx.x * 8 + wid, NGW = gridDim.x * 8;
    const bf16_t* __restrict__ Pm = (const bf16_t*)(ws + WS_R1);
    bf16_t* __restrict__ QA = (bf16_t*)(ws + WS_QA); bf16_t* __restrict__ KA = (bf16_t*)(ws + WS_KA); bf16_t* __restrict__ VA = (bf16_t*)(ws + WS_VA);
    bf16_t* __restrict__ CQ = (bf16_t*)(ws + WS_CQ); bf16_t* __restrict__ CKV = (bf16_t*)(ws + WS_CKV); bf16_t* __restrict__ KR = (bf16_t*)(ws + WS_KR); bf16_t* __restrict__ Y = (bf16_t*)(ws + WS_Y);
    f32x8 invA, invB, gq, gk, gcq, gckv, gkr;
#pragma unroll
    for (int e = 0; e < 8; ++e) { invA[e] = (lane & 1) ? INVA_REV[8 + e] : INVA_REV[e]; invB[e] = INVB_REV[e];
        gq[e] = p->gq_a[l * 64 + (lane & 7) * 8 + e] * CS_A; gk[e] = p->gk_a[l * 64 + (lane & 7) * 8 + e];
        gcq[e] = lane < 48 ? p->g_cq[l * 384 + 8 * lane + e] : 0.f; gckv[e] = lane < 32 ? p->g_ckv[l * 256 + 8 * lane + e] : 0.f; gkr[e] = lane < 4 ? p->gk_b[l * 96 + 64 + 8 * lane + e] : 0.f; }
    const float* wcv = p->w_conv + (size_t)l * 3 * 512 + 8 * lane;
#pragma unroll 2
    for (int row = gw; row < MT; row += NGW) {
        const bool isx = row < MX;
        const int b = isx ? (row >> 11) : ((row - MX) >> 8);
        const int t = isx ? (row & 2047) : ((row - MX) & 255);
        const int S = isx ? SEQ : CTX;
        const int arow = isx ? CTX + t : t;
        const bf16_t* pr = Pm + (size_t)row * NPM;
        f32x8 csA, snA, csB, snB;
        if (isx) { const float posA = (float)((lane & 2) ? (t & 63) : (t >> 6)); const float posB = (float)((lane & 1) ? (t & 63) : (t >> 6));
#pragma unroll
            for (int e = 0; e < 8; ++e) { const float a = posA * invA[e]; csA[e] = __builtin_amdgcn_cosf(a); snA[e] = __builtin_amdgcn_sinf(a); const float bq = posB * invB[e]; csB[e] = __builtin_amdgcn_cosf(bq); snB[e] = __builtin_amdgcn_sinf(bq); } }
        const u32x4 rq = ld16(pr + C_Q + 8 * lane), rk = ld16(pr + C_K + 8 * lane);
        const u32x4 rcq = ld16(pr + C_CQ + 8 * min(lane, 47)), rckv = ld16(pr + C_CKV + 8 * (lane & 31)), rkr = ld16(pr + C_KR + 8 * (lane & 3));
        const u32x4 rpb = ld16(pr + C_PB + 8 * lane), rpc = ld16(pr + C_PC + 8 * lane), rpx = ld16(pr + C_PX + 8 * lane);
        const bf16_t* prm = (t > 0) ? pr - NPM : pr; const bf16_t* prp = (t < S - 1) ? pr + NPM : pr;
        const float fm = (t > 0) ? 1.f : 0.f, fp = (t < S - 1) ? 1.f : 0.f;
        const u32x4 rpcm = ld16(prm + C_PC + 8 * lane), rpxm = ld16(prm + C_PX + 8 * lane), rpcp = ld16(prp + C_PC + 8 * lane), rpxp = ld16(prp + C_PX + 8 * lane);
        const int hw = 1 << (lane >> 4); const int lo = max(t - hw, 0), hi = min(t + hw, S);
        const bf16_t* pp = pr + C_POOL + 8 * lane;
        u32x4 pw[16]; float pvf[16];
#pragma unroll
        for (int j = 0; j < 16; ++j) { const int o = j - 8; const int tt = t + o; const bool v = (o >= -hw) && (o < hw) && (tt >= 0) && (tt < S); pw[j] = ld16(pp + (ptrdiff_t)(v ? o : 0) * NPM); pvf[j] = v ? 1.f : 0.f; }
        const u32x4 rpu = ld16(pp);
        asm volatile("" ::: "memory");
#pragma unroll
        for (int which = 0; which < 2; ++which) {
            f32x8 v = unpack8(which == 0 ? rq : rk);
            float ss = sum8(v); ss += shx<1>(ss); ss += shx<2>(ss); ss += shx<4>(ss);
            const float rs = rsq(ss * (1.f / 64.f) + EPS);
#pragma unroll
            for (int e = 0; e < 8; ++e) v[e] = v[e] * rs * (which == 0 ? gq[e] : gk[e]);
            if (isx) {
#pragma unroll
                for (int e = 0; e < 8; ++e) { const float o = shx<4>(v[e]); v[e] = (lane & 4) ? (o * snA[e] + v[e] * csA[e]) : (v[e] * csA[e] - o * snA[e]); } }
            bf16_t* dst = (which == 0 ? QA : KA) + ((size_t)(b * 8 + (lane >> 3)) * TK + arow) * 64 + (lane & 7) * 8;
            *(u32x4*)dst = pack8(v);
        }
        { f32x8 v = unpack8(rcq);
          if (lane >= 48) {
#pragma unroll
              for (int e = 0; e < 8; ++e) v[e] = 0.f; }
          const float rs = rsq(wave_sum(sum8(v)) * (1.f / 384.f) + EPS);
          if (lane < 48) {
#pragma unroll
              for (int e = 0; e < 8; ++e) v[e] = v[e] * rs * gcq[e];
              *(u32x4*)(CQ + (size_t)row * 384 + 8 * lane) = pack8(v); } }
        { f32x8 v = unpack8(rckv);
          if (lane >= 32) {
#pragma unroll
              for (int e = 0; e < 8; ++e) v[e] = 0.f; }
          const float rs = rsq(wave_sum(sum8(v)) * (1.f / 256.f) + EPS);
          if (lane < 32) {
#pragma unroll
              for (int e = 0; e < 8; ++e) v[e] = v[e] * rs * gckv[e];
              *(u32x4*)(CKV + (size_t)row * 256 + 8 * lane) = pack8(v); } }
        { f32x8 v = unpack8(rkr);
          float ss = sum8(v); ss += shx<1>(ss); ss += shx<2>(ss);
          const float rs = rsq(ss * (1.f / 32.f) + EPS);
#pragma unroll
          for (int e = 0; e < 8; ++e) v[e] = v[e] * rs * p->gk_b[l * 96 + 64 + 8 * (lane & 3) + e];
          if (isx) {
#pragma unroll
              for (int e = 0; e < 8; ++e) { const float o = shx<2>(v[e]); v[e] = (lane & 2) ? (o * snB[e] + v[e] * csB[e]) : (v[e] * csB[e] - o * snB[e]); } }
          if (lane < 4) *(u32x4*)(KR + (size_t)row * 32 + 8 * lane) = pack8(v); }
        { f32x8 sum;
#pragma unroll
          for (int e = 0; e < 8; ++e) sum[e] = 0.f;
#pragma unroll
          for (int j = 0; j < 16; ++j) sum += unpack8(pw[j]) * pvf[j];
          const float inv = 1.f / (float)(hi - lo);
          *(u32x4*)(Y + (size_t)row * 2048 + 1024 + 8 * lane) = pack8(sum * inv - unpack8(rpu)); }
        { const f32x8 pb = unpack8(rpb);
          const f32x8 uc = unpack8(rpc) * unpack8(rpx);
          const f32x8 um = unpack8(rpcm) * unpack8(rpxm) * fm, up = unpack8(rpcp) * unpack8(rpxp) * fp;
          f32x8 y;
#pragma unroll
          for (int e = 0; e < 8; ++e) y[e] = pb[e] * (um[e] * wcv[e] + uc[e] * wcv[512 + e] + up[e] * wcv[1024 + e]);
          *(u32x4*)(Y + (size_t)row * 2048 + 1536 + 8 * lane) = pack8(y); }
    }
}
__device__ __forceinline__ void prep2_phase(KP p, int l, int wv) {
    unsigned char* ws = p->ws;
    const int tid_ = otid(); const int lane = tid_ & 63, wid = tid_ >> 6;
    const int gw = blockIdx.x * 8 + wid, NGW = gridDim.x * 8;
    const bf16_t* __restrict__ QBR = (const bf16_t*)(ws + WS_QBR); const bf16_t* __restrict__ KVR = (const bf16_t*)(ws + WS_KVR); const bf16_t* __restrict__ KR = (const bf16_t*)(ws + WS_KR);
    bf16_t* __restrict__ QB = (bf16_t*)(ws + WS_QB); bf16_t* __restrict__ KB = (bf16_t*)(ws + WS_KB); bf16_t* __restrict__ VB = (bf16_t*)(ws + WS_VB);
    const int h = lane >> 3, sub = lane & 7;
    f32x8 gqn, gkn; f32x4 gqr, invB;
#pragma unroll
    for (int e = 0; e < 8; ++e) { gqn[e] = p->gq_b[l * 96 + sub * 8 + e]; gkn[e] = p->gk_b[l * 96 + sub * 8 + e]; }
#pragma unroll
    for (int e = 0; e < 4; ++e) { gqr[e] = p->gq_b[l * 96 + 64 + sub * 4 + e]; invB[e] = (sub & 1) ? INVB_REV[4 + e] : INVB_REV[e]; }
    for (int row0 = gw; row0 < MT; row0 += 3 * NGW) {
        u32x4 rqn[3], rkn[3], rvv[3]; u32x2 rqr[3], rkr[3];
#pragma unroll
        for (int q = 0; q < 3; ++q) { const int row = (row0 + q * NGW < MT) ? row0 + q * NGW : row0;
            const bf16_t* qr = QBR + (size_t)row * 768 + h * 96; const bf16_t* kr = KVR + (size_t)row * 1024 + h * 128;
            rqn[q] = ld16(qr + sub * 8); rqr[q] = *(const u32x2*)(qr + 64 + sub * 4); rkn[q] = ld16(kr + sub * 8); rvv[q] = ld16(kr + 64 + sub * 8); rkr[q] = *(const u32x2*)(KR + (size_t)row * 32 + sub * 4); }
        asm volatile("" ::: "memory");
#pragma unroll
        for (int q = 0; q < 3; ++q) { const int row = row0 + q * NGW;
            if (row < MT) {
                const bool isx = row < MX;
                const int b = isx ? (row >> 11) : ((row - MX) >> 8);
                const int t = isx ? (row & 2047) : ((row - MX) & 255);
                const int arow = isx ? CTX + t : t;
                const size_t ar = (size_t)(b * 8 + h) * TK + arow;
                f32x8 vn = unpack8(rqn[q]);
                f32x4 vr = unpack4(rqr[q]);
                float sn_ = sum8(vn); sn_ += shx<1>(sn_); sn_ += shx<2>(sn_); sn_ += shx<4>(sn_);
                float sr_ = (vr[0] * vr[0] + vr[1] * vr[1]) + (vr[2] * vr[2] + vr[3] * vr[3]); sr_ += shx<1>(sr_); sr_ += shx<2>(sr_); sr_ += shx<4>(sr_);
                const float rn = rsq(sn_ * (1.f / 64.f) + EPS), rr = rsq(sr_ * (1.f / 32.f) + EPS);
#pragma unroll
                for (int e = 0; e < 8; ++e) vn[e] = vn[e] * rn * gqn[e];
#pragma unroll
                for (int e = 0; e < 4; ++e) vr[e] = vr[e] * rr * gqr[e];
                if (isx) { const float pos = (float)((sub & 2) ? (t & 63) : (t >> 6));
#pragma unroll
                    for (int e = 0; e < 4; ++e) { const float a = pos * invB[e]; const float cs = __builtin_amdgcn_cosf(a), sn = __builtin_amdgcn_sinf(a); const float o = shx<4>(vr[e]);
                        vr[e] = (sub & 4) ? (o * sn + vr[e] * cs) : (vr[e] * cs - o * sn); } }
                *(u32x4*)(QB + ar * 96 + sub * 8) = pack8(vn);
                *(u32x2*)(QB + ar * 96 + 64 + sub * 4) = pack4(vr);
                f32x8 kn = unpack8(rkn[q]);
                float sk = sum8(kn); sk += shx<1>(sk); sk += shx<2>(sk); sk += shx<4>(sk);
                const float rk = rsq(sk * (1.f / 64.f) + EPS);
#pragma unroll
                for (int e = 0; e < 8; ++e) kn[e] = kn[e] * rk * gkn[e];
                *(u32x4*)(KB + ar * 96 + sub * 8) = pack8(kn);
                *(u32x2*)(KB + ar * 96 + 64 + sub * 4) = rkr[q];
                *(u32x4*)(VB + ar * 64 + sub * 8) = rvv[q];
            } }
    }
}

__device__ __forceinline__ void presum_phase(KP p, int nrows, int wv) {
    const bf16_t* __restrict__ Gm = (const bf16_t*)(p->ws + WS_R1);
    bf16_t* __restrict__ Sm = (bf16_t*)(p->ws + WS_MIX);
    const int gt = blockIdx.x * 512 + otid(), NT = gridDim.x * 512;
    const int total = nrows * 128;
    for (int i = gt; i < total; i += 4 * NT) {
        u32x4 a[4], b[4], c[4], d[4]; int idx[4];
#pragma unroll
        for (int q = 0; q < 4; ++q) { idx[q] = (i + q * NT < total) ? i + q * NT : i; const bf16_t* g = Gm + (size_t)(idx[q] >> 7) * 4096 + (idx[q] & 127) * 8;
            a[q] = ld16(g); b[q] = ld16(g + 1024); c[q] = ld16(g + 2048); d[q] = ld16(g + 3072); }
        asm volatile("" ::: "memory");
#pragma unroll
        for (int q = 0; q < 4; ++q) *(u32x4*)(Sm + (size_t)(idx[q] >> 7) * DM + (idx[q] & 127) * 8) = pack8((unpack8(a[q]) + unpack8(b[q])) + (unpack8(c[q]) + unpack8(d[q])));
    }
}

#define XB_TMO      128
#define XB_XCNT(j)  (256  + 64 * (j))
#define XB_XSUB(j)  (1280 + 64 * (j))
#define XB_XGEN(j)  (2304 + 64 * (j))
#define XB_TOP      3328
#define XB_TOPGEN   3392
#define XCD_BAR_WORDS 3456
#define XB_SPIN_CAP (1u << 22)
__device__ __forceinline__ unsigned xb_ld(unsigned* p)              { return __hip_atomic_load(p, __ATOMIC_RELAXED, __HIP_MEMORY_SCOPE_AGENT); }
__device__ __forceinline__ unsigned xb_add(unsigned* p, unsigned v) { return __hip_atomic_fetch_add(p, v, __ATOMIC_RELAXED, __HIP_MEMORY_SCOPE_AGENT); }
__device__ __forceinline__ unsigned xb_xcc_id() { return (unsigned)__builtin_amdgcn_s_getreg((3 << 11) | 20) & 0xFu; }
#define XB_SPIN(cond, bar) do { unsigned _sp = 0; while (cond) { __builtin_amdgcn_s_sleep(1); \
    if ((++_sp & 255u) == 0u) { if (xb_ld(&(bar)[XB_TMO])) break; if (_sp > XB_SPIN_CAP) { atomicAdd(&(bar)[XB_TMO], 1u); break; } } } } while (0)
struct XcdBarrier { unsigned* bar; unsigned x; volatile LAS unsigned* st; };
__device__ __forceinline__ XcdBarrier xcd_barrier_post(unsigned* bar, volatile LAS unsigned* st) {
    XcdBarrier b; b.bar = bar; b.x = xb_xcc_id(); b.st = st;
    if (threadIdx.x == 0) (void)xb_add(&bar[XB_XCNT(b.x)], 1u);
    return b;
}
__device__ __forceinline__ void xcd_barrier_complete(unsigned* bar, unsigned x, unsigned& nloc, unsigned& nx) {
    const unsigned G = gridDim.x * gridDim.y * gridDim.z;
    unsigned sum, cnt, mine, sp = 0u;
    for (;;) {
        sum = 0u; cnt = 0u; mine = 0u;
#pragma unroll
        for (unsigned j = 0; j < 16; ++j) { const unsigned c = xb_ld(&bar[XB_XCNT(j)]); sum += c; cnt += (c > 0u) ? 1u : 0u; mine = (j == x) ? c : mine; }
        if (sum == G) break;
        __builtin_amdgcn_s_sleep(1);
        if ((++sp & 255u) == 0u) { if (xb_ld(&bar[XB_TMO])) break; if (sp > XB_SPIN_CAP) { atomicAdd(&bar[XB_TMO], 1u); break; } }
    }
    nloc = mine > 0u ? mine : 1u; nx = cnt > 0u ? cnt : 1u;
}
__device__ __forceinline__ void xcd_barrier(const XcdBarrier& b, int wv) {
    asm volatile("s_waitcnt vmcnt(0)" ::: "memory");
    __syncthreads();
    if (otid() == 0) {
        unsigned* bar = b.bar; unsigned bx = b.x;
        asm volatile("" : "+s"(bar), "+s"(bx));
        __builtin_amdgcn_s_waitcnt(0);
        unsigned nloc = b.st[0], nx = b.st[1];
        if (nloc == 0u) { xcd_barrier_complete(bar, bx, nloc, nx); b.st[0] = nloc; b.st[1] = nx; }
        const unsigned old = xb_add(&bar[XB_XSUB(bx)], 1u);
        const unsigned gen = old / nloc;
        if (old + 1u == (gen + 1u) * nloc) {
            __builtin_amdgcn_fence(__ATOMIC_RELEASE, "agent");
            asm volatile("s_waitcnt vmcnt(0)" ::: "memory");
            const unsigned og = xb_add(&bar[XB_TOP], 1u);
            const unsigned tg = og / nx;
            if (og + 1u == (tg + 1u) * nx) xb_add(&bar[XB_TOPGEN], 1u);
            else XB_SPIN(xb_ld(&bar[XB_TOPGEN]) == tg, bar);
            __builtin_amdgcn_fence(__ATOMIC_ACQUIRE, "agent");
            xb_add(&bar[XB_XGEN(bx)], 1u);
            asm volatile("s_waitcnt vmcnt(0)" ::: "memory");
        } else {
            XB_SPIN(xb_ld(&bar[XB_XGEN(bx)]) == gen, bar);
            __builtin_amdgcn_fence(__ATOMIC_ACQUIRE, "agent");
            asm volatile("s_waitcnt vmcnt(0)" ::: "memory");
        }
    }
    __syncthreads();
}

constexpr int N_PHASES = 1 + DEPTH * 10;
constexpr int ATT_PROBE = -1;
constexpr int REP0 = 1, REP1 = 1, REP2 = 1, REP3 = 1, REP4 = 1, REP5 = 1, REP6 = 1, REP7 = 1, REP8 = 1, REP9 = 1;

#define PHASE_BEGIN KP p = (KP)__builtin_amdgcn_kernarg_segment_ptr(); asm volatile("" : "+s"(p)); unsigned char* ws = p->ws; const int G = gridDim.x, c = obid(); (void)G; (void)c; (void)ws;
__global__ void __launch_bounds__(512) mega(Params p_unused, int ph_lo, int ph_hi) {
    extern __shared__ __attribute__((aligned(16))) unsigned char lds_raw[];
    LAS unsigned char* lds = (LAS unsigned char*)lds_raw;
    cg::grid_group grid = cg::this_grid();
    const int wv = __builtin_amdgcn_readfirstlane((int)(threadIdx.x >> 6));
    { volatile LAS unsigned* st0 = (volatile LAS unsigned*)(lds + 131072); if (threadIdx.x == 0) { st0[0] = 0u; st0[1] = 0u; } __syncthreads(); }
    const XcdBarrier xbar = xcd_barrier_post((unsigned*)(((KP)__builtin_amdgcn_kernarg_segment_ptr())->ws + WS_BAR), (volatile LAS unsigned*)(lds + 131072));
    {   PHASE_BEGIN
        mod_phase(lds, p, wv);
        const int tid0 = otid();
        if (c == 0 && tid0 < 64) { const int lane = tid0;
            for (int l = 0; l < DEPTH; ++l) { const float* la = p->lam_a + l * 256; const float s1 = wave_sum(la[lane] * la[64 + lane]), s2 = wave_sum(la[128 + lane] * la[192 + lane]);
                const float li = l == 0 ? LAM_INIT[0] : (l == 1 ? LAM_INIT[1] : (l == 2 ? LAM_INIT[2] : LAM_INIT[3]));
                if (lane == 0) { ((float*)(ws + WS_LAM))[l] = __expf(s1) - __expf(s2) + li; ((float*)(ws + WS_LAM))[8 + l] = li; } } }
    }
    if (ph_hi == 0x7fffffff) grid.sync();
    xcd_barrier(xbar, wv);
    for (int l = 0; l < DEPTH; ++l) {
        const bool last = (l == DEPTH - 1);
        const int Mact = last ? MX : MT;
        for (int rep = 0; rep < REP0; ++rep) { PHASE_BEGIN
            if (rep) __syncthreads();
            convert_weights(lds, p, l, wv); bias_gemv(lds, p, l, wv); if (l == 0) init_h(p, wv); }
        xcd_barrier(xbar, wv);
        for (int rep = 0; rep < REP1; ++rep) { PHASE_BEGIN
            pg8::Gemm g{(const bf16_t*)(ws + WS_H), (const bf16_t*)(ws + WS_WIN), DM, DM, DM, 0, 0};
            pg8::Epi<1> E{(bf16_t*)(ws + WS_R1), NPM, NPM / 256, (bf16_t*)(ws + WS_R2), NPG, nullptr, nullptr, nullptr, nullptr, nullptr, nullptr, nullptr, (bf16_t*)(ws + WS_VA), nullptr, (const float*)(ws + WS_PART), (const float*)(ws + WS_BIAS1), NIN};
            pg8::StaticOrder S; S.init(MT, NIN, G, c);
            pg8::gemm_phase(lds, g, S, E, wv); }
        xcd_barrier(xbar, wv);
        for (int rep = 0; rep < REP2; ++rep) { PHASE_BEGIN prep1_phase(p, l, wv); }
        xcd_barrier(xbar, wv);
        for (int rep = 0; rep < REP3; ++rep) { PHASE_BEGIN
            { int k1 = 384; asm volatile("" : "+s"(k1));
              pg8::Gemm g{(const bf16_t*)(ws + WS_CQ), (const bf16_t*)(ws + WS_WUQ), k1, k1, k1, 0, 0};
              pg8::Epi<6> E{(bf16_t*)(ws + WS_QB), l, 0, nullptr, 0, nullptr, nullptr, nullptr, p->gq_b + l * 96, nullptr, nullptr, nullptr, nullptr, nullptr, nullptr, nullptr, 0};
              pg8::StaticOrder S; S.init(MT, 768, G, c);
              pg8::gemm_phase(lds, g, S, E, wv); }
            { int k2 = 256; asm volatile("" : "+s"(k2));
              pg8::Gemm g{(const bf16_t*)(ws + WS_CKV), (const bf16_t*)(ws + WS_WUKV), k2, k2, k2, 0, 0};
              pg8::Epi<7> E{(bf16_t*)(ws + WS_KB), l, 0, (bf16_t*)(ws + WS_VB), 0, (const bf16_t*)(ws + WS_KR), nullptr, nullptr, p->gk_b + l * 96, nullptr, nullptr, nullptr, nullptr, nullptr, nullptr, nullptr, 0};
              pg8::StaticOrder S; S.init(MT, 1024, G, (c + 40) % G);
              pg8::gemm_phase(lds, g, S, E, wv); } }
        xcd_barrier(xbar, wv);
        { PHASE_BEGIN attn_phase<0>(lds, p, l, wv); }
        if (ATT_PROBE >= 0) { PHASE_BEGIN __syncthreads(); attn_phase<(ATT_PROBE < 0 ? 0 : ATT_PROBE)>(lds, p, l, wv); }
        xcd_barrier(xbar, wv);
        for (int rep = 0; rep < REP6; ++rep) { PHASE_BEGIN
            pg8::Gemm g{(const bf16_t*)(ws + WS_Y), (const bf16_t*)(ws + WS_WBR), 512, 2048, 512, 2, 1024};
            pg8::Epi<2> E{(bf16_t*)(ws + WS_R1), 4096, 0, nullptr, 0, (const bf16_t*)(ws + WS_R2), nullptr, nullptr, nullptr, nullptr, nullptr, nullptr, nullptr, nullptr, nullptr, nullptr, 0};
            pg8::StaticOrder S; S.init(Mact, 4096, G, c);
            pg8::gemm_phase(lds, g, S, E, wv); }
        xcd_barrier(xbar, wv);
        { PHASE_BEGIN presum_phase(p, Mact, wv); }
        xcd_barrier(xbar, wv);
        for (int rep = 0; rep < REP7; ++rep) { PHASE_BEGIN
            pg8::Gemm g{(const bf16_t*)(ws + WS_MIX), (const bf16_t*)(ws + WS_WO4), DM, DM, 4096, 0, 0};
            pg8::Epi<3> E{nullptr, rep ? 12345 : 0, 0, nullptr, 0, nullptr, p->out, (float*)(ws + WS_XC), (const float*)(ws + WS_MOD) + (size_t)l * 9 * 6144 + 2 * 1024, l == 0 ? p->x : (const float*)p->out, l == 0 ? p->ctx : (const float*)(ws + WS_XC),
                          (const float*)(ws + WS_VM) + ((size_t)l * 2 + 1) * 9 * DM, (bf16_t*)(ws + WS_H), (float*)(ws + WS_PART), nullptr, nullptr, 0};
            pg8::StaticOrder S; S.init(Mact, DM, G, c);
            pg8::gemm_phase(lds, g, S, E, wv); }
        xcd_barrier(xbar, wv);
        for (int rep = 0; rep < REP8; ++rep) { PHASE_BEGIN
            pg8::Gemm g{(const bf16_t*)(ws + WS_H), (const bf16_t*)(ws + WS_WF1), DM, DM, DM, 0, 0};
            pg8::Epi<4> E{(bf16_t*)(ws + WS_R2), DFF, 0, nullptr, 0, nullptr, nullptr, nullptr, nullptr, nullptr, nullptr, nullptr, nullptr, nullptr, (const float*)(ws + WS_PART), (const float*)(ws + WS_BIAS2), DFF};
            pg8::StaticOrder S; S.init(Mact, DFF, G, c);
            pg8::gemm_phase(lds, g, S, E, wv); }
        xcd_barrier(xbar, wv);
        for (int rep = 0; rep < REP9; ++rep) { PHASE_BEGIN
            pg8::Gemm g{(const bf16_t*)(ws + WS_R2), (const bf16_t*)(ws + WS_WF2), DFF, DFF, DFF, 0, 0};
            pg8::Epi<3> E{nullptr, rep ? 12345 : 0, 0, nullptr, 0, nullptr, p->out, (float*)(ws + WS_XC), (const float*)(ws + WS_MOD) + (size_t)l * 9 * 6144 + 5 * 1024, (const float*)p->out, (const float*)(ws + WS_XC),
                          last ? nullptr : (const float*)(ws + WS_VM) + ((size_t)(l + 1) * 2 + 0) * 9 * DM, (bf16_t*)(ws + WS_H), (float*)(ws + WS_PART), nullptr, nullptr, 0};
            pg8::StaticOrder S; S.init(Mact, DM, G, c);
            pg8::gemm_phase(lds, g, S, E, wv); }
        if (!last) xcd_barrier(xbar, wv);
    }
}

extern "C" void kernel_launch(void* const* d_in, const int* in_sizes, int n_in, void* d_out, int out_size, void* d_ws, size_t ws_size, hipStream_t stream) {
    static int grid = 0;
    if (grid == 0) {
        if (n_in != 26 || out_size != MX * DM || ws_size < WS_END) { fprintf(stderr, "kernel_launch: unexpected problem (n_in %d out %d ws %zu)\n", n_in, out_size, ws_size); grid = -1; return; }
        int dev = 0, cus = 0, per_cu = 0;
        hipGetDevice(&dev); hipDeviceGetAttribute(&cus, hipDeviceAttributeMultiprocessorCount, dev);
        hipFuncSetAttribute((const void*)mega, hipFuncAttributeMaxDynamicSharedMemorySize, LDS_BYTES);
        hipOccupancyMaxActiveBlocksPerMultiprocessor(&per_cu, (const void*)mega, 512, LDS_BYTES);
        (void)hipGetLastError();
        grid = cus > 0 ? cus : 256;
        if (per_cu < 1) fprintf(stderr, "kernel_launch: occupancy query says %d blocks/CU\n", per_cu);
    }
    if (grid < 0) return;
    Params p{};
    const float** pp = (const float**)&p;
    for (int i = 0; i < 26; ++i) pp[i] = (const float*)d_in[i];
    p.out = (float*)d_out; p.ws = (unsigned char*)d_ws;
    if (hipMemsetAsync((char*)d_ws + WS_BAR, 0, XCD_BAR_WORDS * 4, stream) != hipSuccess) { fprintf(stderr, "memset failed\n"); return; }
#if MK_COOP
    int lo = 0, hi = N_PHASES;
    void* args[] = {&p, &lo, &hi};
    hipError_t e = hipLaunchCooperativeKernel((const void*)mega, dim3(grid), dim3(512), args, LDS_BYTES, stream);
    if (e != hipSuccess) fprintf(stderr, "cooperative launch failed: %s\n", hipGetErrorString(e));
#else
    for (int ph = 0; ph < N_PHASES; ++ph) hipLaunchKernelGGL(mega, dim3(grid), dim3(512), LDS_BYTES, stream, p, ph, ph + 1);
#endif
}
```

```cpp
#include <hip/hip_runtime.h>
#include <hip/hip_cooperative_groups.h>
#include <cstdio>
#include <cstdint>
namespace cg = cooperative_groups;

#ifndef PHM
#define PHM 0xffff
#endif
#ifndef MK_COOP
#define MK_COOP 1
#endif

#define LAS __attribute__((address_space(3)))
typedef unsigned short bf16_t;
typedef short bf16x8 __attribute__((ext_vector_type(8)));
typedef float f32x2 __attribute__((ext_vector_type(2)));
typedef float f32x4 __attribute__((ext_vector_type(4)));
typedef float f32x8 __attribute__((ext_vector_type(8)));
typedef float f32x16 __attribute__((ext_vector_type(16)));
typedef unsigned u32x2 __attribute__((ext_vector_type(2)));
typedef unsigned u32x4 __attribute__((ext_vector_type(4)));
typedef __bf16 bf16x2_t __attribute__((ext_vector_type(2)));

constexpr int DM = 1024, NB = 8, SEQ = 2048, DEPTH = 4, CTX = 256, TK = CTX + SEQ;
constexpr int MX = NB * SEQ, MC = NB * CTX, MT = MX + MC;
constexpr int DIN = 8352, NPM = 4352, NPG = 4096, NIN = NPM + NPG, DFF = 4096;
constexpr int NGATE0 = 4256;
constexpr float EPS = 1e-6f;
constexpr int C_Q = 0, C_K = 512, C_V = 1024, C_CQ = 1536, C_CKV = 1920, C_KR = 2176, C_POOL = 2208, C_PB = 2720, C_PC = 3232, C_PX = 3744;

constexpr size_t MiB = 1u << 20;
constexpr size_t WS_WIN = 0, WS_WUQ = 17 * MiB, WS_WUKV = 18 * MiB, WS_WBR = 19 * MiB, WS_WO4 = 23 * MiB, WS_WF1 = 31 * MiB, WS_WF2 = 39 * MiB;
constexpr size_t WS_MOD = 48 * MiB, WS_LAM = 49 * MiB, WS_KR = 50 * MiB;
constexpr size_t WS_BAR = 51 * MiB + 512 * 1024;
constexpr size_t WS_XC = 52 * MiB;
constexpr size_t WS_Y = 60 * MiB, WS_H = WS_Y;
constexpr size_t WS_MIX = WS_Y + 36 * MiB;
constexpr size_t WS_QA = 132 * MiB, WS_KA = 150 * MiB, WS_VA = 168 * MiB;
constexpr size_t WS_CQ = 186 * MiB, WS_CKV = 200 * MiB;
constexpr size_t WS_R1 = 209 * MiB;
constexpr size_t WS_QBR = WS_R1, WS_KVR = WS_R1 + 27 * MiB, WS_QB = WS_R1 + 63 * MiB, WS_KB = WS_R1 + 90 * MiB, WS_VB = WS_R1 + 117 * MiB;
constexpr size_t WS_R2 = 362 * MiB;
constexpr size_t WS_VM = 49 * MiB + 4096, WS_BIAS1 = 49 * MiB + 512 * 1024, WS_BIAS2 = 49 * MiB + 832 * 1024;
constexpr size_t WS_PART = 506 * MiB;
constexpr size_t WS_END = 508 * MiB;
constexpr int LDS_BYTES = 131072 + 1024 + 10 * 2048;

struct Params {
    const float *x, *c, *ctx, *c_ctx, *w_mod, *b_mod, *g1, *g2, *w_in, *gq_a, *gk_a, *lam_a, *g_sub, *g_cq, *w_uq, *g_ckv, *w_ukv, *gq_b, *gk_b,
        *w_pool, *s_pool, *w_conv, *w_branch, *w_o, *w_ff1, *w_ff2;
    float* out; unsigned char* ws;
};

typedef const __attribute__((address_space(4))) Params* KP;
__device__ __forceinline__ unsigned cvtpk(float lo, float hi) { f32x2 v = {lo, hi}; bf16x2_t b = __builtin_convertvector(v, bf16x2_t); return __builtin_bit_cast(unsigned, b); }
__device__ __forceinline__ f32x8 unpack8(u32x4 w) {
    f32x8 r;
    r[0] = __uint_as_float(w.x << 16); r[1] = __uint_as_float(w.x & 0xffff0000u); r[2] = __uint_as_float(w.y << 16); r[3] = __uint_as_float(w.y & 0xffff0000u);
    r[4] = __uint_as_float(w.z << 16); r[5] = __uint_as_float(w.z & 0xffff0000u); r[6] = __uint_as_float(w.w << 16); r[7] = __uint_as_float(w.w & 0xffff0000u);
    return r;
}
__device__ __forceinline__ f32x4 unpack4(u32x2 w) {
    f32x4 r; r[0] = __uint_as_float(w.x << 16); r[1] = __uint_as_float(w.x & 0xffff0000u); r[2] = __uint_as_float(w.y << 16); r[3] = __uint_as_float(w.y & 0xffff0000u); return r;
}
__device__ __forceinline__ u32x4 pack8(f32x8 v) { u32x4 w; w.x = cvtpk(v[0], v[1]); w.y = cvtpk(v[2], v[3]); w.z = cvtpk(v[4], v[5]); w.w = cvtpk(v[6], v[7]); return w; }
__device__ __forceinline__ u32x2 pack4(f32x4 v) { u32x2 w; w.x = cvtpk(v[0], v[1]); w.y = cvtpk(v[2], v[3]); return w; }
__device__ __forceinline__ u32x4 ld16(const bf16_t* p) { return *(const u32x4*)p; }
template <int O> __device__ __forceinline__ float shx(float v) {
    if constexpr (O < 32) return __builtin_bit_cast(float, __builtin_amdgcn_ds_swizzle(__builtin_bit_cast(int, v), (O << 10) | 0x1f));
    else { auto rr = __builtin_amdgcn_permlane32_swap(__builtin_bit_cast(unsigned, v), __builtin_bit_cast(unsigned, v), false, false);
           const float a = __builtin_bit_cast(float, (unsigned)rr[0]), b = __builtin_bit_cast(float, (unsigned)rr[1]); return a == v ? b : a; }
}
__device__ __forceinline__ float xsum32(float v) { auto rr = __builtin_amdgcn_permlane32_swap(__builtin_bit_cast(unsigned, v), __builtin_bit_cast(unsigned, v), false, false);
    return __builtin_bit_cast(float, (unsigned)rr[0]) + __builtin_bit_cast(float, (unsigned)rr[1]); }
__device__ __forceinline__ float xmax32(float v) { auto rr = __builtin_amdgcn_permlane32_swap(__builtin_bit_cast(unsigned, v), __builtin_bit_cast(unsigned, v), false, false);
    return fmaxf(__builtin_bit_cast(float, (unsigned)rr[0]), __builtin_bit_cast(float, (unsigned)rr[1])); }
__device__ __forceinline__ float wave_sum(float v) {
    v += shx<1>(v); v += shx<2>(v); v += shx<4>(v); v += shx<8>(v); v += shx<16>(v); return xsum32(v);
}
__device__ __forceinline__ float sum8(f32x8 v) { return ((v[0] * v[0] + v[1] * v[1]) + (v[2] * v[2] + v[3] * v[3])) + ((v[4] * v[4] + v[5] * v[5]) + (v[6] * v[6] + v[7] * v[7])); }
__device__ __forceinline__ int olane() { int l; asm volatile("v_mbcnt_lo_u32_b32 %0, -1, 0\n\tv_mbcnt_hi_u32_b32 %0, -1, %0" : "=v"(l)); return l; }
#define otid() ((wv << 6) | olane())
__device__ __forceinline__ int obid() { int t = blockIdx.x; asm volatile("" : "+s"(t)); return t; }
__device__ __forceinline__ float rsq(float x) { return __builtin_amdgcn_rsqf(x); }

__device__ constexpr float INVA_REV[16] = {1.591549431e-01f, 8.949940161e-02f, 5.032921210e-02f, 2.830219583e-02f, 1.591549431e-02f, 8.949940161e-03f, 5.032921210e-03f, 2.830219583e-03f, 1.591549431e-03f, 8.949940161e-04f, 5.032921210e-04f, 2.830219583e-04f, 1.591549431e-04f, 8.949940161e-05f, 5.032921210e-05f, 2.830219583e-05f};
__device__ constexpr float INVB_REV[8] = {1.591549431e-01f, 5.032921210e-02f, 1.591549431e-02f, 5.032921210e-03f, 1.591549431e-03f, 5.032921210e-04f, 1.591549431e-04f, 5.032921210e-05f};
__device__ constexpr float LAM_INIT[4] = {2.000000000e-01f, 3.555090676e-01f, 4.707130183e-01f, 5.560582042e-01f};

constexpr float CS_A = 0.125f * 1.4426950408889634f, CS_B = 0.10206207261596577f * 1.4426950408889634f;

namespace pg8 {
constexpr int BM = 256, BK = 64, HALF = 128, HTB = HALF * BK * 2, STAGE_BYTES = 8 * HTB, NXCD = 8, WGM = 8;
__host__ __device__ __forceinline__ int lds_byte(int r, int c) { const int st = (r >> 4) * 2 + (c >> 5), rr = r & 15, cc = c & 31, ob = rr * 64 + cc * 2; return st * 1024 + (ob ^ (((ob >> 9) & 1) << 5)); }
__host__ __device__ __forceinline__ void stage_rc(int b, int& R, int& C) { const int st = b / 1024, sb = b % 1024, swz = sb ^ (((sb >> 9) & 1) << 5); R = (st >> 1) * 16 + swz / 64; C = (st & 1) * 32 + (swz % 64) / 2; }
__host__ __device__ __forceinline__ int perm32(int rho) { const int n = rho >> 4, i = rho & 15; return 8 * (i >> 2) + 4 * n + (i & 3); }

struct Unit { int pm, pn; };
struct Gemm { const bf16_t* A; const bf16_t* Bt; int K, lda, ldb, zshift; size_t zA; };

struct StaticOrder {
    int nM, nN, nwg, G, c;
    __device__ void init(int M, int N, int G_, int c_) { nM = M / BM; nN = N / BM; nwg = nM * nN; G = G_; c = c_; }
    __device__ bool next(int i, Unit& u) const {
        const long L = (long)i * G + c; if (L >= nwg) return false;
        int wgid = (int)L; { const int q = nwg / NXCD, r = nwg % NXCD, xcd = wgid % NXCD, off = wgid / NXCD; wgid = (xcd < r ? xcd * (q + 1) : r * (q + 1) + (xcd - r) * q) + off; }
        const int nig = WGM * nN, gid = wgid / nig, fm = gid * WGM, gsz = (nM - fm) < WGM ? (nM - fm) : WGM;
        u.pm = fm + ((wgid % nig) % gsz); u.pn = (wgid % nig) / gsz; return true;
    }
};

template <int MODE> struct Epi {
    static constexpr bool PERM = true, TAB = (MODE == 1 || MODE == 4);
    bf16_t* O; int ldc; int split_tile; bf16_t* O2; int ldc2;
    const bf16_t* gate;
    float* xo; float* xc; const float* mod; const float* xi; const float* xci;
    const float* vm; bf16_t* Hout; float* part;
    const float* partr; const float* bias; int bias_ld;
    __device__ __forceinline__ void operator()(const f32x4 (&acc)[2][2][4][2], const Unit& u, int wr, int wc, int fr, int fq, const LAS float* tab) const {
        const int ln_ = olane(); const int fr_ = ln_ & 15, fq_ = ln_ >> 4; (void)fr; (void)fq;
        const int row0 = u.pm * BM + wr * 64 + fr_;
        const int ct = u.pn * BM + wc * 32 + 8 * fq_;
        if constexpr (MODE == 0 || MODE == 1 || MODE == 4) {
            bf16_t* base = O; int ld = ldc; int c0 = ct;
            if (MODE == 1 && u.pn >= split_tile) { base = O2; ld = ldc2; c0 = ct - split_tile * BM; }
            float rs[8];
#pragma unroll
            for (int i = 0; i < 8; ++i) rs[i] = 1.f;
            if (MODE != 0) {
#pragma unroll
                for (int i = 0; i < 8; ++i) rs[i] = tab[wr * 64 + fr_ + (i >> 2) * HALF + (i & 3) * 16]; }
#pragma unroll
            for (int bj = 0; bj < 2; ++bj) {
                f32x4 b0 = {0.f, 0.f, 0.f, 0.f}, b1 = b0;
                if (MODE != 0) { const LAS float* bp = tab + 256 + wc * 32 + 8 * fq_ + bj * HALF; b0 = *(const LAS f32x4*)bp; b1 = *(const LAS f32x4*)(bp + 4); }
#pragma unroll
                for (int i = 0; i < 8; ++i) { const int ai = i >> 2, m = i & 3; bf16_t* rowp = base + (size_t)(row0 + ai * HALF + m * 16) * ld + c0;
                    if (MODE == 1 && (u.pn == 4 || u.pn == 5)) {
                        const bool isx = u.pm < MX / BM; const int bb = isx ? (u.pm >> 3) : (u.pm - MX / BM), ar0 = isx ? CTX + (u.pm & 7) * BM : 0;
                        rowp = Hout + ((size_t)(bb * 4 + 2 * (u.pn - 4) + bj) * TK + ar0 + wr * 64 + fr_ + ai * HALF + m * 16) * 128 + wc * 32 + 8 * fq_ - bj * HALF; }
                    f32x4 v0 = acc[ai][bj][m][0], v1 = acc[ai][bj][m][1];
                    if (MODE != 0) { v0 = v0 * rs[i] + b0; v1 = v1 * rs[i] + b1; }
                    if (MODE == 4) {
#pragma unroll
                        for (int e = 0; e < 4; ++e) { float a = fmaxf(v0[e], 0.f), b = fmaxf(v1[e], 0.f); v0[e] = a * a; v1[e] = b * b; } }
                    u32x4 w; w.x = cvtpk(v0[0], v0[1]); w.y = cvtpk(v0[2], v0[3]); w.z = cvtpk(v1[0], v1[1]); w.w = cvtpk(v1[2], v1[3]);
                    *(u32x4*)(rowp + bj * HALF) = w; } }
        } else if constexpr (MODE == 6 || MODE == 7) {
            LAS float* xb = (LAS float*)tab;
            const bool isx = u.pm < MX / BM;
            const int b = isx ? (u.pm >> 3) : (u.pm - MX / BM);
            const int arow0 = isx ? CTX + (u.pm & 7) * BM : 0, t0 = (u.pm & 7) * BM;
            const int lr0 = wr * 64 + fr_;
#pragma unroll
            for (int bj = 0; bj < 2; ++bj)
#pragma unroll
                for (int i = 0; i < 8; ++i) { const f32x4 v0 = acc[i >> 2][bj][i & 3][0], v1 = acc[i >> 2][bj][i & 3][1];
                    float s = ((v0[0] * v0[0] + v0[1] * v0[1]) + (v0[2] * v0[2] + v0[3] * v0[3])) + ((v1[0] * v1[0] + v1[1] * v1[1]) + (v1[2] * v1[2] + v1[3] * v1[3]));
                    s += shx<16>(s); s = xsum32(s);
                    if (fq_ == 0) xb[((lr0 + (i >> 2) * HALF + (i & 3) * 16) * 2 + bj) * 4 + wc] = s; }
            asm volatile("s_waitcnt lgkmcnt(0)" ::: "memory"); __builtin_amdgcn_s_barrier(); asm volatile("" ::: "memory");
            const bool rope_tile = (MODE == 6) && (u.pn == 2);
            const bool vwave = (MODE == 7) && (wc >= 2);
#pragma unroll
            for (int bj = 0; bj < 2; ++bj) {
                const int h = (MODE == 7) ? (2 * u.pn + bj) : (rope_tile ? (4 * bj + wc) : (4 * u.pn + 2 * bj + (wc >> 1)));
                const size_t hb = (size_t)(b * 8 + h) * TK + arow0;
                f32x8 gn;
#pragma unroll
                for (int e = 0; e < 8; ++e) gn[e] = mod[(rope_tile ? 64 : (wc & 1) * 32) + 8 * fq_ + e] * (MODE == 6 ? CS_B : 1.f);
#pragma unroll
                for (int i = 0; i < 8; ++i) { const int lr = lr0 + (i >> 2) * HALF + (i & 3) * 16; const f32x4 v0 = acc[i >> 2][bj][i & 3][0], v1 = acc[i >> 2][bj][i & 3][1];
                    f32x8 v; v[0] = v0[0]; v[1] = v0[1]; v[2] = v0[2]; v[3] = v0[3]; v[4] = v1[0]; v[5] = v1[1]; v[6] = v1[2]; v[7] = v1[3];
                    if (vwave) {
                        *(u32x4*)(O2 + (hb + lr) * 64 + (wc - 2) * 32 + 8 * fq_) = pack8(v);
                        if (wc == 2) *(u32x4*)(O + (hb + lr) * 96 + 64 + 8 * fq_) = ld16(gate + (size_t)(u.pm * BM + lr) * 32 + 8 * fq_);
                    } else if (rope_tile) {
                        const float rs = rsq(xb[((lr * 2 + bj) * 4 + wc)] * (1.f / 32.f) + EPS);
#pragma unroll
                        for (int e = 0; e < 8; ++e) v[e] = v[e] * rs * gn[e];
                        if (isx) { const int t = t0 + lr; const float pos = (float)((fq_ & 1) ? (t & 63) : (t >> 6));
#pragma unroll
                            for (int e = 0; e < 8; ++e) { const float a = pos * INVB_REV[e]; const float cs = __builtin_amdgcn_cosf(a), sn = __builtin_amdgcn_sinf(a); const float o = shx<32>(v[e]);
                                v[e] = (fq_ & 2) ? (o * sn + v[e] * cs) : (v[e] * cs - o * sn); } }
                        *(u32x4*)(O + (hb + lr) * 96 + 64 + 8 * fq_) = pack8(v);
                    } else {
                        const LAS float* xp = xb + ((lr * 2 + bj) * 4 + (wc & 2));
                        const float rs = rsq((xp[0] + xp[1]) * (1.f / 64.f) + EPS);
#pragma unroll
                        for (int e = 0; e < 8; ++e) v[e] = v[e] * rs * gn[e];
                        *(u32x4*)(O + (hb + lr) * 96 + (wc & 1) * 32 + 8 * fq_) = pack8(v);
                    } } }
            asm volatile("s_waitcnt lgkmcnt(0)" ::: "memory"); __builtin_amdgcn_s_barrier(); asm volatile("" ::: "memory");
        } else if constexpr (MODE == 2) {
#pragma unroll
            for (int bj = 0; bj < 2; ++bj) {
                u32x4 gw[8];
#pragma unroll
                for (int i = 0; i < 8; ++i) gw[i] = ld16(gate + (size_t)(row0 + (i >> 2) * HALF + (i & 3) * 16) * NPG + ct + bj * HALF);
#pragma unroll
                for (int i = 0; i < 8; ++i) { const int ai = i >> 2, m = i & 3; const size_t off = (size_t)(row0 + ai * HALF + m * 16) * NPG + ct + bj * HALF;
                    const f32x8 g = unpack8(gw[i]); const f32x4 v0 = acc[ai][bj][m][0], v1 = acc[ai][bj][m][1]; f32x8 o;
#pragma unroll
                    for (int e = 0; e < 8; ++e) { const float sg = __builtin_amdgcn_rcpf(1.f + __builtin_amdgcn_exp2f(-1.4426950408889634f * g[e])); o[e] = (e < 4 ? v0[e & 3] : v1[e & 3]) * sg; }
                    *(u32x4*)(O + off) = pack8(o); } }
        } else if (MODE == 3 && ldc != 12345) {
            const int R = u.pm * BM;
            float* xb = (R < MX) ? xo + (size_t)R * DM : xc + (size_t)(R - MX) * DM;
            const float* xr = (R < MX) ? xi + (size_t)R * DM : xci + (size_t)(R - MX) * DM;
            const int mr = (R < MX) ? (R >> 11) : 8;
            float ss[8];
#pragma unroll
            for (int i = 0; i < 8; ++i) ss[i] = 0.f;
#pragma unroll
            for (int bj = 0; bj < 2; ++bj) {
                const float* gp = mod + (size_t)mr * 6144 + ct + bj * HALF; const f32x4 g0 = *(const f32x4*)gp, g1 = *(const f32x4*)(gp + 4);
                f32x4 w0 = {0.f, 0.f, 0.f, 0.f}, w1 = w0;
                if (vm) { const float* vp = vm + (size_t)mr * DM + ct + bj * HALF; w0 = *(const f32x4*)vp; w1 = *(const f32x4*)(vp + 4); }
#pragma unroll
                for (int hb = 0; hb < 2; ++hb) {
                    f32x4 xa[4], xbv[4];
#pragma unroll
                    for (int q = 0; q < 4; ++q) { const int i = hb * 4 + q; const int lr = wr * 64 + fr_ + (i >> 2) * HALF + (i & 3) * 16; const float* xp = xr + (size_t)lr * DM + ct + bj * HALF; xa[q] = *(const f32x4*)xp; xbv[q] = *(const f32x4*)(xp + 4); }
#pragma unroll
                    for (int q = 0; q < 4; ++q) { const int i = hb * 4 + q; const int ai = i >> 2, m = i & 3; const int lr = wr * 64 + fr_ + ai * HALF + m * 16; float* xp = xb + (size_t)lr * DM + ct + bj * HALF;
                        f32x4 xv0 = xa[q] + g0 * acc[ai][bj][m][0], xv1 = xbv[q] + g1 * acc[ai][bj][m][1];
                        *(f32x4*)xp = xv0; *(f32x4*)(xp + 4) = xv1;
                        if (vm) { ss[i] += ((xv0[0] * xv0[0] + xv0[1] * xv0[1]) + (xv0[2] * xv0[2] + xv0[3] * xv0[3])) + ((xv1[0] * xv1[0] + xv1[1] * xv1[1]) + (xv1[2] * xv1[2] + xv1[3] * xv1[3]));
                            const f32x4 h0 = xv0 * w0, h1 = xv1 * w1; u32x4 w; w.x = cvtpk(h0[0], h0[1]); w.y = cvtpk(h0[2], h0[3]); w.z = cvtpk(h1[0], h1[1]); w.w = cvtpk(h1[2], h1[3]);
                            *(u32x4*)(Hout + (size_t)(R + lr) * DM + ct + bj * HALF) = w; } } } }
            if (vm) {
#pragma unroll
                for (int i = 0; i < 8; ++i) { float s = ss[i]; s += shx<16>(s); s = xsum32(s); const int lr = wr * 64 + fr_ + (i >> 2) * HALF + (i & 3) * 16;
                    if (fq_ == 0) part[(size_t)(R + lr) * 16 + u.pn * 4 + wc] = s; } }
        }
    }
};

template <class EpiT, class Sched>
__device__ __forceinline__ void gemm_phase(LAS unsigned char* lds, const Gemm g, const Sched& S, const EpiT& E, int wv) {
    LAS float* tab = (LAS float*)(lds + STAGE_BYTES + 1024);
    const int tid = otid(), wid = __builtin_amdgcn_readfirstlane(tid >> 6), lane = tid & 63, wr = wid >> 2, wc = wid & 3, fr = lane & 15, fq = lane >> 4;
    const int K = g.K, nt = K / BK;
    unsigned voffA[2], voffB[2];
#pragma unroll
    for (int i = 0; i < 2; ++i) { int R, C; stage_rc(tid * 16 + i * 8192, R, C); const int Rb = EpiT::PERM ? ((R & ~31) + perm32(R & 31)) : R;
        voffA[i] = (unsigned)(R * g.lda + C) * 2u; voffB[i] = (unsigned)(Rb * g.ldb + C) * 2u; }
    const size_t kstep = (size_t)(BK * 2);
    const size_t hstepA = (size_t)HALF * g.lda * 2, hstepB = (size_t)HALF * g.ldb * 2;
    const size_t tstepA = 2 * hstepA, tstepB = 2 * hstepB;
    const unsigned ldsw = (unsigned)wid * 1024u;
    const int foff = lds_byte(fr, fq * 8);
    const int aoff = wr * 8192 + foff, boff = wc * 4096 + foff;
#define PG8_SA(b, h) (((b) * 2 + (h)) * HTB)
#define PG8_SB(b, h) ((4 + (b) * 2 + (h)) * HTB)
#define PG8_STAGE(bufoff, gbase, voff) do { _Pragma("unroll") for (int _i = 0; _i < 2; ++_i) \
        __builtin_amdgcn_global_load_lds((const unsigned*)((const char*)(gbase) + (voff)[_i]), (LAS unsigned*)(lds + (bufoff) + ldsw + _i * 8192), 16, 0, 0); } while (0)
#define PG8_LDA(dst, b, h) do { _Pragma("unroll") for (int m = 0; m < 4; ++m) _Pragma("unroll") for (int k = 0; k < 2; ++k) dst[m][k] = *(const LAS bf16x8*)(lds + PG8_SA(b, h) + aoff + m * 2048 + k * 1024); } while (0)
#define PG8_LDB(dst, b, h) do { _Pragma("unroll") for (int n = 0; n < 2; ++n) _Pragma("unroll") for (int k = 0; k < 2; ++k) dst[n][k] = *(const LAS bf16x8*)(lds + PG8_SB(b, h) + boff + n * 2048 + k * 1024); } while (0)
#define PG8_MMA(ai, bj, At, Bt) do { __builtin_amdgcn_s_setprio(1); _Pragma("unroll") for (int m = 0; m < 4; ++m) _Pragma("unroll") for (int n = 0; n < 2; ++n) _Pragma("unroll") for (int k = 0; k < 2; ++k) \
        acc[ai][bj][m][n] = __builtin_amdgcn_mfma_f32_16x16x32_bf16(Bt[n][k], At[m][k], acc[ai][bj][m][n], 0, 0, 0); __builtin_amdgcn_s_setprio(0); } while (0)
#define PG8_WAIT_V(n) asm volatile("s_waitcnt vmcnt(" #n ")" ::: "memory")
#define PG8_WAIT_L(n) asm volatile("s_waitcnt lgkmcnt(" #n ")" ::: "memory")
#define PG8_BAR __builtin_amdgcn_s_barrier()
#define PG8_SCHED __builtin_amdgcn_sched_barrier(0)
    Unit cur, nxt; int ui = 0;
    if (!S.next(0, cur)) return;
    if constexpr (EpiT::TAB) {
        Unit tu;
        for (int i = 0; S.next(i, tu); ++i) {
            if (tid < 256) { const f32x4* pp = (const f32x4*)(E.partr + (size_t)(tu.pm * BM + tid) * 16); const f32x4 p0 = pp[0], p1 = pp[1], p2 = pp[2], p3 = pp[3];
                const f32x4 ps = (p0 + p1) + (p2 + p3); tab[i * 512 + tid] = rsq(((ps[0] + ps[1]) + (ps[2] + ps[3])) * (1.f / DM) + EPS); }
            else { const int mr = (tu.pm * BM < MX) ? ((tu.pm * BM) >> 11) : 8; tab[i * 512 + tid] = E.bias[(size_t)mr * E.bias_ld + tu.pn * BM + (tid - 256)]; }
        }
        __syncthreads();
    }
    f32x4 acc[2][2][4][2];
#pragma unroll
    for (int a = 0; a < 2; ++a)
#pragma unroll
        for (int b = 0; b < 2; ++b)
#pragma unroll
            for (int m = 0; m < 4; ++m)
#pragma unroll
                for (int n = 0; n < 2; ++n) acc[a][b][m][n] = (f32x4){0.f, 0.f, 0.f, 0.f};
    bf16x8 At[4][2], B0[2][2], B1[2][2];
    const char* cA = (const char*)g.A + (size_t)cur.pm * tstepA + (size_t)(cur.pn >> g.zshift) * g.zA; const char* cB = (const char*)g.Bt + (size_t)cur.pn * tstepB;
    PG8_STAGE(PG8_SB(0, 0), cB, voffB); PG8_STAGE(PG8_SB(0, 1), cB + hstepB, voffB); PG8_STAGE(PG8_SA(0, 0), cA, voffA); PG8_STAGE(PG8_SA(0, 1), cA + hstepA, voffA);
    if (wr == 1) PG8_BAR;
    PG8_WAIT_V(2); PG8_BAR;
    PG8_STAGE(PG8_SB(1, 0), cB + kstep, voffB); PG8_STAGE(PG8_SA(1, 0), cA + kstep, voffA); PG8_STAGE(PG8_SB(1, 1), cB + hstepB + kstep, voffB);
    PG8_WAIT_V(6); PG8_BAR;
    for (;;) {
        const bool has_next = S.next(ui + 1, nxt);
        const char* nA = has_next ? (const char*)g.A + (size_t)nxt.pm * tstepA + (size_t)(nxt.pn >> g.zshift) * g.zA : cA; const char* nB = has_next ? (const char*)g.Bt + (size_t)nxt.pn * tstepB : cB;
        for (int t = 0; t < nt; t += 2) {
            const bool last = (t == nt - 2);
            const char* a1 = cA + (size_t)(t + 1) * kstep;
            const char* a2 = last ? nA : cA + (size_t)(t + 2) * kstep; const char* b2 = last ? nB : cB + (size_t)(t + 2) * kstep;
            const char* a3 = a2 + kstep; const char* b3 = b2 + kstep;
            PG8_LDB(B0, 0, 0); PG8_LDB(B1, 0, 1); PG8_SCHED; PG8_LDA(At, 0, 0); PG8_STAGE(PG8_SA(1, 1), a1 + hstepA, voffA);
            PG8_WAIT_V(8); PG8_WAIT_L(0); PG8_BAR; PG8_MMA(0, 0, At, B0); PG8_MMA(0, 1, At, B1); PG8_BAR; PG8_SCHED;
            PG8_LDA(At, 0, 1); PG8_STAGE(PG8_SB(0, 0), b2, voffB); PG8_STAGE(PG8_SB(0, 1), b2 + hstepB, voffB); PG8_STAGE(PG8_SA(0, 0), a2, voffA);
            PG8_WAIT_V(8); PG8_WAIT_L(0); PG8_BAR; PG8_MMA(1, 0, At, B0); PG8_MMA(1, 1, At, B1); PG8_BAR; PG8_SCHED;
            PG8_LDB(B0, 1, 0); PG8_LDB(B1, 1, 1); PG8_SCHED; PG8_LDA(At, 1, 0); PG8_STAGE(PG8_SA(0, 1), a2 + hstepA, voffA);
            PG8_WAIT_V(8); PG8_WAIT_L(0); PG8_BAR; PG8_MMA(0, 0, At, B0); PG8_MMA(0, 1, At, B1); PG8_BAR; PG8_SCHED;
            PG8_LDA(At, 1, 1); PG8_STAGE(PG8_SB(1, 0), b3, voffB); PG8_STAGE(PG8_SB(1, 1), b3 + hstepB, voffB); PG8_STAGE(PG8_SA(1, 0), a3, voffA);
            PG8_WAIT_V(8); PG8_WAIT_L(0); PG8_BAR; PG8_MMA(1, 0, At, B0); PG8_MMA(1, 1, At, B1); PG8_BAR; PG8_SCHED;
        }
        if (wr == 0) PG8_BAR;
        E(acc, cur, wr, wc, fr, fq, EpiT::TAB ? tab + ui * 512 : tab);
        if (!has_next) break;
#pragma unroll
        for (int a = 0; a < 2; ++a)
#pragma unroll
            for (int b = 0; b < 2; ++b)
#pragma unroll
                for (int m = 0; m < 4; ++m)
#pragma unroll
                    for (int n = 0; n < 2; ++n) acc[a][b][m][n] = (f32x4){0.f, 0.f, 0.f, 0.f};
        cur = nxt; cA = nA; cB = nB; ++ui;
        if (wr == 1) PG8_BAR;
    }
    PG8_WAIT_V(0);
    PG8_BAR;
#undef PG8_SA
#undef PG8_SB
#undef PG8_STAGE
#undef PG8_LDA
#undef PG8_LDB
#undef PG8_MMA
#undef PG8_WAIT_V
#undef PG8_WAIT_L
#undef PG8_BAR
#undef PG8_SCHED
}
}

#define MFMA32(a, b, c) __builtin_amdgcn_mfma_f32_32x32x16_bf16((a), (b), (c), 0, 0, 0)
constexpr int ATT_BUF = 32768, ATT_VOFF = 13312, ATT_VP = 136;

template <int DK, int DV, int VAR>
__device__ __forceinline__ void attn_pass(LAS unsigned char* lds, const bf16_t* Qg, const bf16_t* Kg, const bf16_t* Vg, int ntiles, float cs, f32x16 (&O)[DV / 32], float& lsum, int wv) {
    constexpr int KP = DK * 2 + 16, KCH = DK / 8, NKC = 64 * KCH;
    const int tid = otid(), lane = tid & 63, wid = tid >> 6, l32 = lane & 31, hf = lane >> 5;
    bf16x8 qf[DK / 16];
    { const bf16_t* qrow = Qg + (size_t)(wid * 32 + l32) * DK + hf * 8;
#pragma unroll
      for (int kk = 0; kk < DK / 16; ++kk) qf[kk] = *(const bf16x8*)(qrow + kk * 16); }
    const int kc0 = tid, kc1 = tid + 512;
    const int kr0 = kc0 / KCH, kq0 = kc0 % KCH, kr1 = kc1 / KCH, kq1 = kc1 % KCH;
    const bool k1on = (kc1 < NKC);
    const int kp = (DV == 128 ? (wid >> 2) : ((wid >> 1) & 1)) * 16 + (lane & 15);
    const int vch = (DV == 128 ? (wid & 3) : (wid & 1)) * 4 + (lane >> 4);
    const bool von = (DV == 128) || (wid < 4);
    const bf16_t* kg0 = Kg + kr0 * DK + kq0 * 8; const bf16_t* kg1 = Kg + kr1 * DK + kq1 * 8;
    const bf16_t* vg0 = Vg + (size_t)(2 * kp) * DV + vch * 8;
    const unsigned kl0 = kr0 * KP + kq0 * 16, kl1 = kr1 * KP + kq1 * 16, vl0 = ATT_VOFF + (vch * 8) * ATT_VP + kp * 4;
    u32x4 ka0, ka1, va0, va1;
    { unsigned z0 = 0u; asm volatile("" : "+v"(z0)); ka1 = (u32x4){z0, z0, z0, z0}; } va0 = ka1; va1 = ka1; ka0 = ka1;
#define ATT_LOADK(t, r0, r1) do { r0 = *(const u32x4*)kg0; if (k1on) r1 = *(const u32x4*)kg1; kg0 += 64 * DK; kg1 += 64 * DK; } while (0)
#define ATT_LOADV(t, r0, r1) do { if (von) { r0 = *(const u32x4*)vg0; r1 = *(const u32x4*)(vg0 + DV); } vg0 += 64 * DV; } while (0)
#define ATT_STOREK(bi, r0, r1) do { LAS unsigned char* kb_ = lds + (bi) * ATT_BUF; *(LAS u32x4*)(kb_ + kl0) = r0; if (k1on) *(LAS u32x4*)(kb_ + kl1) = r1; } while (0)
#define ATT_STOREV(bi, r0, r1) do { if (von) { LAS unsigned char* vb_ = lds + (bi) * ATT_BUF + vl0; \
            *(LAS unsigned*)(vb_ + 0 * ATT_VP) = (r0.x & 0xffffu) | (r1.x << 16); *(LAS unsigned*)(vb_ + 1 * ATT_VP) = (r0.x >> 16) | (r1.x & 0xffff0000u); \
            *(LAS unsigned*)(vb_ + 2 * ATT_VP) = (r0.y & 0xffffu) | (r1.y << 16); *(LAS unsigned*)(vb_ + 3 * ATT_VP) = (r0.y >> 16) | (r1.y & 0xffff0000u); \
            *(LAS unsigned*)(vb_ + 4 * ATT_VP) = (r0.z & 0xffffu) | (r1.z << 16); *(LAS unsigned*)(vb_ + 5 * ATT_VP) = (r0.z >> 16) | (r1.z & 0xffff0000u); \
            *(LAS unsigned*)(vb_ + 6 * ATT_VP) = (r0.w & 0xffffu) | (r1.w << 16); *(LAS unsigned*)(vb_ + 7 * ATT_VP) = (r0.w >> 16) | (r1.w & 0xffff0000u); } } while (0)
#define ATT_QK(bi, S0, S1) do { const unsigned ka_ = (unsigned)(unsigned long long)(lds + (bi) * ATT_BUF + l32 * KP + hf * 16); \
        bf16x8 kfa[DK / 16], kfb[DK / 16]; \
          \
        if constexpr (DK == 64) { \
            asm volatile("ds_read_b128 %0, %8\n\tds_read_b128 %1, %8 offset:%9\n\tds_read_b128 %2, %8 offset:32\n\tds_read_b128 %3, %8 offset:%10\n\t" \
                         "ds_read_b128 %4, %8 offset:64\n\tds_read_b128 %5, %8 offset:%11\n\tds_read_b128 %6, %8 offset:96\n\tds_read_b128 %7, %8 offset:%12\n\ts_waitcnt lgkmcnt(0)" \
                         : "=&v"(kfa[0]), "=&v"(kfb[0]), "=&v"(kfa[1]), "=&v"(kfb[1]), "=&v"(kfa[2]), "=&v"(kfb[2]), "=&v"(kfa[3]), "=&v"(kfb[3]) \
                         : "v"(ka_), "n"(32 * KP), "n"(32 * KP + 32), "n"(32 * KP + 64), "n"(32 * KP + 96) : "memory"); \
        } else { \
            asm volatile("ds_read_b128 %0, %12\n\tds_read_b128 %1, %12 offset:%13\n\tds_read_b128 %2, %12 offset:32\n\tds_read_b128 %3, %12 offset:%14\n\t" \
                         "ds_read_b128 %4, %12 offset:64\n\tds_read_b128 %5, %12 offset:%15\n\tds_read_b128 %6, %12 offset:96\n\tds_read_b128 %7, %12 offset:%16\n\t" \
                         "ds_read_b128 %8, %12 offset:128\n\tds_read_b128 %9, %12 offset:%17\n\tds_read_b128 %10, %12 offset:160\n\tds_read_b128 %11, %12 offset:%18\n\ts_waitcnt lgkmcnt(0)" \
                         : "=&v"(kfa[0]), "=&v"(kfb[0]), "=&v"(kfa[1]), "=&v"(kfb[1]), "=&v"(kfa[2]), "=&v"(kfb[2]), "=&v"(kfa[3]), "=&v"(kfb[3]), "=&v"(kfa[DK / 16 - 2]), "=&v"(kfb[DK / 16 - 2]), "=&v"(kfa[DK / 16 - 1]), "=&v"(kfb[DK / 16 - 1]) \
                         : "v"(ka_), "n"(32 * KP), "n"(32 * KP + 32), "n"(32 * KP + 64), "n"(32 * KP + 96), "n"(32 * KP + 128), "n"(32 * KP + 160) : "memory"); \
        } \
        S0 = MFMA32(kfa[0], qf[0], negm); S1 = MFMA32(kfb[0], qf[0], negm);                \
        _Pragma("unroll") for (int kk = 1; kk < DK / 16; ++kk) { S0 = MFMA32(kfa[kk], qf[kk], S0); S1 = MFMA32(kfb[kk], qf[kk], S1); } } while (0)
#define ATT_VISSUE(vl, vh, base) asm volatile("ds_read_b64 %0, %16\n\tds_read_b64 %1, %16 offset:16\n\tds_read_b64 %2, %16 offset:32\n\tds_read_b64 %3, %16 offset:48\n\t" \
                         "ds_read_b64 %4, %16 offset:64\n\tds_read_b64 %5, %16 offset:80\n\tds_read_b64 %6, %16 offset:96\n\tds_read_b64 %7, %16 offset:112\n\t" \
                         "ds_read_b64 %8, %16 offset:%17\n\tds_read_b64 %9, %16 offset:%18\n\tds_read_b64 %10, %16 offset:%19\n\tds_read_b64 %11, %16 offset:%20\n\t" \
                         "ds_read_b64 %12, %16 offset:%21\n\tds_read_b64 %13, %16 offset:%22\n\tds_read_b64 %14, %16 offset:%23\n\tds_read_b64 %15, %16 offset:%24" \
                         : "=&v"(vl[0]), "=&v"(vh[0]), "=&v"(vl[1]), "=&v"(vh[1]), "=&v"(vl[2]), "=&v"(vh[2]), "=&v"(vl[3]), "=&v"(vh[3]), \
                           "=&v"(vl[4]), "=&v"(vh[4]), "=&v"(vl[5]), "=&v"(vh[5]), "=&v"(vl[6]), "=&v"(vh[6]), "=&v"(vl[7]), "=&v"(vh[7]) \
                         : "v"(base), "n"(32 * ATT_VP), "n"(32 * ATT_VP + 16), "n"(32 * ATT_VP + 32), "n"(32 * ATT_VP + 48), "n"(32 * ATT_VP + 64), "n"(32 * ATT_VP + 80), "n"(32 * ATT_VP + 96), "n"(32 * ATT_VP + 112) : "memory")
#define ATT_VWAIT(vl, vh) asm volatile("s_waitcnt lgkmcnt(0)" : "+v"(vl[0]), "+v"(vh[0]), "+v"(vl[1]), "+v"(vh[1]), "+v"(vl[2]), "+v"(vh[2]), "+v"(vl[3]), "+v"(vh[3]), \
                           "+v"(vl[4]), "+v"(vh[4]), "+v"(vl[5]), "+v"(vh[5]), "+v"(vl[6]), "+v"(vh[6]), "+v"(vl[7]), "+v"(vh[7]) :: "memory")
#define ATT_VFRAG(vl, vh, i) __builtin_bit_cast(bf16x8, (u32x4){vl[i].x, vl[i].y, vh[i].x, vh[i].y})
#define ATT_SOFTMAX_PV(bi, S0, S1) do { \
        const unsigned va_ = (unsigned)(unsigned long long)(lds + (bi) * ATT_BUF + ATT_VOFF + l32 * ATT_VP + 8 * hf); \
        u32x2 vl[8], vh[8]; \
        if (VAR != 4) ATT_VISSUE(vl, vh, va_);                        \
        float mx = fmaxf(fmaxf(S0[0], S1[0]), fmaxf(S0[1], S1[1])); \
        _Pragma("unroll") for (int i = 2; i < 16; i += 2) mx = fmaxf(mx, fmaxf(fmaxf(S0[i], S1[i]), fmaxf(S0[i + 1], S1[i + 1]))); \
        mx = xmax32(mx); \
        if (t == 0 || __builtin_amdgcn_ballot_w64(mx > 8.f) != 0ull) {          \
            const float dm = (t == 0) ? mx : fmaxf(mx, 0.f); \
            if (t != 0) { const float alpha = __builtin_amdgcn_exp2f(-dm); lrun *= alpha; _Pragma("unroll") for (int tt = 0; tt < DV / 32; ++tt) O[tt] *= alpha; } \
            mrun += dm; \
            _Pragma("unroll") for (int i = 0; i < 16; ++i) { negm[i] = -mrun; S0[i] -= dm; S1[i] -= dm; } } \
        f32x2 ps2 = {0.f, 0.f}; \
        _Pragma("unroll") for (int i = 0; i < 16; i += 2) { f32x2 a = {S0[i], S0[i + 1]}, c = {S1[i], S1[i + 1]}; \
            if (VAR != 2) { a.x = __builtin_amdgcn_exp2f(a.x); a.y = __builtin_amdgcn_exp2f(a.y); c.x = __builtin_amdgcn_exp2f(c.x); c.y = __builtin_amdgcn_exp2f(c.y); } ps2 += a; ps2 += c; \
            S0[i] = a.x; S0[i + 1] = a.y; S1[i] = c.x; S1[i + 1] = c.y; } \
        lrun += ps2.x + ps2.y; \
        bf16x8 pf[4]; \
        _Pragma("unroll") for (int j = 0; j < 4; ++j) { u32x4 w; \
            if (j < 2) { w.x = cvtpk(S0[8 * j + 0], S0[8 * j + 1]); w.y = cvtpk(S0[8 * j + 2], S0[8 * j + 3]); w.z = cvtpk(S0[8 * j + 4], S0[8 * j + 5]); w.w = cvtpk(S0[8 * j + 6], S0[8 * j + 7]); } \
            else { const int jj = j - 2; w.x = cvtpk(S1[8 * jj + 0], S1[8 * jj + 1]); w.y = cvtpk(S1[8 * jj + 2], S1[8 * jj + 3]); w.z = cvtpk(S1[8 * jj + 4], S1[8 * jj + 5]); w.w = cvtpk(S1[8 * jj + 6], S1[8 * jj + 7]); } \
            pf[j] = __builtin_bit_cast(bf16x8, w); } \
        if (VAR == 4) { _Pragma("unroll") for (int tt = 0; tt < DV / 32; ++tt) _Pragma("unroll") for (int j = 0; j < 4; ++j) O[tt][j] += __builtin_bit_cast(float, (int)pf[j][0]); } else { \
            ATT_VWAIT(vl, vh); \
            _Pragma("unroll") for (int j = 0; j < 4; ++j) O[0] = MFMA32(ATT_VFRAG(vl, vh, j), pf[j], O[0]); \
            _Pragma("unroll") for (int j = 0; j < 4; ++j) O[1] = MFMA32(ATT_VFRAG(vl, vh, 4 + j), pf[j], O[1]); \
            if constexpr (DV == 128) { const unsigned vc_ = va_ + 64 * ATT_VP; u32x2 wl[8], wh[8]; ATT_VISSUE(wl, wh, vc_); ATT_VWAIT(wl, wh); \
                _Pragma("unroll") for (int j = 0; j < 4; ++j) O[2] = MFMA32(ATT_VFRAG(wl, wh, j), pf[j], O[2]); \
                _Pragma("unroll") for (int j = 0; j < 4; ++j) O[3] = MFMA32(ATT_VFRAG(wl, wh, 4 + j), pf[j], O[3]); } } } while (0)
#pragma unroll
    for (int t = 0; t < DV / 32; ++t)
#pragma unroll
        for (int i = 0; i < 16; ++i) O[t][i] = 0.f;
    float mrun = 0.f, lrun = 0.f; (void)cs;
    f32x16 Sa0, Sa1, negm;
#pragma unroll
    for (int i = 0; i < 16; ++i) negm[i] = 0.f;
    __syncthreads();
    ATT_LOADK(0, ka0, ka1); ATT_LOADV(0, va0, va1);
    for (int t = 0; t < ntiles; ++t) {
        if (VAR != 1 || t < 2) { ATT_STOREK(t & 1, ka0, ka1); ATT_STOREV(t & 1, va0, va1); }
        __syncthreads();
        if (VAR != 1) { if (t + 1 < ntiles) { ATT_LOADK(t + 1, ka0, ka1); ATT_LOADV(t + 1, va0, va1); } }
        if (VAR != 3) { ATT_QK(t & 1, Sa0, Sa1); } else {
#pragma unroll
            for (int i = 0; i < 16; ++i) { Sa0[i] = (float)(t + i) * 1e-3f; Sa1[i] = (float)(t - i) * 1e-3f; } }
        ATT_SOFTMAX_PV(t & 1, Sa0, Sa1);
    }
    lsum = xsum32(lrun);
#undef ATT_LOADK
#undef ATT_LOADV
#undef ATT_STOREK
#undef ATT_STOREV
#undef ATT_QK
#undef ATT_SOFTMAX_PV
#undef ATT_VISSUE
#undef ATT_VWAIT
#undef ATT_VFRAG
}

template <int VAR> __device__ __forceinline__ void attn_unit_a(LAS unsigned char* lds, KP p, int l, int bh, int qb, int wv) {
    unsigned char* ws = p->ws;
    const int b = bh >> 2, h = bh & 3;
    const int tid_ = otid(); const int lane = tid_ & 63, wid = tid_ >> 6, l32 = lane & 31, hf = lane >> 5;
    const int ntiles = qb == 0 ? CTX / 64 : TK / 64;
    const int q0 = qb == 0 ? 0 : CTX + (qb - 1) * 256;
    const bf16_t* QA = (const bf16_t*)(ws + WS_QA); const bf16_t* KA = (const bf16_t*)(ws + WS_KA); const bf16_t* VA = (const bf16_t*)(ws + WS_VA);
    const float cs = 0.125f * 1.4426950408889634f;
    const float lam = ((const float*)(ws + WS_LAM))[l];
    const float lam_init = ((const float*)(ws + WS_LAM))[8 + l];
    f32x16 O[4]; float lsum;
    const bf16_t* Vg = VA + (size_t)(b * 4 + h) * TK * 128;
    attn_pass<64, 128, VAR>(lds, QA + ((size_t)(b * 8 + h * 2 + 0) * TK + q0) * 64, KA + (size_t)(b * 8 + h * 2 + 0) * TK * 64, Vg, ntiles, cs, O, lsum, wv);
    LAS unsigned* o0 = (LAS unsigned*)(lds + 65536 + wid * 8192) + lane;
    { const float inv = 1.f / lsum;
#pragma unroll
      for (int t = 0; t < 4; ++t)
#pragma unroll
          for (int i = 0; i < 8; ++i) o0[(t * 8 + i) * 64] = cvtpk(O[t][2 * i] * inv, O[t][2 * i + 1] * inv); }
    attn_pass<64, 128, VAR>(lds, QA + ((size_t)(b * 8 + h * 2 + 1) * TK + q0) * 64, KA + (size_t)(b * 8 + h * 2 + 1) * TK * 64, Vg, ntiles, cs, O, lsum, wv);
    const float inv1 = lam / lsum;
    float ss = 0.f;
#pragma unroll
    for (int t = 0; t < 4; ++t)
#pragma unroll
        for (int i = 0; i < 8; ++i) { const unsigned ow = o0[(t * 8 + i) * 64]; const float a = __uint_as_float(ow << 16) - O[t][2 * i] * inv1, c = __uint_as_float(ow & 0xffff0000u) - O[t][2 * i + 1] * inv1;
            O[t][2 * i] = a; O[t][2 * i + 1] = c; ss += a * a + c * c; }
    ss = xsum32(ss);
    const float rs = rsq(ss * (1.f / 128.f) + EPS) * (1.f - lam_init);
    const int row = (qb == 0 ? MX + b * CTX : b * SEQ + (qb - 1) * 256) + wid * 32 + l32;
    if (VAR != 0 && rs != 12345.f) return;
    bf16_t* yp = (bf16_t*)(ws + WS_Y) + (size_t)row * 2048 + h * 128 + 4 * hf;
    const float* gs = p->g_sub + l * 128 + 4 * hf;
#pragma unroll
    for (int t = 0; t < 4; ++t)
#pragma unroll
        for (int i4 = 0; i4 < 4; ++i4) { const f32x4 g = *(const f32x4*)(gs + 32 * t + 8 * i4);
            f32x4 v; v[0] = O[t][4 * i4] * rs * g[0]; v[1] = O[t][4 * i4 + 1] * rs * g[1]; v[2] = O[t][4 * i4 + 2] * rs * g[2]; v[3] = O[t][4 * i4 + 3] * rs * g[3];
            *(u32x2*)(yp + 32 * t + 8 * i4) = pack4(v); }
}
template <int VAR> __device__ __forceinline__ void attn_unit_b(LAS unsigned char* lds, KP p, int bh, int qb, int wv) {
    unsigned char* ws = p->ws;
    const int b = bh >> 3, h = bh & 7;
    const int tid_ = otid(); const int lane = tid_ & 63, wid = tid_ >> 6, l32 = lane & 31, hf = lane >> 5;
    const int ntiles = qb == 0 ? CTX / 64 : TK / 64;
    const int q0 = qb == 0 ? 0 : CTX + (qb - 1) * 256;
    const bf16_t* QB = (const bf16_t*)(ws + WS_QB); const bf16_t* KB = (const bf16_t*)(ws + WS_KB); const bf16_t* VB = (const bf16_t*)(ws + WS_VB);
    const float cs = 0.10206207261596577f * 1.4426950408889634f;
    f32x16 O[2]; float lsum;
    attn_pass<96, 64, VAR>(lds, QB + ((size_t)bh * TK + q0) * 96, KB + (size_t)bh * TK * 96, VB + (size_t)bh * TK * 64, ntiles, cs, O, lsum, wv);
    const float inv = 1.f / lsum;
    const int row = (qb == 0 ? MX + b * CTX : b * SEQ + (qb - 1) * 256) + wid * 32 + l32;
    if (VAR != 0 && inv != 12345.f) return;
    bf16_t* yp = (bf16_t*)(ws + WS_Y) + (size_t)row * 2048 + 512 + h * 64 + 4 * hf;
#pragma unroll
    for (int t = 0; t < 2; ++t)
#pragma unroll
        for (int i4 = 0; i4 < 4; ++i4) { f32x4 v; v[0] = O[t][4 * i4] * inv; v[1] = O[t][4 * i4 + 1] * inv; v[2] = O[t][4 * i4 + 2] * inv; v[3] = O[t][4 * i4 + 3] * inv;
            *(u32x2*)(yp + 32 * t + 8 * i4) = pack4(v); }
}
template <int VAR> __device__ __forceinline__ void attn_phase(LAS unsigned char* lds, KP p, int l, int wv) {
    const int G = gridDim.x, c = blockIdx.x;
    const int NU = (l == DEPTH - 1) ? 768 : 864;
    for (int u = c; u < NU; u += G) {
        if (u < 256) { const int xcd = u & 7, j = u >> 3; attn_unit_a<VAR>(lds, p, l, xcd * 4 + (j >> 3), 1 + (j & 7), wv); }
        else if (u < 768) { const int u2 = u - 256, r = u2 >> 8, c2 = u2 & 255, xcd = c2 & 7, j = c2 >> 3; attn_unit_b<VAR>(lds, p, xcd * 8 + (j >> 3) * 2 + r, 1 + (j & 7), wv); }
        else { const int u3 = u - 768; if (u3 < 32) attn_unit_a<VAR>(lds, p, l, u3, 0, wv); else attn_unit_b<VAR>(lds, p, u3 - 32, 0, wv); }
    }
}

__device__ __forceinline__ void tr_item(const float* W, int N, bf16_t* WT, int ldk, int row_off, int split, int shift, int ncopy, int copy_stride, LAS float* scr, int item, int lane) {
    const int nblk = N / 32, kb = item / nblk, nb = item % nblk, k0 = 64 * kb, n0 = 32 * nb;
    float wv_[32];
#pragma unroll
    for (int i = 0; i < 32; ++i) wv_[i] = W[(size_t)(k0 + 2 * i + (lane >> 5)) * N + n0 + (lane & 31)];
#pragma unroll
    for (int i = 0; i < 32; ++i) scr[(2 * i + (lane >> 5)) * 33 + (lane & 31)] = wv_[i];
    asm volatile("s_waitcnt lgkmcnt(0)" ::: "memory");
    const int c = lane & 7;
    const int rsh = row_off + n0 + (n0 >= split ? shift : 0);
#pragma unroll
    for (int j = 0; j < 4; ++j) { const int n = (lane >> 3) + 8 * j; const LAS float* s = scr + (8 * c) * 33 + n;
        u32x4 o; o.x = cvtpk(s[0 * 33], s[1 * 33]); o.y = cvtpk(s[2 * 33], s[3 * 33]); o.z = cvtpk(s[4 * 33], s[5 * 33]); o.w = cvtpk(s[6 * 33], s[7 * 33]);
        for (int cp = 0; cp < ncopy; ++cp) *(u32x4*)(WT + (size_t)(rsh + n) * ldk + cp * copy_stride + k0 + 8 * c) = o; }
    asm volatile("s_waitcnt lgkmcnt(0)" ::: "memory");
}
__device__ __forceinline__ void convert_weights(LAS unsigned char* lds, KP p, int l, int wv) {
    unsigned char* ws = p->ws;
    const int tid_ = otid(); const int lane = tid_ & 63, wid = tid_ >> 6;
    LAS float* scr = (LAS float*)(lds + wid * 8704);
    const int gw = blockIdx.x * 8 + wid, NGW = gridDim.x * 8;
    constexpr int I_IN = 16 * (DIN / 32), I_UQ = 6 * 24, I_UKV = 4 * 32, I_BR = 8 * 32, I_O = 16 * 32, I_F1 = 16 * 128, I_F2 = 64 * 32;
    constexpr int NIT = I_IN + I_UQ + I_UKV + 3 * I_BR + I_O + I_F1 + I_F2;
    const int BIG = 1 << 30;
    for (int it = gw; it < NIT; it += NGW) {
        int r = it;
        if (r < I_IN) { tr_item(p->w_in + (size_t)l * DM * DIN, DIN, (bf16_t*)(ws + WS_WIN), DM, 0, NGATE0, NPM - NGATE0, 1, 0, scr, r, lane); continue; } r -= I_IN;
        if (r < I_UQ) { const int nb = r % 24, hh = nb / 3, part = nb % 3, dest = part < 2 ? (2 * hh + part) * 32 : 512 + 32 * hh;
            tr_item(p->w_uq + (size_t)l * 384 * 768, 768, (bf16_t*)(ws + WS_WUQ), 384, dest - 32 * nb, BIG, 0, 1, 0, scr, r, lane); continue; } r -= I_UQ;
        if (r < I_UKV) { tr_item(p->w_ukv + (size_t)l * 256 * 1024, 1024, (bf16_t*)(ws + WS_WUKV), 256, 0, BIG, 0, 1, 0, scr, r, lane); continue; } r -= I_UKV;
        if (r < 3 * I_BR) { const int z3 = r / I_BR, z = z3 == 2 ? 3 : z3; tr_item(p->w_branch + ((size_t)l * 4 + z) * 512 * 1024, 1024, (bf16_t*)(ws + WS_WBR), 512, z * 1024, BIG, 0, 1, 0, scr, r % I_BR, lane); continue; } r -= 3 * I_BR;
        if (r < I_O) { tr_item(p->w_o + (size_t)l * DM * DM, DM, (bf16_t*)(ws + WS_WO4), 4096, 0, BIG, 0, 1, 0, scr, r, lane); continue; } r -= I_O;
        if (r < I_F1) { tr_item(p->w_ff1 + (size_t)l * DM * DFF, DFF, (bf16_t*)(ws + WS_WF1), DM, 0, BIG, 0, 1, 0, scr, r, lane); continue; } r -= I_F1;
        tr_item(p->w_ff2 + (size_t)l * DFF * DM, DM, (bf16_t*)(ws + WS_WF2), DFF, 0, BIG, 0, 1, 0, scr, r, lane);
    }
    { const int gt = blockIdx.x * 512 + otid(), NT = gridDim.x * 512; u32x4* z = (u32x4*)((bf16_t*)(ws + WS_WIN) + (size_t)NGATE0 * DM);
      unsigned z0 = 0u; asm volatile("" : "+v"(z0));
      for (int i = gt; i < (NPM - NGATE0) * DM / 8; i += NT) z[i] = (u32x4){z0, z0, z0, z0}; }
    { const float* wp = p->w_pool + (size_t)l * 4 * 128 * 128; const float* sp = p->s_pool + l * 512; const float* wb = p->w_branch + ((size_t)l * 4 + 2) * 512 * 1024;
      bf16_t* dst = (bf16_t*)(ws + WS_WBR) + (size_t)2048 * 512;
      LAS float* As = (LAS float*)lds;
      const int tid = otid();
      int gcur = -1;
      for (int it = blockIdx.x; it < 4 * 256; it += gridDim.x) {
          const int gi = it >> 8, d0 = (it & 255) * 4;
          if (gi != gcur) { __syncthreads();
              for (int i = tid; i < 128 * 128; i += 512) { const int cl = i >> 7, j = i & 127; As[cl * 129 + j] = wp[(size_t)gi * 16384 + i] * sp[gi * 128 + j]; }
              __syncthreads(); gcur = gi; }
          const int cl = tid & 127, d = d0 + __builtin_amdgcn_readfirstlane(tid >> 7);
          const float* br = wb + (size_t)gi * 128 * 1024 + d;
          float a = 0.f;
#pragma unroll 8
          for (int j = 0; j < 128; ++j) a += As[cl * 129 + j] * br[(size_t)j * 1024];
          dst[(size_t)d * 512 + gi * 128 + cl] = (bf16_t)(cvtpk(a, 0.f) & 0xffffu);
      }
      __syncthreads(); }
}
__device__ __forceinline__ void mod_phase(LAS unsigned char* lds, KP p, int wv) {
    LAS float* sv = (LAS float*)lds;
    LAS float* red = (LAS float*)(lds + 9 * 1024 * 4);
    const int tid = otid(), lane = tid & 63, wid = tid >> 6;
    for (int i = tid; i < 9 * 1024; i += 512) { const float v = i < 8192 ? p->c[i] : p->c_ctx[i - 8192]; sv[i] = v / (1.f + __expf(-v)); }
    __syncthreads();
    float* mod = (float*)(p->ws + WS_MOD);
    for (int it = blockIdx.x; it < DEPTH * 96; it += gridDim.x) {
        const int l = it / 96, n0 = (it % 96) * 64;
        const float* W = p->w_mod + (size_t)l * DM * 6144 + n0 + lane;
        float a[9];
#pragma unroll
        for (int r = 0; r < 9; ++r) a[r] = 0.f;
        for (int k = wid * 128; k < wid * 128 + 128; k += 8) { float w[8];
#pragma unroll
            for (int j = 0; j < 8; ++j) w[j] = W[(size_t)(k + j) * 6144];
#pragma unroll
            for (int r = 0; r < 9; ++r) { const f32x4 s0 = *(const LAS f32x4*)(sv + r * 1024 + k), s1 = *(const LAS f32x4*)(sv + r * 1024 + k + 4);
                a[r] += ((s0[0] * w[0] + s0[1] * w[1]) + (s0[2] * w[2] + s0[3] * w[3])) + ((s1[0] * w[4] + s1[1] * w[5]) + (s1[2] * w[6] + s1[3] * w[7])); } }
#pragma unroll
        for (int r = 0; r < 9; ++r) red[(wid * 9 + r) * 64 + lane] = a[r];
        __syncthreads();
        for (int o = tid; o < 9 * 64; o += 512) { const int r = o >> 6, n = o & 63; float s = p->b_mod[l * 6144 + n0 + n];
#pragma unroll
            for (int w = 0; w < 8; ++w) s += red[(w * 9 + r) * 64 + n];
            mod[((size_t)l * 9 + r) * 6144 + n0 + n] = s;
            const int nn = n0 + n, ch = nn >> 10, cc = nn & 1023;
            if (ch == 1) ((float*)(p->ws + WS_VM))[(((size_t)l * 2 + 0) * 9 + r) * DM + cc] = p->g1[l * DM + cc] * (1.f + s);
            if (ch == 4) ((float*)(p->ws + WS_VM))[(((size_t)l * 2 + 1) * 9 + r) * DM + cc] = p->g2[l * DM + cc] * (1.f + s); }
        __syncthreads();
    }
}
__device__ __forceinline__ void bias_gemv(LAS unsigned char* lds, KP p, int l, int wv) {
    LAS float* sv = (LAS float*)lds;
    LAS float* red = (LAS float*)(lds + 2 * 9 * 1024 * 4);
    const int tid = otid(), lane = tid & 63, wid = tid >> 6;
    const float* mod = (const float*)(p->ws + WS_MOD) + (size_t)l * 9 * 6144;
    __syncthreads();
    for (int i = tid; i < 2 * 9 * 1024; i += 512) { const int which = i / 9216, r = (i % 9216) >> 10, k = i & 1023; sv[i] = mod[(size_t)r * 6144 + (which ? 3 : 0) * 1024 + k]; }
    __syncthreads();
    constexpr int IT1 = (DIN + 63) / 64, IT2 = DFF / 64;
    for (int it = blockIdx.x; it < IT1 + IT2; it += gridDim.x) {
        const bool second = it >= IT1; const int n0 = (second ? it - IT1 : it) * 64; const int N = second ? DFF : DIN;
        const int col = n0 + lane; const bool on = col < N;
        const float* W = (second ? p->w_ff1 + (size_t)l * DM * DFF : p->w_in + (size_t)l * DM * DIN) + (on ? col : 0);
        const LAS float* s9 = sv + (second ? 9216 : 0);
        float a[9];
#pragma unroll
        for (int r = 0; r < 9; ++r) a[r] = 0.f;
        for (int k = wid * 128; k < wid * 128 + 128; k += 8) { float w[8];
#pragma unroll
            for (int j = 0; j < 8; ++j) w[j] = W[(size_t)(k + j) * N];
#pragma unroll
            for (int r = 0; r < 9; ++r) { const f32x4 s0 = *(const LAS f32x4*)(s9 + r * 1024 + k), s1 = *(const LAS f32x4*)(s9 + r * 1024 + k + 4);
                a[r] += ((s0[0] * w[0] + s0[1] * w[1]) + (s0[2] * w[2] + s0[3] * w[3])) + ((s1[0] * w[4] + s1[1] * w[5]) + (s1[2] * w[6] + s1[3] * w[7])); } }
#pragma unroll
        for (int r = 0; r < 9; ++r) red[(wid * 9 + r) * 64 + lane] = a[r];
        __syncthreads();
        for (int o = tid; o < 9 * 64; o += 512) { const int r = o >> 6, n = o & 63; const int c = n0 + n;
            if (c < N) { float s = 0.f;
#pragma unroll
                for (int w = 0; w < 8; ++w) s += red[(w * 9 + r) * 64 + n];
                if (second) ((float*)(p->ws + WS_BIAS2))[(size_t)r * DFF + c] = s;
                else ((float*)(p->ws + WS_BIAS1))[(size_t)r * NIN + (c < NGATE0 ? c : c + (NPM - NGATE0))] = s; } }
        __syncthreads();
    }
}
__device__ __forceinline__ void init_h(KP p, int wv) {
    const int tid_ = otid(); const int lane = tid_ & 63, wid = tid_ >> 6;
    const int gw = blockIdx.x * 8 + wid, NGW = gridDim.x * 8;
    const float* vm = (const float*)(p->ws + WS_VM);
    bf16_t* H = (bf16_t*)(p->ws + WS_H); float* part = (float*)(p->ws + WS_PART);
    for (int row = gw; row < MT; row += NGW) {
        const float* xr = row < MX ? p->x + (size_t)row * DM : p->ctx + (size_t)(row - MX) * DM;
        const float* vr = vm + (size_t)(row < MX ? (row >> 11) : 8) * DM;
        float s = 0.f;
#pragma unroll
        for (int j = 0; j < 4; ++j) { const int col = 4 * lane + 256 * j; const f32x4 v = *(const f32x4*)(xr + col); s += (v[0] * v[0] + v[1] * v[1]) + (v[2] * v[2] + v[3] * v[3]);
            *(u32x2*)(H + (size_t)row * DM + col) = pack4(v * *(const f32x4*)(vr + col)); }
        s = wave_sum(s);
        if (lane < 16) part[(size_t)row * 16 + lane] = lane == 0 ? s : 0.f;
    }
}
__device__ __forceinline__ void norm_phase(KP p, int l, int chunk, int nrows, int wv) {
    const int tid_ = otid(); const int lane = tid_ & 63, wid = tid_ >> 6;
    const int gw = blockIdx.x * 8 + wid, NGW = gridDim.x * 8;
    const float* g = (chunk == 0 ? p->g1 : p->g2) + l * DM;
    const float* mod = (const float*)(p->ws + WS_MOD) + (size_t)l * 9 * 6144;
    bf16_t* H = (bf16_t*)(p->ws + WS_H);
    for (int row = gw; row < nrows; row += NGW) {
        const float* xr = row < MX ? p->out + (size_t)row * DM : (const float*)(p->ws + WS_XC) + (size_t)(row - MX) * DM;
        const float* mr = mod + (size_t)(row < MX ? (row >> 11) : 8) * 6144 + chunk * 1024;
        f32x4 v[4]; float s = 0.f;
#pragma unroll
        for (int j = 0; j < 4; ++j) { v[j] = *(const f32x4*)(xr + 4 * lane + 256 * j); s += (v[j][0] * v[j][0] + v[j][1] * v[j][1]) + (v[j][2] * v[j][2] + v[j][3] * v[j][3]); }
        const float rs = rsq(wave_sum(s) * (1.f / DM) + EPS);
#pragma unroll
        for (int j = 0; j < 4; ++j) { const int col = 4 * lane + 256 * j; const f32x4 gv = *(const f32x4*)(g + col), sh = *(const f32x4*)(mr + col), sc = *(const f32x4*)(mr + 1024 + col);
            f32x4 o = (v[j] * rs * gv) * (1.f + sc) + sh; *(u32x2*)(H + (size_t)row * DM + col) = pack4(o); }
    }
}

__device__ __forceinline__ void prep1_phase(KP p, int l, int wv) {
    unsigned char* ws = p->ws;
    const int tid_ = otid(); const int lane = tid_ & 63, wid = tid_ >> 6;
    const int gw = blockIdx.x * 8 + wid, NGW = gridDim.x * 8;
    const bf16_t* __restrict__ Pm = (const bf16_t*)(ws + WS_R1);
    bf16_t* __restrict__ QA = (bf16_t*)(ws + WS_QA); bf16_t* __restrict__ KA = (bf16_t*)(ws + WS_KA); bf16_t* __restrict__ VA = (bf16_t*)(ws + WS_VA);
    bf16_t* __restrict__ CQ = (bf16_t*)(ws + WS_CQ); bf16_t* __restrict__ CKV = (bf16_t*)(ws + WS_CKV); bf16_t* __restrict__ KR = (bf16_t*)(ws + WS_KR); bf16_t* __restrict__ Y = (bf16_t*)(ws + WS_Y);
    f32x8 invA, invB, gq, gk, gcq, gckv, gkr;
#pragma unroll
    for (int e = 0; e < 8; ++e) { invA[e] = (lane & 1) ? INVA_REV[8 + e] : INVA_REV[e]; invB[e] = INVB_REV[e];
        gq[e] = p->gq_a[l * 64 + (lane & 7) * 8 + e] * CS_A; gk[e] = p->gk_a[l * 64 + (lane & 7) * 8 + e];
        gcq[e] = lane < 48 ? p->g_cq[l * 384 + 8 * lane + e] : 0.f; gckv[e] = lane < 32 ? p->g_ckv[l * 256 + 8 * lane + e] : 0.f; gkr[e] = lane < 4 ? p->gk_b[l * 96 + 64 + 8 * lane + e] : 0.f; }
    const float* wcv = p->w_conv + (size_t)l * 3 * 512 + 8 * lane;
#pragma unroll 2
    for (int row = gw; row < MT; row += NGW) {
        const bool isx = row < MX;
        const int b = isx ? (row >> 11) : ((row - MX) >> 8);
        const int t = isx ? (row & 2047) : ((row - MX) & 255);
        const int S = isx ? SEQ : CTX;
        const int arow = isx ? CTX + t : t;
        const bf16_t* pr = Pm + (size_t)row * NPM;
        f32x8 csA, snA, csB, snB;
        if (isx) { const float posA = (float)((lane & 2) ? (t & 63) : (t >> 6)); const float posB = (float)((lane & 1) ? (t & 63) : (t >> 6));
#pragma unroll
            for (int e = 0; e < 8; ++e) { const float a = posA * invA[e]; csA[e] = __builtin_amdgcn_cosf(a); snA[e] = __builtin_amdgcn_sinf(a); const float bq = posB * invB[e]; csB[e] = __builtin_amdgcn_cosf(bq); snB[e] = __builtin_amdgcn_sinf(bq); } }
        const u32x4 rq = ld16(pr + C_Q + 8 * lane), rk = ld16(pr + C_K + 8 * lane);
        const u32x4 rcq = ld16(pr + C_CQ + 8 * min(lane, 47)), rckv = ld16(pr + C_CKV + 8 * (lane & 31)), rkr = ld16(pr + C_KR + 8 * (lane & 3));
        const u32x4 rpb = ld16(pr + C_PB + 8 * lane), rpc = ld16(pr + C_PC + 8 * lane), rpx = ld16(pr + C_PX + 8 * lane);
        const bf16_t* prm = (t > 0) ? pr - NPM : pr; const bf16_t* prp = (t < S - 1) ? pr + NPM : pr;
        const float fm = (t > 0) ? 1.f : 0.f, fp = (t < S - 1) ? 1.f : 0.f;
        const u32x4 rpcm = ld16(prm + C_PC + 8 * lane), rpxm = ld16(prm + C_PX + 8 * lane), rpcp = ld16(prp + C_PC + 8 * lane), rpxp = ld16(prp + C_PX + 8 * lane);
        const int hw = 1 << (lane >> 4); const int lo = max(t - hw, 0), hi = min(t + hw, S);
        const bf16_t* pp = pr + C_POOL + 8 * lane;
        u32x4 pw[16]; float pvf[16];
#pragma unroll
        for (int j = 0; j < 16; ++j) { const int o = j - 8; const int tt = t + o; const bool v = (o >= -hw) && (o < hw) && (tt >= 0) && (tt < S); pw[j] = ld16(pp + (ptrdiff_t)(v ? o : 0) * NPM); pvf[j] = v ? 1.f : 0.f; }
        const u32x4 rpu = ld16(pp);
        asm volatile("" ::: "memory");
#pragma unroll
        for (int which = 0; which < 2; ++which) {
            f32x8 v = unpack8(which == 0 ? rq : rk);
            float ss = sum8(v); ss += shx<1>(ss); ss += shx<2>(ss); ss += shx<4>(ss);
            const float rs = rsq(ss * (1.f / 64.f) + EPS);
#pragma unroll
            for (int e = 0; e < 8; ++e) v[e] = v[e] * rs * (which == 0 ? gq[e] : gk[e]);
            if (isx) {
#pragma unroll
                for (int e = 0; e < 8; ++e) { const float o = shx<4>(v[e]); v[e] = (lane & 4) ? (o * snA[e] + v[e] * csA[e]) : (v[e] * csA[e] - o * snA[e]); } }
            bf16_t* dst = (which == 0 ? QA : KA) + ((size_t)(b * 8 + (lane >> 3)) * TK + arow) * 64 + (lane & 7) * 8;
            *(u32x4*)dst = pack8(v);
        }
        { f32x8 v = unpack8(rcq);
          if (lane >= 48) {
#pragma unroll
              for (int e = 0; e < 8; ++e) v[e] = 0.f; }
          const float rs = rsq(wave_sum(sum8(v)) * (1.f / 384.f) + EPS);
          if (lane < 48) {
#pragma unroll
              for (int e = 0; e < 8; ++e) v[e] = v[e] * rs * gcq[e];
              *(u32x4*)(CQ + (size_t)row * 384 + 8 * lane) = pack8(v); } }
        { f32x8 v = unpack8(rckv);
          if (lane >= 32) {
#pragma unroll
              for (int e = 0; e < 8; ++e) v[e] = 0.f; }
          const float rs = rsq(wave_sum(sum8(v)) * (1.f / 256.f) + EPS);
          if (lane < 32) {
#pragma unroll
              for (int e = 0; e < 8; ++e) v[e] = v[e] * rs * gckv[e];
              *(u32x4*)(CKV + (size_t)row * 256 + 8 * lane) = pack8(v); } }
        { f32x8 v = unpack8(rkr);
          float ss = sum8(v); ss += shx<1>(ss); ss += shx<2>(ss);
          const float rs = rsq(ss * (1.f / 32.f) + EPS);
#pragma unroll
          for (int e = 0; e < 8; ++e) v[e] = v[e] * rs * p->gk_b[l * 96 + 64 + 8 * (lane & 3) + e];
          if (isx) {
#pragma unroll
              for (int e = 0; e < 8; ++e) { const float o = shx<2>(v[e]); v[e] = (lane & 2) ? (o * snB[e] + v[e] * csB[e]) : (v[e] * csB[e] - o * snB[e]); } }
          if (lane < 4) *(u32x4*)(KR + (size_t)row * 32 + 8 * lane) = pack8(v); }
        { f32x8 sum;
#pragma unroll
          for (int e = 0; e < 8; ++e) sum[e] = 0.f;
#pragma unroll
          for (int j = 0; j < 16; ++j) sum += unpack8(pw[j]) * pvf[j];
          const float inv = 1.f / (float)(hi - lo);
          *(u32x4*)(Y + (size_t)row * 2048 + 1024 + 8 * lane) = pack8(sum * inv - unpack8(rpu)); }
        { const f32x8 pb = unpack8(rpb);
          const f32x8 uc = unpack8(rpc) * unpack8(rpx);
          const f32x8 um = unpack8(rpcm) * unpack8(rpxm) * fm, up = unpack8(rpcp) * unpack8(rpxp) * fp;
          f32x8 y;
#pragma unroll
          for (int e = 0; e < 8; ++e) y[e] = pb[e] * (um[e] * wcv[e] + uc[e] * wcv[512 + e] + up[e] * wcv[1024 + e]);
          *(u32x4*)(Y + (size_t)row * 2048 + 1536 + 8 * lane) = pack8(y); }
    }
}
__device__ __forceinline__ void prep2_phase(KP p, int l, int wv) {
    unsigned char* ws = p->ws;
    const int tid_ = otid(); const int lane = tid_ & 63, wid = tid_ >> 6;
    const int gw = blockIdx.x * 8 + wid, NGW = gridDim.x * 8;
    const bf16_t* __restrict__ QBR = (const bf16_t*)(ws + WS_QBR); const bf16_t* __restrict__ KVR = (const bf16_t*)(ws + WS_KVR); const bf16_t* __restrict__ KR = (const bf16_t*)(ws + WS_KR);
    bf16_t* __restrict__ QB = (bf16_t*)(ws + WS_QB); bf16_t* __restrict__ KB = (bf16_t*)(ws + WS_KB); bf16_t* __restrict__ VB = (bf16_t*)(ws + WS_VB);
    const int h = lane >> 3, sub = lane & 7;
    f32x8 gqn, gkn; f32x4 gqr, invB;
#pragma unroll
    for (int e = 0; e < 8; ++e) { gqn[e] = p->gq_b[l * 96 + sub * 8 + e]; gkn[e] = p->gk_b[l * 96 + sub * 8 + e]; }
#pragma unroll
    for (int e = 0; e < 4; ++e) { gqr[e] = p->gq_b[l * 96 + 64 + sub * 4 + e]; invB[e] = (sub & 1) ? INVB_REV[4 + e] : INVB_REV[e]; }
    for (int row0 = gw; row0 < MT; row0 += 3 * NGW) {
        u32x4 rqn[3], rkn[3], rvv[3]; u32x2 rqr[3], rkr[3];
#pragma unroll
        for (int q = 0; q < 3; ++q) { const int row = (row0 + q * NGW < MT) ? row0 + q * NGW : row0;
            const bf16_t* qr = QBR + (size_t)row * 768 + h * 96; const bf16_t* kr = KVR + (size_t)row * 1024 + h * 128;
            rqn[q] = ld16(qr + sub * 8); rqr[q] = *(const u32x2*)(qr + 64 + sub * 4); rkn[q] = ld16(kr + sub * 8); rvv[q] = ld16(kr + 64 + sub * 8); rkr[q] = *(const u32x2*)(KR + (size_t)row * 32 + sub * 4); }
        asm volatile("" ::: "memory");
#pragma unroll
        for (int q = 0; q < 3; ++q) { const int row = row0 + q * NGW;
            if (row < MT) {
                const bool isx = row < MX;
                const int b = isx ? (row >> 11) : ((row - MX) >> 8);
                const int t = isx ? (row & 2047) : ((row - MX) & 255);
                const int arow = isx ? CTX + t : t;
                const size_t ar = (size_t)(b * 8 + h) * TK + arow;
                f32x8 vn = unpack8(rqn[q]);
                f32x4 vr = unpack4(rqr[q]);
                float sn_ = sum8(vn); sn_ += shx<1>(sn_); sn_ += shx<2>(sn_); sn_ += shx<4>(sn_);
                float sr_ = (vr[0] * vr[0] + vr[1] * vr[1]) + (vr[2] * vr[2] + vr[3] * vr[3]); sr_ += shx<1>(sr_); sr_ += shx<2>(sr_); sr_ += shx<4>(sr_);
                const float rn = rsq(sn_ * (1.f / 64.f) + EPS), rr = rsq(sr_ * (1.f / 32.f) + EPS);
#pragma unroll
                for (int e = 0; e < 8; ++e) vn[e] = vn[e] * rn * gqn[e];
#pragma unroll
                for (int e = 0; e < 4; ++e) vr[e] = vr[e] * rr * gqr[e];
                if (isx) { const float pos = (float)((sub & 2) ? (t & 63) : (t >> 6));
#pragma unroll
                    for (int e = 0; e < 4; ++e) { const float a = pos * invB[e]; const float cs = __builtin_amdgcn_cosf(a), sn = __builtin_amdgcn_sinf(a); const float o = shx<4>(vr[e]);
                        vr[e] = (sub & 4) ? (o * sn + vr[e] * cs) : (vr[e] * cs - o * sn); } }
                *(u32x4*)(QB + ar * 96 + sub * 8) = pack8(vn);
                *(u32x2*)(QB + ar * 96 + 64 + sub * 4) = pack4(vr);
                f32x8 kn = unpack8(rkn[q]);
                float sk = sum8(kn); sk += shx<1>(sk); sk += shx<2>(sk); sk += shx<4>(sk);
                const float rk = rsq(sk * (1.f / 64.f) + EPS);
#pragma unroll
                for (int e = 0; e < 8; ++e) kn[e] = kn[e] * rk * gkn[e];
                *(u32x4*)(KB + ar * 96 + sub * 8) = pack8(kn);
                *(u32x2*)(KB + ar * 96 + 64 + sub * 4) = rkr[q];
                *(u32x4*)(VB + ar * 64 + sub * 8) = rvv[q];
            } }
    }
}

__device__ __forceinline__ void presum_phase(KP p, int nrows, int wv) {
    const bf16_t* __restrict__ Gm = (const bf16_t*)(p->ws + WS_R1);
    bf16_t* __restrict__ Sm = (bf16_t*)(p->ws + WS_MIX);
    const int gt = blockIdx.x * 512 + otid(), NT = gridDim.x * 512;
    const int total = nrows * 128;
    for (int i = gt; i < total; i += 4 * NT) {
        u32x4 a[4], b[4], c[4], d[4]; int idx[4];
#pragma unroll
        for (int q = 0; q < 4; ++q) { idx[q] = (i + q * NT < total) ? i + q * NT : i; const bf16_t* g = Gm + (size_t)(idx[q] >> 7) * 4096 + (idx[q] & 127) * 8;
            a[q] = ld16(g); b[q] = ld16(g + 1024); c[q] = ld16(g + 2048); d[q] = ld16(g + 3072); }
        asm volatile("" ::: "memory");
#pragma unroll
        for (int q = 0; q < 4; ++q) *(u32x4*)(Sm + (size_t)(idx[q] >> 7) * DM + (idx[q] & 127) * 8) = pack8((unpack8(a[q]) + unpack8(b[q])) + (unpack8(c[q]) + unpack8(d[q])));
    }
}

#define XB_TMO      128
#define XB_XCNT(j)  (256  + 64 * (j))
#define XB_XSUB(j)  (1280 + 64 * (j))
#define XB_XGEN(j)  (2304 + 64 * (j))
#define XB_TOP      3328
#define XB_TOPGEN   3392
#define XCD_BAR_WORDS 3456
#define XB_SPIN_CAP (1u << 22)
__device__ __forceinline__ unsigned xb_ld(unsigned* p)              { return __hip_atomic_load(p, __ATOMIC_RELAXED, __HIP_MEMORY_SCOPE_AGENT); }
__device__ __forceinline__ unsigned xb_add(unsigned* p, unsigned v) { return __hip_atomic_fetch_add(p, v, __ATOMIC_RELAXED, __HIP_MEMORY_SCOPE_AGENT); }
__device__ __forceinline__ unsigned xb_xcc_id() { return (unsigned)__builtin_amdgcn_s_getreg((3 << 11) | 20) & 0xFu; }
#define XB_SPIN(cond, bar) do { unsigned _sp = 0; while (cond) { __builtin_amdgcn_s_sleep(1); \
    if ((++_sp & 255u) == 0u) { if (xb_ld(&(bar)[XB_TMO])) break; if (_sp > XB_SPIN_CAP) { atomicAdd(&(bar)[XB_TMO], 1u); break; } } } } while (0)
struct XcdBarrier { unsigned* bar; unsigned x; volatile LAS unsigned* st; };
__device__ __forceinline__ XcdBarrier xcd_barrier_post(unsigned* bar, volatile LAS unsigned* st) {
    XcdBarrier b; b.bar = bar; b.x = xb_xcc_id(); b.st = st;
    if (threadIdx.x == 0) (void)xb_add(&bar[XB_XCNT(b.x)], 1u);
    return b;
}
__device__ __forceinline__ void xcd_barrier_complete(unsigned* bar, unsigned x, unsigned& nloc, unsigned& nx) {
    const unsigned G = gridDim.x * gridDim.y * gridDim.z;
    unsigned sum, cnt, mine, sp = 0u;
    for (;;) {
        sum = 0u; cnt = 0u; mine = 0u;
#pragma unroll
        for (unsigned j = 0; j < 16; ++j) { const unsigned c = xb_ld(&bar[XB_XCNT(j)]); sum += c; cnt += (c > 0u) ? 1u : 0u; mine = (j == x) ? c : mine; }
        if (sum == G) break;
        __builtin_amdgcn_s_sleep(1);
        if ((++sp & 255u) == 0u) { if (xb_ld(&bar[XB_TMO])) break; if (sp > XB_SPIN_CAP) { atomicAdd(&bar[XB_TMO], 1u); break; } }
    }
    nloc = mine > 0u ? mine : 1u; nx = cnt > 0u ? cnt : 1u;
}
__device__ __forceinline__ void xcd_barrier(const XcdBarrier& b, int wv) {
    asm volatile("s_waitcnt vmcnt(0)" ::: "memory");
    __syncthreads();
    if (otid() == 0) {
        unsigned* bar = b.bar; unsigned bx = b.x;
        asm volatile("" : "+s"(bar), "+s"(bx));
        __builtin_amdgcn_s_waitcnt(0);
        unsigned nloc = b.st[0], nx = b.st[1];
        if (nloc == 0u) { xcd_barrier_complete(bar, bx, nloc, nx); b.st[0] = nloc; b.st[1] = nx; }
        const unsigned old = xb_add(&bar[XB_XSUB(bx)], 1u);
        const unsigned gen = old / nloc;
        if (old + 1u == (gen + 1u) * nloc) {
            __builtin_amdgcn_fence(__ATOMIC_RELEASE, "agent");
            asm volatile("s_waitcnt vmcnt(0)" ::: "memory");
            const unsigned og = xb_add(&bar[XB_TOP], 1u);
            const unsigned tg = og / nx;
            if (og + 1u == (tg + 1u) * nx) xb_add(&bar[XB_TOPGEN], 1u);
            else XB_SPIN(xb_ld(&bar[XB_TOPGEN]) == tg, bar);
            __builtin_amdgcn_fence(__ATOMIC_ACQUIRE, "agent");
            xb_add(&bar[XB_XGEN(bx)], 1u);
            asm volatile("s_waitcnt vmcnt(0)" ::: "memory");
        } else {
            XB_SPIN(xb_ld(&bar[XB_XGEN(bx)]) == gen, bar);
            __builtin_amdgcn_fence(__ATOMIC_ACQUIRE, "agent");
            asm volatile("s_waitcnt vmcnt(0)" ::: "memory");
        }
    }
    __syncthreads();
}

constexpr int N_PHASES = 1 + DEPTH * 10;
constexpr int ATT_PROBE = -1;
constexpr int REP0 = 1, REP1 = 1, REP2 = 1, REP3 = 1, REP4 = 1, REP5 = 1, REP6 = 1, REP7 = 1, REP8 = 1, REP9 = 1;

#define PHASE_BEGIN KP p = (KP)__builtin_amdgcn_kernarg_segment_ptr(); asm volatile("" : "+s"(p)); unsigned char* ws = p->ws; const int G = gridDim.x, c = obid(); (void)G; (void)c; (void)ws;
__global__ void __launch_bounds__(512) mega(Params p_unused, int ph_lo, int ph_hi) {
    extern __shared__ __attribute__((aligned(16))) unsigned char lds_raw[];
    LAS unsigned char* lds = (LAS unsigned char*)lds_raw;
    cg::grid_group grid = cg::this_grid();
    const int wv = __builtin_amdgcn_readfirstlane((int)(threadIdx.x >> 6));
    { volatile LAS unsigned* st0 = (volatile LAS unsigned*)(lds + 131072); if (threadIdx.x == 0) { st0[0] = 0u; st0[1] = 0u; } __syncthreads(); }
    const XcdBarrier xbar = xcd_barrier_post((unsigned*)(((KP)__builtin_amdgcn_kernarg_segment_ptr())->ws + WS_BAR), (volatile LAS unsigned*)(lds + 131072));
    {   PHASE_BEGIN
        mod_phase(lds, p, wv);
        const int tid0 = otid();
        if (c == 0 && tid0 < 64) { const int lane = tid0;
            for (int l = 0; l < DEPTH; ++l) { const float* la = p->lam_a + l * 256; const float s1 = wave_sum(la[lane] * la[64 + lane]), s2 = wave_sum(la[128 + lane] * la[192 + lane]);
                const float li = l == 0 ? LAM_INIT[0] : (l == 1 ? LAM_INIT[1] : (l == 2 ? LAM_INIT[2] : LAM_INIT[3]));
                if (lane == 0) { ((float*)(ws + WS_LAM))[l] = __expf(s1) - __expf(s2) + li; ((float*)(ws + WS_LAM))[8 + l] = li; } } }
    }
    if (ph_hi == 0x7fffffff) grid.sync();
    xcd_barrier(xbar, wv);
    for (int l = 0; l < DEPTH; ++l) {
        const bool last = (l == DEPTH - 1);
        const int Mact = last ? MX : MT;
        for (int rep = 0; rep < REP0; ++rep) { PHASE_BEGIN
            if (rep) __syncthreads();
            convert_weights(lds, p, l, wv); bias_gemv(lds, p, l, wv); if (l == 0) init_h(p, wv); }
        xcd_barrier(xbar, wv);
        for (int rep = 0; rep < REP1; ++rep) { PHASE_BEGIN
            pg8::Gemm g{(const bf16_t*)(ws + WS_H), (const bf16_t*)(ws + WS_WIN), DM, DM, DM, 0, 0};
            pg8::Epi<1> E{(bf16_t*)(ws + WS_R1), NPM, NPM / 256, (bf16_t*)(ws + WS_R2), NPG, nullptr, nullptr, nullptr, nullptr, nullptr, nullptr, nullptr, (bf16_t*)(ws + WS_VA), nullptr, (const float*)(ws + WS_PART), (const float*)(ws + WS_BIAS1), NIN};
            pg8::StaticOrder S; S.init(MT, NIN, G, c);
            pg8::gemm_phase(lds, g, S, E, wv); }
        xcd_barrier(xbar, wv);
        for (int rep = 0; rep < REP2; ++rep) { PHASE_BEGIN prep1_phase(p, l, wv); }
        xcd_barrier(xbar, wv);
        for (int rep = 0; rep < REP3; ++rep) { PHASE_BEGIN
            { int k1 = 384; asm volatile("" : "+s"(k1));
              pg8::Gemm g{(const bf16_t*)(ws + WS_CQ), (const bf16_t*)(ws + WS_WUQ), k1, k1, k1, 0, 0};
              pg8::Epi<6> E{(bf16_t*)(ws + WS_QB), l, 0, nullptr, 0, nullptr, nullptr, nullptr, p->gq_b + l * 96, nullptr, nullptr, nullptr, nullptr, nullptr, nullptr, nullptr, 0};
              pg8::StaticOrder S; S.init(MT, 768, G, c);
              pg8::gemm_phase(lds, g, S, E, wv); }
            { int k2 = 256; asm volatile("" : "+s"(k2));
              pg8::Gemm g{(const bf16_t*)(ws + WS_CKV), (const bf16_t*)(ws + WS_WUKV), k2, k2, k2, 0, 0};
              pg8::Epi<7> E{(bf16_t*)(ws + WS_KB), l, 0, (bf16_t*)(ws + WS_VB), 0, (const bf16_t*)(ws + WS_KR), nullptr, nullptr, p->gk_b + l * 96, nullptr, nullptr, nullptr, nullptr, nullptr, nullptr, nullptr, 0};
              pg8::StaticOrder S; S.init(MT, 1024, G, (c + 40) % G);
              pg8::gemm_phase(lds, g, S, E, wv); } }
        xcd_barrier(xbar, wv);
        { PHASE_BEGIN attn_phase<0>(lds, p, l, wv); }
        if (ATT_PROBE >= 0) { PHASE_BEGIN __syncthreads(); attn_phase<(ATT_PROBE < 0 ? 0 : ATT_PROBE)>(lds, p, l, wv); }
        xcd_barrier(xbar, wv);
        for (int rep = 0; rep < REP6; ++rep) { PHASE_BEGIN
            pg8::Gemm g{(const bf16_t*)(ws + WS_Y), (const bf16_t*)(ws + WS_WBR), 512, 2048, 512, 2, 1024};
            pg8::Epi<2> E{(bf16_t*)(ws + WS_R1), 4096, 0, nullptr, 0, (const bf16_t*)(ws + WS_R2), nullptr, nullptr, nullptr, nullptr, nullptr, nullptr, nullptr, nullptr, nullptr, nullptr, 0};
            pg8::StaticOrder S; S.init(Mact, 4096, G, c);
            pg8::gemm_phase(lds, g, S, E, wv); }
        xcd_barrier(xbar, wv);
        { PHASE_BEGIN presum_phase(p, Mact, wv); }
        xcd_barrier(xbar, wv);
        for (int rep = 0; rep < REP7; ++rep) { PHASE_BEGIN
            pg8::Gemm g{(const bf16_t*)(ws + WS_MIX), (const bf16_t*)(ws + WS_WO4), DM, DM, 4096, 0, 0};
            pg8::Epi<3> E{nullptr, rep ? 12345 : 0, 0, nullptr, 0, nullptr, p->out, (float*)(ws + WS_XC), (const float*)(ws + WS_MOD) + (size_t)l * 9 * 6144 + 2 * 1024, l == 0 ? p->x : (const float*)p->out, l == 0 ? p->ctx : (const float*)(ws + WS_XC),
                          (const float*)(ws + WS_VM) + ((size_t)l * 2 + 1) * 9 * DM, (bf16_t*)(ws + WS_H), (float*)(ws + WS_PART), nullptr, nullptr, 0};
            pg8::StaticOrder S; S.init(Mact, DM, G, c);
            pg8::gemm_phase(lds, g, S, E, wv); }
        xcd_barrier(xbar, wv);
        for (int rep = 0; rep < REP8; ++rep) { PHASE_BEGIN
            pg8::Gemm g{(const bf16_t*)(ws + WS_H), (const bf16_t*)(ws + WS_WF1), DM, DM, DM, 0, 0};
            pg8::Epi<4> E{(bf16_t*)(ws + WS_R2), DFF, 0, nullptr, 0, nullptr, nullptr, nullptr, nullptr, nullptr, nullptr, nullptr, nullptr, nullptr, (const float*)(ws + WS_PART), (const float*)(ws + WS_BIAS2), DFF};
            pg8::StaticOrder S; S.init(Mact, DFF, G, c);
            pg8::gemm_phase(lds, g, S, E, wv); }
        xcd_barrier(xbar, wv);
        for (int rep = 0; rep < REP9; ++rep) { PHASE_BEGIN
            pg8::Gemm g{(const bf16_t*)(ws + WS_R2), (const bf16_t*)(ws + WS_WF2), DFF, DFF, DFF, 0, 0};
            pg8::Epi<3> E{nullptr, rep ? 12345 : 0, 0, nullptr, 0, nullptr, p->out, (float*)(ws + WS_XC), (const float*)(ws + WS_MOD) + (size_t)l * 9 * 6144 + 5 * 1024, (const float*)p->out, (const float*)(ws + WS_XC),
                          last ? nullptr : (const float*)(ws + WS_VM) + ((size_t)(l + 1) * 2 + 0) * 9 * DM, (bf16_t*)(ws + WS_H), (float*)(ws + WS_PART), nullptr, nullptr, 0};
            pg8::StaticOrder S; S.init(Mact, DM, G, c);
            pg8::gemm_phase(lds, g, S, E, wv); }
        if (!last) xcd_barrier(xbar, wv);
    }
}

extern "C" void kernel_launch(void* const* d_in, const int* in_sizes, int n_in, void* d_out, int out_size, void* d_ws, size_t ws_size, hipStream_t stream) {
    static int grid = 0;
    if (grid == 0) {
        if (n_in != 26 || out_size != MX * DM || ws_size < WS_END) { fprintf(stderr, "kernel_launch: unexpected problem (n_in %d out %d ws %zu)\n", n_in, out_size, ws_size); grid = -1; return; }
        int dev = 0, cus = 0, per_cu = 0;
        hipGetDevice(&dev); hipDeviceGetAttribute(&cus, hipDeviceAttributeMultiprocessorCount, dev);
        hipFuncSetAttribute((const void*)mega, hipFuncAttributeMaxDynamicSharedMemorySize, LDS_BYTES);
        hipOccupancyMaxActiveBlocksPerMultiprocessor(&per_cu, (const void*)mega, 512, LDS_BYTES);
        (void)hipGetLastError();
        grid = cus > 0 ? cus : 256;
        if (per_cu < 1) fprintf(stderr, "kernel_launch: occupancy query says %d blocks/CU\n", per_cu);
    }
    if (grid < 0) return;
    Params p{};
    const float** pp = (const float**)&p;
    for (int i = 0; i < 26; ++i) pp[i] = (const float*)d_in[i];
    p.out = (float*)d_out; p.ws = (unsigned char*)d_ws;
    if (hipMemsetAsync((char*)d_ws + WS_BAR, 0, XCD_BAR_WORDS * 4, stream) != hipSuccess) { fprintf(stderr, "memset failed\n"); return; }
#if MK_COOP
    int lo = 0, hi = N_PHASES;
    void* args[] = {&p, &lo, &hi};
    hipError_t e = hipLaunchCooperativeKernel((const void*)mega, dim3(grid), dim3(512), args, LDS_BYTES, stream);
    if (e != hipSuccess) fprintf(stderr, "cooperative launch failed: %s\n", hipGetErrorString(e));
#else
    for (int ph = 0; ph < N_PHASES; ++ph) hipLaunchKernelGGL(mega, dim3(grid), dim3(512), LDS_BYTES, stream, p, ph, ph + 1);
#endif
}
```

```cpp
#include <hip/hip_runtime.h>
#include <hip/hip_cooperative_groups.h>
#include <cstdio>
#include <cstdint>
namespace cg = cooperative_groups;

#ifndef PHM
#define PHM 0xffff
#endif
#ifndef MK_COOP
#define MK_COOP 1
#endif

#define LAS __attribute__((address_space(3)))
typedef unsigned short bf16_t;
typedef short bf16x8 __attribute__((ext_vector_type(8)));
typedef float f32x2 __attribute__((ext_vector_type(2)));
typedef float f32x4 __attribute__((ext_vector_type(4)));
typedef float f32x8 __attribute__((ext_vector_type(8)));
typedef float f32x16 __attribute__((ext_vector_type(16)));
typedef unsigned u32x2 __attribute__((ext_vector_type(2)));
typedef unsigned u32x4 __attribute__((ext_vector_type(4)));
typedef __bf16 bf16x2_t __attribute__((ext_vector_type(2)));

constexpr int DM = 1024, NB = 8, SEQ = 2048, DEPTH = 4, CTX = 256, TK = CTX + SEQ;
constexpr int MX = NB * SEQ, MC = NB * CTX, MT = MX + MC;
constexpr int DIN = 8352, NPM = 4352, NPG = 4096, NIN = NPM + NPG, DFF = 4096;
constexpr int NGATE0 = 4256;
constexpr float EPS = 1e-6f;
constexpr int C_Q = 0, C_K = 512, C_V = 1024, C_CQ = 1536, C_CKV = 1920, C_KR = 2176, C_POOL = 2208, C_PB = 2720, C_PC = 3232, C_PX = 3744;

constexpr size_t MiB = 1u << 20;
constexpr size_t WS_WIN = 0, WS_WUQ = 17 * MiB, WS_WUKV = 18 * MiB, WS_WBR = 19 * MiB, WS_WO4 = 23 * MiB, WS_WF1 = 31 * MiB, WS_WF2 = 39 * MiB;
constexpr size_t WS_MOD = 48 * MiB, WS_LAM = 49 * MiB, WS_KR = 50 * MiB;
constexpr size_t WS_BAR = 51 * MiB + 512 * 1024;
constexpr size_t WS_XC = 52 * MiB;
constexpr size_t WS_Y = 60 * MiB, WS_H = WS_Y;
constexpr size_t WS_MIX = WS_Y + 36 * MiB;
constexpr size_t WS_QA = 132 * MiB, WS_KA = 150 * MiB, WS_VA = 168 * MiB;
constexpr size_t WS_CQ = 186 * MiB, WS_CKV = 200 * MiB;
constexpr size_t WS_R1 = 209 * MiB;
constexpr size_t WS_QBR = WS_R1, WS_KVR = WS_R1 + 27 * MiB, WS_QB = WS_R1 + 63 * MiB, WS_KB = WS_R1 + 90 * MiB, WS_VB = WS_R1 + 117 * MiB;
constexpr size_t WS_R2 = 362 * MiB;
constexpr size_t WS_VM = 49 * MiB + 4096, WS_BIAS1 = 49 * MiB + 512 * 1024, WS_BIAS2 = 49 * MiB + 832 * 1024;
constexpr size_t WS_PART = 506 * MiB;
constexpr size_t WS_END = 508 * MiB;
constexpr int LDS_BYTES = 131072 + 1024 + 10 * 2048;

struct Params {
    const float *x, *c, *ctx, *c_ctx, *w_mod, *b_mod, *g1, *g2, *w_in, *gq_a, *gk_a, *lam_a, *g_sub, *g_cq, *w_uq, *g_ckv, *w_ukv, *gq_b, *gk_b,
        *w_pool, *s_pool, *w_conv, *w_branch, *w_o, *w_ff1, *w_ff2;
    float* out; unsigned char* ws;
};

typedef const __attribute__((address_space(4))) Params* KP;
__device__ __forceinline__ unsigned cvtpk(float lo, float hi) { f32x2 v = {lo, hi}; bf16x2_t b = __builtin_convertvector(v, bf16x2_t); return __builtin_bit_cast(unsigned, b); }
__device__ __forceinline__ f32x8 unpack8(u32x4 w) {
    f32x8 r;
    r[0] = __uint_as_float(w.x << 16); r[1] = __uint_as_float(w.x & 0xffff0000u); r[2] = __uint_as_float(w.y << 16); r[3] = __uint_as_float(w.y & 0xffff0000u);
    r[4] = __uint_as_float(w.z << 16); r[5] = __uint_as_float(w.z & 0xffff0000u); r[6] = __uint_as_float(w.w << 16); r[7] = __uint_as_float(w.w & 0xffff0000u);
    return r;
}
__device__ __forceinline__ f32x4 unpack4(u32x2 w) {
    f32x4 r; r[0] = __uint_as_float(w.x << 16); r[1] = __uint_as_float(w.x & 0xffff0000u); r[2] = __uint_as_float(w.y << 16); r[3] = __uint_as_float(w.y & 0xffff0000u); return r;
}
__device__ __forceinline__ u32x4 pack8(f32x8 v) { u32x4 w; w.x = cvtpk(v[0], v[1]); w.y = cvtpk(v[2], v[3]); w.z = cvtpk(v[4], v[5]); w.w = cvtpk(v[6], v[7]); return w; }
__device__ __forceinline__ u32x2 pack4(f32x4 v) { u32x2 w; w.x = cvtpk(v[0], v[1]); w.y = cvtpk(v[2], v[3]); return w; }
__device__ __forceinline__ u32x4 ld16(const bf16_t* p) { return *(const u32x4*)p; }
template <int O> __device__ __forceinline__ float shx(float v) {
    if constexpr (O < 32) return __builtin_bit_cast(float, __builtin_amdgcn_ds_swizzle(__builtin_bit_cast(int, v), (O << 10) | 0x1f));
    else { auto rr = __builtin_amdgcn_permlane32_swap(__builtin_bit_cast(unsigned, v), __builtin_bit_cast(unsigned, v), false, false);
           const float a = __builtin_bit_cast(float, (unsigned)rr[0]), b = __builtin_bit_cast(float, (unsigned)rr[1]); return a == v ? b : a; }
}
__device__ __forceinline__ float xsum32(float v) { auto rr = __builtin_amdgcn_permlane32_swap(__builtin_bit_cast(unsigned, v), __builtin_bit_cast(unsigned, v), false, false);
    return __builtin_bit_cast(float, (unsigned)rr[0]) + __builtin_bit_cast(float, (unsigned)rr[1]); }
__device__ __forceinline__ float xmax32(float v) { auto rr = __builtin_amdgcn_permlane32_swap(__builtin_bit_cast(unsigned, v), __builtin_bit_cast(unsigned, v), false, false);
    return fmaxf(__builtin_bit_cast(float, (unsigned)rr[0]), __builtin_bit_cast(float, (unsigned)rr[1])); }
__device__ __forceinline__ float wave_sum(float v) {
    v += shx<1>(v); v += shx<2>(v); v += shx<4>(v); v += shx<8>(v); v += shx<16>(v); return xsum32(v);
}
__device__ __forceinline__ float sum8(f32x8 v) { return ((v[0] * v[0] + v[1] * v[1]) + (v[2] * v[2] + v[3] * v[3])) + ((v[4] * v[4] + v[5] * v[5]) + (v[6] * v[6] + v[7] * v[7])); }
__device__ __forceinline__ int olane() { int l; asm volatile("v_mbcnt_lo_u32_b32 %0, -1, 0\n\tv_mbcnt_hi_u32_b32 %0, -1, %0" : "=v"(l)); return l; }
#define otid() ((wv << 6) | olane())
__device__ __forceinline__ int obid() { int t = blockIdx.x; asm volatile("" : "+s"(t)); return t; }
__device__ __forceinline__ float rsq(float x) { return __builtin_amdgcn_rsqf(x); }

__device__ constexpr float INVA_REV[16] = {1.591549431e-01f, 8.949940161e-02f, 5.032921210e-02f, 2.830219583e-02f, 1.591549431e-02f, 8.949940161e-03f, 5.032921210e-03f, 2.830219583e-03f, 1.591549431e-03f, 8.949940161e-04f, 5.032921210e-04f, 2.830219583e-04f, 1.591549431e-04f, 8.949940161e-05f, 5.032921210e-05f, 2.830219583e-05f};
__device__ constexpr float INVB_REV[8] = {1.591549431e-01f, 5.032921210e-02f, 1.591549431e-02f, 5.032921210e-03f, 1.591549431e-03f, 5.032921210e-04f, 1.591549431e-04f, 5.032921210e-05f};
__device__ constexpr float LAM_INIT[4] = {2.000000000e-01f, 3.555090676e-01f, 4.707130183e-01f, 5.560582042e-01f};

constexpr float CS_A = 0.125f * 1.4426950408889634f, CS_B = 0.10206207261596577f * 1.4426950408889634f;

namespace pg8 {
constexpr int BM = 256, BK = 64, HALF = 128, HTB = HALF * BK * 2, STAGE_BYTES = 8 * HTB, NXCD = 8, WGM = 8;
__host__ __device__ __forceinline__ int lds_byte(int r, int c) { const int st = (r >> 4) * 2 + (c >> 5), rr = r & 15, cc = c & 31, ob = rr * 64 + cc * 2; return st * 1024 + (ob ^ (((ob >> 9) & 1) << 5)); }
__host__ __device__ __forceinline__ void stage_rc(int b, int& R, int& C) { const int st = b / 1024, sb = b % 1024, swz = sb ^ (((sb >> 9) & 1) << 5); R = (st >> 1) * 16 + swz / 64; C = (st & 1) * 32 + (swz % 64) / 2; }
__host__ __device__ __forceinline__ int perm32(int rho) { const int n = rho >> 4, i = rho & 15; return 8 * (i >> 2) + 4 * n + (i & 3); }

struct Unit { int pm, pn; };
struct Gemm { const bf16_t* A; const bf16_t* Bt; int K, lda, ldb, zshift; size_t zA; };

struct StaticOrder {
    int nM, nN, nwg, G, c;
    __device__ void init(int M, int N, int G_, int c_) { nM = M / BM; nN = N / BM; nwg = nM * nN; G = G_; c = c_; }
    __device__ bool next(int i, Unit& u) const {
        const long L = (long)i * G + c; if (L >= nwg) return false;
        int wgid = (int)L; { const int q = nwg / NXCD, r = nwg % NXCD, xcd = wgid % NXCD, off = wgid / NXCD; wgid = (xcd < r ? xcd * (q + 1) : r * (q + 1) + (xcd - r) * q) + off; }
        const int nig = WGM * nN, gid = wgid / nig, fm = gid * WGM, gsz = (nM - fm) < WGM ? (nM - fm) : WGM;
        u.pm = fm + ((wgid % nig) % gsz); u.pn = (wgid % nig) / gsz; return true;
    }
};

template <int MODE> struct Epi {
    static constexpr bool PERM = true, TAB = (MODE == 1 || MODE == 4);
    bf16_t* O; int ldc; int split_tile; bf16_t* O2; int ldc2;
    const bf16_t* gate;
    float* xo; float* xc; const float* mod; const float* xi; const float* xci;
    const float* vm; bf16_t* Hout; float* part;
    const float* partr; const float* bias; int bias_ld;
    __device__ __forceinline__ void operator()(const f32x4 (&acc)[2][2][4][2], const Unit& u, int wr, int wc, int fr, int fq, const LAS float* tab) const {
        const int ln_ = olane(); const int fr_ = ln_ & 15, fq_ = ln_ >> 4; (void)fr; (void)fq;
        const int row0 = u.pm * BM + wr * 64 + fr_;
        const int ct = u.pn * BM + wc * 32 + 8 * fq_;
        if constexpr (MODE == 0 || MODE == 1 || MODE == 4) {
            bf16_t* base = O; int ld = ldc; int c0 = ct;
            if (MODE == 1 && u.pn >= split_tile) { base = O2; ld = ldc2; c0 = ct - split_tile * BM; }
            float rs[8];
#pragma unroll
            for (int i = 0; i < 8; ++i) rs[i] = 1.f;
            if (MODE != 0) {
#pragma unroll
                for (int i = 0; i < 8; ++i) rs[i] = tab[wr * 64 + fr_ + (i >> 2) * HALF + (i & 3) * 16]; }
#pragma unroll
            for (int bj = 0; bj < 2; ++bj) {
                f32x4 b0 = {0.f, 0.f, 0.f, 0.f}, b1 = b0;
                if (MODE != 0) { const LAS float* bp = tab + 256 + wc * 32 + 8 * fq_ + bj * HALF; b0 = *(const LAS f32x4*)bp; b1 = *(const LAS f32x4*)(bp + 4); }
#pragma unroll
                for (int i = 0; i < 8; ++i) { const int ai = i >> 2, m = i & 3; bf16_t* rowp = base + (size_t)(row0 + ai * HALF + m * 16) * ld + c0;
                    if (MODE == 1 && (u.pn == 4 || u.pn == 5)) {
                        const bool isx = u.pm < MX / BM; const int bb = isx ? (u.pm >> 3) : (u.pm - MX / BM), ar0 = isx ? CTX + (u.pm & 7) * BM : 0;
                        rowp = Hout + ((size_t)(bb * 4 + 2 * (u.pn - 4) + bj) * TK + ar0 + wr * 64 + fr_ + ai * HALF + m * 16) * 128 + wc * 32 + 8 * fq_ - bj * HALF; }
                    f32x4 v0 = acc[ai][bj][m][0], v1 = acc[ai][bj][m][1];
                    if (MODE != 0) { v0 = v0 * rs[i] + b0; v1 = v1 * rs[i] + b1; }
                    if (MODE == 4) {
#pragma unroll
                        for (int e = 0; e < 4; ++e) { float a = fmaxf(v0[e], 0.f), b = fmaxf(v1[e], 0.f); v0[e] = a * a; v1[e] = b * b; } }
                    u32x4 w; w.x = cvtpk(v0[0], v0[1]); w.y = cvtpk(v0[2], v0[3]); w.z = cvtpk(v1[0], v1[1]); w.w = cvtpk(v1[2], v1[3]);
                    *(u32x4*)(rowp + bj * HALF) = w; } }
        } else if constexpr (MODE == 6 || MODE == 7) {
            LAS float* xb = (LAS float*)tab;
            const bool isx = u.pm < MX / BM;
            const int b = isx ? (u.pm >> 3) : (u.pm - MX / BM);
            const int arow0 = isx ? CTX + (u.pm & 7) * BM : 0, t0 = (u.pm & 7) * BM;
            const int lr0 = wr * 64 + fr_;
#pragma unroll
            for (int bj = 0; bj < 2; ++bj)
#pragma unroll
                for (int i = 0; i < 8; ++i) { const f32x4 v0 = acc[i >> 2][bj][i & 3][0], v1 = acc[i >> 2][bj][i & 3][1];
                    float s = ((v0[0] * v0[0] + v0[1] * v0[1]) + (v0[2] * v0[2] + v0[3] * v0[3])) + ((v1[0] * v1[0] + v1[1] * v1[1]) + (v1[2] * v1[2] + v1[3] * v1[3]));
                    s += shx<16>(s); s = xsum32(s);
                    if (fq_ == 0) xb[((lr0 + (i >> 2) * HALF + (i & 3) * 16) * 2 + bj) * 4 + wc] = s; }
            asm volatile("s_waitcnt lgkmcnt(0)" ::: "memory"); __builtin_amdgcn_s_barrier(); asm volatile("" ::: "memory");
            const bool rope_tile = (MODE == 6) && (u.pn == 2);
            const bool vwave = (MODE == 7) && (wc >= 2);
#pragma unroll
            for (int bj = 0; bj < 2; ++bj) {
                const int h = (MODE == 7) ? (2 * u.pn + bj) : (rope_tile ? (4 * bj + wc) : (4 * u.pn + 2 * bj + (wc >> 1)));
                const size_t hb = (size_t)(b * 8 + h) * TK + arow0;
                f32x8 gn;
#pragma unroll
                for (int e = 0; e < 8; ++e) gn[e] = mod[(rope_tile ? 64 : (wc & 1) * 32) + 8 * fq_ + e] * (MODE == 6 ? CS_B : 1.f);
#pragma unroll
                for (int i = 0; i < 8; ++i) { const int lr = lr0 + (i >> 2) * HALF + (i & 3) * 16; const f32x4 v0 = acc[i >> 2][bj][i & 3][0], v1 = acc[i >> 2][bj][i & 3][1];
                    f32x8 v; v[0] = v0[0]; v[1] = v0[1]; v[2] = v0[2]; v[3] = v0[3]; v[4] = v1[0]; v[5] = v1[1]; v[6] = v1[2]; v[7] = v1[3];
                    if (vwave) {
                        *(u32x4*)(O2 + (hb + lr) * 64 + (wc - 2) * 32 + 8 * fq_) = pack8(v);
                        if (wc == 2) *(u32x4*)(O + (hb + lr) * 96 + 64 + 8 * fq_) = ld16(gate + (size_t)(u.pm * BM + lr) * 32 + 8 * fq_);
                    } else if (rope_tile) {
                        const float rs = rsq(xb[((lr * 2 + bj) * 4 + wc)] * (1.f / 32.f) + EPS);
#pragma unroll
                        for (int e = 0; e < 8; ++e) v[e] = v[e] * rs * gn[e];
                        if (isx) { const int t = t0 + lr; const float pos = (float)((fq_ & 1) ? (t & 63) : (t >> 6));
#pragma unroll
                            for (int e = 0; e < 8; ++e) { const float a = pos * INVB_REV[e]; const float cs = __builtin_amdgcn_cosf(a), sn = __builtin_amdgcn_sinf(a); const float o = shx<32>(v[e]);
                                v[e] = (fq_ & 2) ? (o * sn + v[e] * cs) : (v[e] * cs - o * sn); } }
                        *(u32x4*)(O + (hb + lr) * 96 + 64 + 8 * fq_) = pack8(v);
                    } else {
                        const LAS float* xp = xb + ((lr * 2 + bj) * 4 + (wc & 2));
                        const float rs = rsq((xp[0] + xp[1]) * (1.f / 64.f) + EPS);
#pragma unroll
                        for (int e = 0; e < 8; ++e) v[e] = v[e] * rs * gn[e];
                        *(u32x4*)(O + (hb + lr) * 96 + (wc & 1) * 32 + 8 * fq_) = pack8(v);
                    } } }
            asm volatile("s_waitcnt lgkmcnt(0)" ::: "memory"); __builtin_amdgcn_s_barrier(); asm volatile("" ::: "memory");
        } else if constexpr (MODE == 2) {
#pragma unroll
            for (int bj = 0; bj < 2; ++bj) {
                u32x4 gw[8];
#pragma unroll
                for (int i = 0; i < 8; ++i) gw[i] = ld16(gate + (size_t)(row0 + (i >> 2) * HALF + (i & 3) * 16) * NPG + ct + bj * HALF);
#pragma unroll
                for (int i = 0; i < 8; ++i) { const int ai = i >> 2, m = i & 3; const size_t off = (size_t)(row0 + ai * HALF + m * 16) * NPG + ct + bj * HALF;
                    const f32x8 g = unpack8(gw[i]); const f32x4 v0 = acc[ai][bj][m][0], v1 = acc[ai][bj][m][1]; f32x8 o;
#pragma unroll
                    for (int e = 0; e < 8; ++e) { const float sg = __builtin_amdgcn_rcpf(1.f + __builtin_amdgcn_exp2f(-1.4426950408889634f * g[e])); o[e] = (e < 4 ? v0[e & 3] : v1[e & 3]) * sg; }
                    *(u32x4*)(O + off) = pack8(o); } }
        } else if (MODE == 3 && ldc != 12345) {
            const int R = u.pm * BM;
            float* xb = (R < MX) ? xo + (size_t)R * DM : xc + (size_t)(R - MX) * DM;
            const float* xr = (R < MX) ? xi + (size_t)R * DM : xci + (size_t)(R - MX) * DM;
            const int mr = (R < MX) ? (R >> 11) : 8;
            float ss[8];
#pragma unroll
            for (int i = 0; i < 8; ++i) ss[i] = 0.f;
#pragma unroll
            for (int bj = 0; bj < 2; ++bj) {
                const float* gp = mod + (size_t)mr * 6144 + ct + bj * HALF; const f32x4 g0 = *(const f32x4*)gp, g1 = *(const f32x4*)(gp + 4);
                f32x4 w0 = {0.f, 0.f, 0.f, 0.f}, w1 = w0;
                if (vm) { const float* vp = vm + (size_t)mr * DM + ct + bj * HALF; w0 = *(const f32x4*)vp; w1 = *(const f32x4*)(vp + 4); }
#pragma unroll
                for (int hb = 0; hb < 2; ++hb) {
                    f32x4 xa[4], xbv[4];
#pragma unroll
                    for (int q = 0; q < 4; ++q) { const int i = hb * 4 + q; const int lr = wr * 64 + fr_ + (i >> 2) * HALF + (i & 3) * 16; const float* xp = xr + (size_t)lr * DM + ct + bj * HALF; xa[q] = *(const f32x4*)xp; xbv[q] = *(const f32x4*)(xp + 4); }
#pragma unroll
                    for (int q = 0; q < 4; ++q) { const int i = hb * 4 + q; const int ai = i >> 2, m = i & 3; const int lr = wr * 64 + fr_ + ai * HALF + m * 16; float* xp = xb + (size_t)lr * DM + ct + bj * HALF;
                        f32x4 xv0 = xa[q] + g0 * acc[ai][bj][m][0], xv1 = xbv[q] + g1 * acc[ai][bj][m][1];
                        *(f32x4*)xp = xv0; *(f32x4*)(xp + 4) = xv1;
                        if (vm) { ss[i] += ((xv0[0] * xv0[0] + xv0[1] * xv0[1]) + (xv0[2] * xv0[2] + xv0[3] * xv0[3])) + ((xv1[0] * xv1[0] + xv1[1] * xv1[1]) + (xv1[2] * xv1[2] + xv1[3] * xv1[3]));
                            const f32x4 h0 = xv0 * w0, h1 = xv1 * w1; u32x4 w; w.x = cvtpk(h0[0], h0[1]); w.y = cvtpk(h0[2], h0[3]); w.z = cvtpk(h1[0], h1[1]); w.w = cvtpk(h1[2], h1[3]);
                            *(u32x4*)(Hout + (size_t)(R + lr) * DM + ct + bj * HALF) = w; } } } }
            if (vm) {
#pragma unroll
                for (int i = 0; i < 8; ++i) { float s = ss[i]; s += shx<16>(s); s = xsum32(s); const int lr = wr * 64 + fr_ + (i >> 2) * HALF + (i & 3) * 16;
                    if (fq_ == 0) part[(size_t)(R + lr) * 16 + u.pn * 4 + wc] = s; } }
        }
    }
};

template <class EpiT, class Sched>
__device__ __forceinline__ void gemm_phase(LAS unsigned char* lds, const Gemm g, const Sched& S, const EpiT& E, int wv) {
    LAS float* tab = (LAS float*)(lds + STAGE_BYTES + 1024);
    const int tid = otid(), wid = __builtin_amdgcn_readfirstlane(tid >> 6), lane = tid & 63, wr = wid >> 2, wc = wid & 3, fr = lane & 15, fq = lane >> 4;
    const int K = g.K, nt = K / BK;
    unsigned voffA[2], voffB[2];
#pragma unroll
    for (int i = 0; i < 2; ++i) { int R, C; stage_rc(tid * 16 + i * 8192, R, C); const int Rb = EpiT::PERM ? ((R & ~31) + perm32(R & 31)) : R;
        voffA[i] = (unsigned)(R * g.lda + C) * 2u; voffB[i] = (unsigned)(Rb * g.ldb + C) * 2u; }
    const size_t kstep = (size_t)(BK * 2);
    const size_t hstepA = (size_t)HALF * g.lda * 2, hstepB = (size_t)HALF * g.ldb * 2;
    const size_t tstepA = 2 * hstepA, tstepB = 2 * hstepB;
    const unsigned ldsw = (unsigned)wid * 1024u;
    const int foff = lds_byte(fr, fq * 8);
    const int aoff = wr * 8192 + foff, boff = wc * 4096 + foff;
#define PG8_SA(b, h) (((b) * 2 + (h)) * HTB)
#define PG8_SB(b, h) ((4 + (b) * 2 + (h)) * HTB)
#define PG8_STAGE(bufoff, gbase, voff) do { _Pragma("unroll") for (int _i = 0; _i < 2; ++_i) \
        __builtin_amdgcn_global_load_lds((const unsigned*)((const char*)(gbase) + (voff)[_i]), (LAS unsigned*)(lds + (bufoff) + ldsw + _i * 8192), 16, 0, 0); } while (0)
#define PG8_LDA(dst, b, h) do { _Pragma("unroll") for (int m = 0; m < 4; ++m) _Pragma("unroll") for (int k = 0; k < 2; ++k) dst[m][k] = *(const LAS bf16x8*)(lds + PG8_SA(b, h) + aoff + m * 2048 + k * 1024); } while (0)
#define PG8_LDB(dst, b, h) do { _Pragma("unroll") for (int n = 0; n < 2; ++n) _Pragma("unroll") for (int k = 0; k < 2; ++k) dst[n][k] = *(const LAS bf16x8*)(lds + PG8_SB(b, h) + boff + n * 2048 + k * 1024); } while (0)
#define PG8_MMA(ai, bj, At, Bt) do { __builtin_amdgcn_s_setprio(1); _Pragma("unroll") for (int m = 0; m < 4; ++m) _Pragma("unroll") for (int n = 0; n < 2; ++n) _Pragma("unroll") for (int k = 0; k < 2; ++k) \
        acc[ai][bj][m][n] = __builtin_amdgcn_mfma_f32_16x16x32_bf16(Bt[n][k], At[m][k], acc[ai][bj][m][n], 0, 0, 0); __builtin_amdgcn_s_setprio(0); } while (0)
#define PG8_WAIT_V(n) asm volatile("s_waitcnt vmcnt(" #n ")" ::: "memory")
#define PG8_WAIT_L(n) asm volatile("s_waitcnt lgkmcnt(" #n ")" ::: "memory")
#define PG8_BAR __builtin_amdgcn_s_barrier()
#define PG8_SCHED __builtin_amdgcn_sched_barrier(0)
    Unit cur, nxt; int ui = 0;
    if (!S.next(0, cur)) return;
    if constexpr (EpiT::TAB) {
        Unit tu;
        for (int i = 0; S.next(i, tu); ++i) {
            if (tid < 256) { const f32x4* pp = (const f32x4*)(E.partr + (size_t)(tu.pm * BM + tid) * 16); const f32x4 p0 = pp[0], p1 = pp[1], p2 = pp[2], p3 = pp[3];
                const f32x4 ps = (p0 + p1) + (p2 + p3); tab[i * 512 + tid] = rsq(((ps[0] + ps[1]) + (ps[2] + ps[3])) * (1.f / DM) + EPS); }
            else { const int mr = (tu.pm * BM < MX) ? ((tu.pm * BM) >> 11) : 8; tab[i * 512 + tid] = E.bias[(size_t)mr * E.bias_ld + tu.pn * BM + (tid - 256)]; }
        }
        __syncthreads();
    }
    f32x4 acc[2][2][4][2];
#pragma unroll
    for (int a = 0; a < 2; ++a)
#pragma unroll
        for (int b = 0; b < 2; ++b)
#pragma unroll
            for (int m = 0; m < 4; ++m)
#pragma unroll
                for (int n = 0; n < 2; ++n) acc[a][b][m][n] = (f32x4){0.f, 0.f, 0.f, 0.f};
    bf16x8 At[4][2], B0[2][2], B1[2][2];
    const char* cA = (const char*)g.A + (size_t)cur.pm * tstepA + (size_t)(cur.pn >> g.zshift) * g.zA; const char* cB = (const char*)g.Bt + (size_t)cur.pn * tstepB;
    PG8_STAGE(PG8_SB(0, 0), cB, voffB); PG8_STAGE(PG8_SB(0, 1), cB + hstepB, voffB); PG8_STAGE(PG8_SA(0, 0), cA, voffA); PG8_STAGE(PG8_SA(0, 1), cA + hstepA, voffA);
    if (wr == 1) PG8_BAR;
    PG8_WAIT_V(2); PG8_BAR;
    PG8_STAGE(PG8_SB(1, 0), cB + kstep, voffB); PG8_STAGE(PG8_SA(1, 0), cA + kstep, voffA); PG8_STAGE(PG8_SB(1, 1), cB + hstepB + kstep, voffB);
    PG8_WAIT_V(6); PG8_BAR;
    for (;;) {
        const bool has_next = S.next(ui + 1, nxt);
        const char* nA = has_next ? (const char*)g.A + (size_t)nxt.pm * tstepA + (size_t)(nxt.pn >> g.zshift) * g.zA : cA; const char* nB = has_next ? (const char*)g.Bt + (size_t)nxt.pn * tstepB : cB;
        for (int t = 0; t < nt; t += 2) {
            const bool last = (t == nt - 2);
            const char* a1 = cA + (size_t)(t + 1) * kstep;
            const char* a2 = last ? nA : cA + (size_t)(t + 2) * kstep; const char* b2 = last ? nB : cB + (size_t)(t + 2) * kstep;
            const char* a3 = a2 + kstep; const char* b3 = b2 + kstep;
            PG8_LDB(B0, 0, 0); PG8_LDB(B1, 0, 1); PG8_SCHED; PG8_LDA(At, 0, 0); PG8_STAGE(PG8_SA(1, 1), a1 + hstepA, voffA);
            PG8_WAIT_V(8); PG8_WAIT_L(0); PG8_BAR; PG8_MMA(0, 0, At, B0); PG8_MMA(0, 1, At, B1); PG8_BAR; PG8_SCHED;
            PG8_LDA(At, 0, 1); PG8_STAGE(PG8_SB(0, 0), b2, voffB); PG8_STAGE(PG8_SB(0, 1), b2 + hstepB, voffB); PG8_STAGE(PG8_SA(0, 0), a2, voffA);
            PG8_WAIT_V(8); PG8_WAIT_L(0); PG8_BAR; PG8_MMA(1, 0, At, B0); PG8_MMA(1, 1, At, B1); PG8_BAR; PG8_SCHED;
            PG8_LDB(B0, 1, 0); PG8_LDB(B1, 1, 1); PG8_SCHED; PG8_LDA(At, 1, 0); PG8_STAGE(PG8_SA(0, 1), a2 + hstepA, voffA);
            PG8_WAIT_V(8); PG8_WAIT_L(0); PG8_BAR; PG8_MMA(0, 0, At, B0); PG8_MMA(0, 1, At, B1); PG8_BAR; PG8_SCHED;
            PG8_LDA(At, 1, 1); PG8_STAGE(PG8_SB(1, 0), b3, voffB); PG8_STAGE(PG8_SB(1, 1), b3 + hstepB, voffB); PG8_STAGE(PG8_SA(1, 0), a3, voffA);
            PG8_WAIT_V(8); PG8_WAIT_L(0); PG8_BAR; PG8_MMA(1, 0, At, B0); PG8_MMA(1, 1, At, B1); PG8_BAR; PG8_SCHED;
        }
        if (wr == 0) PG8_BAR;
        E(acc, cur, wr, wc, fr, fq, EpiT::TAB ? tab + ui * 512 : tab);
        if (!has_next) break;
#pragma unroll
        for (int a = 0; a < 2; ++a)
#pragma unroll
            for (int b = 0; b < 2; ++b)
#pragma unroll
                for (int m = 0; m < 4; ++m)
#pragma unroll
                    for (int n = 0; n < 2; ++n) acc[a][b][m][n] = (f32x4){0.f, 0.f, 0.f, 0.f};
        cur = nxt; cA = nA; cB = nB; ++ui;
        if (wr == 1) PG8_BAR;
    }
    PG8_WAIT_V(0);
    PG8_BAR;
#undef PG8_SA
#undef PG8_SB
#undef PG8_STAGE
#undef PG8_LDA
#undef PG8_LDB
#undef PG8_MMA
#undef PG8_WAIT_V
#undef PG8_WAIT_L
#undef PG8_BAR
#undef PG8_SCHED
}
}

#define MFMA32(a, b, c) __builtin_amdgcn_mfma_f32_32x32x16_bf16((a), (b), (c), 0, 0, 0)
constexpr int ATT_BUF = 32768, ATT_VOFF = 13312, ATT_VP = 136;

template <int DK, int DV, int VAR>
__device__ __forceinline__ void attn_pass(LAS unsigned char* lds, const bf16_t* Qg, const bf16_t* Kg, const bf16_t* Vg, int ntiles, float cs, f32x16 (&O)[DV / 32], float& lsum, int wv) {
    constexpr int KP = DK * 2 + 16, KCH = DK / 8, NKC = 64 * KCH;
    const int tid = otid(), lane = tid & 63, wid = tid >> 6, l32 = lane & 31, hf = lane >> 5;
    bf16x8 qf[DK / 16];
    { const bf16_t* qrow = Qg + (size_t)(wid * 32 + l32) * DK + hf * 8;
#pragma unroll
      for (int kk = 0; kk < DK / 16; ++kk) qf[kk] = *(const bf16x8*)(qrow + kk * 16); }
    const int kc0 = tid, kc1 = tid + 512;
    const int kr0 = kc0 / KCH, kq0 = kc0 % KCH, kr1 = kc1 / KCH, kq1 = kc1 % KCH;
    const bool k1on = (kc1 < NKC);
    const int kp = (DV == 128 ? (wid >> 2) : ((wid >> 1) & 1)) * 16 + (lane & 15);
    const int vch = (DV == 128 ? (wid & 3) : (wid & 1)) * 4 + (lane >> 4);
    const bool von = (DV == 128) || (wid >= 4);
    const bf16_t* kg0 = Kg + kr0 * DK + kq0 * 8; const bf16_t* kg1 = Kg + kr1 * DK + kq1 * 8;
    const bf16_t* vg0 = Vg + (size_t)(2 * kp) * DV + vch * 8;
    const unsigned kl0 = kr0 * KP + kq0 * 16, kl1 = kr1 * KP + kq1 * 16, vl0 = ATT_VOFF + (vch * 8) * ATT_VP + kp * 4;
    u32x4 ka0, ka1, va0, va1;
    { unsigned z0 = 0u; asm volatile("" : "+v"(z0)); ka1 = (u32x4){z0, z0, z0, z0}; } va0 = ka1; va1 = ka1; ka0 = ka1;
#define ATT_LOADK(t, r0, r1) do { r0 = *(const u32x4*)kg0; if (k1on) r1 = *(const u32x4*)kg1; kg0 += 64 * DK; kg1 += 64 * DK; } while (0)
#define ATT_LOADV(t, r0, r1) do { if (von) { r0 = *(const u32x4*)vg0; r1 = *(const u32x4*)(vg0 + DV); } vg0 += 64 * DV; } while (0)
#define ATT_STOREK(bi, r0, r1) do { LAS unsigned char* kb_ = lds + (bi) * ATT_BUF; *(LAS u32x4*)(kb_ + kl0) = r0; if (k1on) *(LAS u32x4*)(kb_ + kl1) = r1; } while (0)
#define ATT_STOREV(bi, r0, r1) do { if (von) { LAS unsigned char* vb_ = lds + (bi) * ATT_BUF + vl0; \
            *(LAS unsigned*)(vb_ + 0 * ATT_VP) = (r0.x & 0xffffu) | (r1.x << 16); *(LAS unsigned*)(vb_ + 1 * ATT_VP) = (r0.x >> 16) | (r1.x & 0xffff0000u); \
            *(LAS unsigned*)(vb_ + 2 * ATT_VP) = (r0.y & 0xffffu) | (r1.y << 16); *(LAS unsigned*)(vb_ + 3 * ATT_VP) = (r0.y >> 16) | (r1.y & 0xffff0000u); \
            *(LAS unsigned*)(vb_ + 4 * ATT_VP) = (r0.z & 0xffffu) | (r1.z << 16); *(LAS unsigned*)(vb_ + 5 * ATT_VP) = (r0.z >> 16) | (r1.z & 0xffff0000u); \
            *(LAS unsigned*)(vb_ + 6 * ATT_VP) = (r0.w & 0xffffu) | (r1.w << 16); *(LAS unsigned*)(vb_ + 7 * ATT_VP) = (r0.w >> 16) | (r1.w & 0xffff0000u); } } while (0)
#define ATT_QK(bi, S0, S1) do { const unsigned ka_ = (unsigned)(unsigned long long)(lds + (bi) * ATT_BUF + l32 * KP + hf * 16); \
        bf16x8 kfa[DK / 16], kfb[DK / 16]; \
          \
        if constexpr (DK == 64) { \
            asm volatile("ds_read_b128 %0, %8\n\tds_read_b128 %1, %8 offset:%9\n\tds_read_b128 %2, %8 offset:32\n\tds_read_b128 %3, %8 offset:%10\n\t" \
                         "ds_read_b128 %4, %8 offset:64\n\tds_read_b128 %5, %8 offset:%11\n\tds_read_b128 %6, %8 offset:96\n\tds_read_b128 %7, %8 offset:%12\n\ts_waitcnt lgkmcnt(0)" \
                         : "=&v"(kfa[0]), "=&v"(kfb[0]), "=&v"(kfa[1]), "=&v"(kfb[1]), "=&v"(kfa[2]), "=&v"(kfb[2]), "=&v"(kfa[3]), "=&v"(kfb[3]) \
                         : "v"(ka_), "n"(32 * KP), "n"(32 * KP + 32), "n"(32 * KP + 64), "n"(32 * KP + 96) : "memory"); \
        } else { \
            asm volatile("ds_read_b128 %0, %12\n\tds_read_b128 %1, %12 offset:%13\n\tds_read_b128 %2, %12 offset:32\n\tds_read_b128 %3, %12 offset:%14\n\t" \
                         "ds_read_b128 %4, %12 offset:64\n\tds_read_b128 %5, %12 offset:%15\n\tds_read_b128 %6, %12 offset:96\n\tds_read_b128 %7, %12 offset:%16\n\t" \
                         "ds_read_b128 %8, %12 offset:128\n\tds_read_b128 %9, %12 offset:%17\n\tds_read_b128 %10, %12 offset:160\n\tds_read_b128 %11, %12 offset:%18\n\ts_waitcnt lgkmcnt(0)" \
                         : "=&v"(kfa[0]), "=&v"(kfb[0]), "=&v"(kfa[1]), "=&v"(kfb[1]), "=&v"(kfa[2]), "=&v"(kfb[2]), "=&v"(kfa[3]), "=&v"(kfb[3]), "=&v"(kfa[DK / 16 - 2]), "=&v"(kfb[DK / 16 - 2]), "=&v"(kfa[DK / 16 - 1]), "=&v"(kfb[DK / 16 - 1]) \
                         : "v"(ka_), "n"(32 * KP), "n"(32 * KP + 32), "n"(32 * KP + 64), "n"(32 * KP + 96), "n"(32 * KP + 128), "n"(32 * KP + 160) : "memory"); \
        } \
        S0 = MFMA32(kfa[0], qf[0], negm); S1 = MFMA32(kfb[0], qf[0], negm);                \
        _Pragma("unroll") for (int kk = 1; kk < DK / 16; ++kk) { S0 = MFMA32(kfa[kk], qf[kk], S0); S1 = MFMA32(kfb[kk], qf[kk], S1); } } while (0)
#define ATT_VISSUE(vl, vh, base) asm volatile("ds_read_b64 %0, %16\n\tds_read_b64 %1, %16 offset:16\n\tds_read_b64 %2, %16 offset:32\n\tds_read_b64 %3, %16 offset:48\n\t" \
                         "ds_read_b64 %4, %16 offset:64\n\tds_read_b64 %5, %16 offset:80\n\tds_read_b64 %6, %16 offset:96\n\tds_read_b64 %7, %16 offset:112\n\t" \
                         "ds_read_b64 %8, %16 offset:%17\n\tds_read_b64 %9, %16 offset:%18\n\tds_read_b64 %10, %16 offset:%19\n\tds_read_b64 %11, %16 offset:%20\n\t" \
                         "ds_read_b64 %12, %16 offset:%21\n\tds_read_b64 %13, %16 offset:%22\n\tds_read_b64 %14, %16 offset:%23\n\tds_read_b64 %15, %16 offset:%24" \
                         : "=&v"(vl[0]), "=&v"(vh[0]), "=&v"(vl[1]), "=&v"(vh[1]), "=&v"(vl[2]), "=&v"(vh[2]), "=&v"(vl[3]), "=&v"(vh[3]), \
                           "=&v"(vl[4]), "=&v"(vh[4]), "=&v"(vl[5]), "=&v"(vh[5]), "=&v"(vl[6]), "=&v"(vh[6]), "=&v"(vl[7]), "=&v"(vh[7]) \
                         : "v"(base), "n"(32 * ATT_VP), "n"(32 * ATT_VP + 16), "n"(32 * ATT_VP + 32), "n"(32 * ATT_VP + 48), "n"(32 * ATT_VP + 64), "n"(32 * ATT_VP + 80), "n"(32 * ATT_VP + 96), "n"(32 * ATT_VP + 112) : "memory")
#define ATT_VWAIT(vl, vh) asm volatile("s_waitcnt lgkmcnt(0)" : "+v"(vl[0]), "+v"(vh[0]), "+v"(vl[1]), "+v"(vh[1]), "+v"(vl[2]), "+v"(vh[2]), "+v"(vl[3]), "+v"(vh[3]), \
                           "+v"(vl[4]), "+v"(vh[4]), "+v"(vl[5]), "+v"(vh[5]), "+v"(vl[6]), "+v"(vh[6]), "+v"(vl[7]), "+v"(vh[7]) :: "memory")
#define ATT_VFRAG(vl, vh, i) __builtin_bit_cast(bf16x8, (u32x4){vl[i].x, vl[i].y, vh[i].x, vh[i].y})
#define ATT_SOFTMAX_PV(bi, S0, S1) do { \
        const unsigned va_ = (unsigned)(unsigned long long)(lds + (bi) * ATT_BUF + ATT_VOFF + l32 * ATT_VP + 8 * hf); \
        u32x2 vl[8], vh[8]; \
        if (VAR != 4) ATT_VISSUE(vl, vh, va_);                        \
        float mx = fmaxf(fmaxf(S0[0], S1[0]), fmaxf(S0[1], S1[1])); \
        _Pragma("unroll") for (int i = 2; i < 16; i += 2) mx = fmaxf(mx, fmaxf(fmaxf(S0[i], S1[i]), fmaxf(S0[i + 1], S1[i + 1]))); \
        mx = xmax32(mx); \
        if (t == 0 || __builtin_amdgcn_ballot_w64(mx > 8.f) != 0ull) {          \
            const float dm = (t == 0) ? mx : fmaxf(mx, 0.f); \
            if (t != 0) { const float alpha = __builtin_amdgcn_exp2f(-dm); lrun *= alpha; _Pragma("unroll") for (int tt = 0; tt < DV / 32; ++tt) O[tt] *= alpha; } \
            mrun += dm; \
            _Pragma("unroll") for (int i = 0; i < 16; ++i) { negm[i] = -mrun; S0[i] -= dm; S1[i] -= dm; } } \
        f32x2 ps2 = {0.f, 0.f}; \
        _Pragma("unroll") for (int i = 0; i < 16; i += 2) { f32x2 a = {S0[i], S0[i + 1]}, c = {S1[i], S1[i + 1]}; \
            if (VAR != 2) { a.x = __builtin_amdgcn_exp2f(a.x); a.y = __builtin_amdgcn_exp2f(a.y); c.x = __builtin_amdgcn_exp2f(c.x); c.y = __builtin_amdgcn_exp2f(c.y); } ps2 += a; ps2 += c; \
            S0[i] = a.x; S0[i + 1] = a.y; S1[i] = c.x; S1[i + 1] = c.y; } \
        lrun += ps2.x + ps2.y; \
        bf16x8 pf[4]; \
        _Pragma("unroll") for (int j = 0; j < 4; ++j) { u32x4 w; \
            if (j < 2) { w.x = cvtpk(S0[8 * j + 0], S0[8 * j + 1]); w.y = cvtpk(S0[8 * j + 2], S0[8 * j + 3]); w.z = cvtpk(S0[8 * j + 4], S0[8 * j + 5]); w.w = cvtpk(S0[8 * j + 6], S0[8 * j + 7]); } \
            else { const int jj = j - 2; w.x = cvtpk(S1[8 * jj + 0], S1[8 * jj + 1]); w.y = cvtpk(S1[8 * jj + 2], S1[8 * jj + 3]); w.z = cvtpk(S1[8 * jj + 4], S1[8 * jj + 5]); w.w = cvtpk(S1[8 * jj + 6], S1[8 * jj + 7]); } \
            pf[j] = __builtin_bit_cast(bf16x8, w); } \
        if (VAR == 4) { _Pragma("unroll") for (int tt = 0; tt < DV / 32; ++tt) _Pragma("unroll") for (int j = 0; j < 4; ++j) O[tt][j] += __builtin_bit_cast(float, (int)pf[j][0]); } else { \
            ATT_VWAIT(vl, vh); \
            _Pragma("unroll") for (int j = 0; j < 4; ++j) O[0] = MFMA32(ATT_VFRAG(vl, vh, j), pf[j], O[0]); \
            _Pragma("unroll") for (int j = 0; j < 4; ++j) O[1] = MFMA32(ATT_VFRAG(vl, vh, 4 + j), pf[j], O[1]); \
            if constexpr (DV == 128) { const unsigned vc_ = va_ + 64 * ATT_VP; u32x2 wl[8], wh[8]; ATT_VISSUE(wl, wh, vc_); ATT_VWAIT(wl, wh); \
                _Pragma("unroll") for (int j = 0; j < 4; ++j) O[2] = MFMA32(ATT_VFRAG(wl, wh, j), pf[j], O[2]); \
                _Pragma("unroll") for (int j = 0; j < 4; ++j) O[3] = MFMA32(ATT_VFRAG(wl, wh, 4 + j), pf[j], O[3]); } } } while (0)
#pragma unroll
    for (int t = 0; t < DV / 32; ++t)
#pragma unroll
        for (int i = 0; i < 16; ++i) O[t][i] = 0.f;
    float mrun = 0.f, lrun = 0.f; (void)cs;
    f32x16 Sa0, Sa1, negm;
#pragma unroll
    for (int i = 0; i < 16; ++i) negm[i] = 0.f;
    __syncthreads();
    ATT_LOADK(0, ka0, ka1); ATT_LOADV(0, va0, va1);
    for (int t = 0; t < ntiles; ++t) {
        if (VAR != 1 || t < 2) { ATT_STOREK(t & 1, ka0, ka1); ATT_STOREV(t & 1, va0, va1); }
        __syncthreads();
        if (VAR != 1) { if (t + 1 < ntiles) { ATT_LOADK(t + 1, ka0, ka1); ATT_LOADV(t + 1, va0, va1); } }
        if (VAR != 3) { ATT_QK(t & 1, Sa0, Sa1); } else {
#pragma unroll
            for (int i = 0; i < 16; ++i) { Sa0[i] = (float)(t + i) * 1e-3f; Sa1[i] = (float)(t - i) * 1e-3f; } }
        ATT_SOFTMAX_PV(t & 1, Sa0, Sa1);
    }
    lsum = xsum32(lrun);
#undef ATT_LOADK
#undef ATT_LOADV
#undef ATT_STOREK
#undef ATT_STOREV
#undef ATT_QK
#undef ATT_SOFTMAX_PV
#undef ATT_VISSUE
#undef ATT_VWAIT
#undef ATT_VFRAG
}

template <int VAR> __device__ __forceinline__ void attn_unit_a(LAS unsigned char* lds, KP p, int l, int bh, int qb, int wv) {
    unsigned char* ws = p->ws;
    const int b = bh >> 2, h = bh & 3;
    const int tid_ = otid(); const int lane = tid_ & 63, wid = tid_ >> 6, l32 = lane & 31, hf = lane >> 5;
    const int ntiles = qb == 0 ? CTX / 64 : TK / 64;
    const int q0 = qb == 0 ? 0 : CTX + (qb - 1) * 256;
    const bf16_t* QA = (const bf16_t*)(ws + WS_QA); const bf16_t* KA = (const bf16_t*)(ws + WS_KA); const bf16_t* VA = (const bf16_t*)(ws + WS_VA);
    const float cs = 0.125f * 1.4426950408889634f;
    const float lam = ((const float*)(ws + WS_LAM))[l];
    const float lam_init = ((const float*)(ws + WS_LAM))[8 + l];
    f32x16 O[4]; float lsum;
    const bf16_t* Vg = VA + (size_t)(b * 4 + h) * TK * 128;
    attn_pass<64, 128, VAR>(lds, QA + ((size_t)(b * 8 + h * 2 + 0) * TK + q0) * 64, KA + (size_t)(b * 8 + h * 2 + 0) * TK * 64, Vg, ntiles, cs, O, lsum, wv);
    LAS unsigned* o0 = (LAS unsigned*)(lds + 65536 + wid * 8192) + lane;
    { const float inv = 1.f / lsum;
#pragma unroll
      for (int t = 0; t < 4; ++t)
#pragma unroll
          for (int i = 0; i < 8; ++i) o0[(t * 8 + i) * 64] = cvtpk(O[t][2 * i] * inv, O[t][2 * i + 1] * inv); }
    attn_pass<64, 128, VAR>(lds, QA + ((size_t)(b * 8 + h * 2 + 1) * TK + q0) * 64, KA + (size_t)(b * 8 + h * 2 + 1) * TK * 64, Vg, ntiles, cs, O, lsum, wv);
    const float inv1 = lam / lsum;
    float ss = 0.f;
#pragma unroll
    for (int t = 0; t < 4; ++t)
#pragma unroll
        for (int i = 0; i < 8; ++i) { const unsigned ow = o0[(t * 8 + i) * 64]; const float a = __uint_as_float(ow << 16) - O[t][2 * i] * inv1, c = __uint_as_float(ow & 0xffff0000u) - O[t][2 * i + 1] * inv1;
            O[t][2 * i] = a; O[t][2 * i + 1] = c; ss += a * a + c * c; }
    ss = xsum32(ss);
    const float rs = rsq(ss * (1.f / 128.f) + EPS) * (1.f - lam_init);
    const int row = (qb == 0 ? MX + b * CTX : b * SEQ + (qb - 1) * 256) + wid * 32 + l32;
    if (VAR != 0 && rs != 12345.f) return;
    bf16_t* yp = (bf16_t*)(ws + WS_Y) + (size_t)row * 2048 + h * 128 + 4 * hf;
    const float* gs = p->g_sub + l * 128 + 4 * hf;
#pragma unroll
    for (int t = 0; t < 4; ++t)
#pragma unroll
        for (int i4 = 0; i4 < 4; ++i4) { const f32x4 g = *(const f32x4*)(gs + 32 * t + 8 * i4);
            f32x4 v; v[0] = O[t][4 * i4] * rs * g[0]; v[1] = O[t][4 * i4 + 1] * rs * g[1]; v[2] = O[t][4 * i4 + 2] * rs * g[2]; v[3] = O[t][4 * i4 + 3] * rs * g[3];
            *(u32x2*)(yp + 32 * t + 8 * i4) = pack4(v); }
}
template <int VAR> __device__ __forceinline__ void attn_unit_b(LAS unsigned char* lds, KP p, int bh, int qb, int wv) {
    unsigned char* ws = p->ws;
    const int b = bh >> 3, h = bh & 7;
    const int tid_ = otid(); const int lane = tid_ & 63, wid = tid_ >> 6, l32 = lane & 31, hf = lane >> 5;
    const int ntiles = qb == 0 ? CTX / 64 : TK / 64;
    const int q0 = qb == 0 ? 0 : CTX + (qb - 1) * 256;
    const bf16_t* QB = (const bf16_t*)(ws + WS_QB); const bf16_t* KB = (const bf16_t*)(ws + WS_KB); const bf16_t* VB = (const bf16_t*)(ws + WS_VB);
    const float cs = 0.10206207261596577f * 1.4426950408889634f;
    f32x16 O[2]; float lsum;
    attn_pass<96, 64, VAR>(lds, QB + ((size_t)bh * TK + q0) * 96, KB + (size_t)bh * TK * 96, VB + (size_t)bh * TK * 64, ntiles, cs, O, lsum, wv);
    const float inv = 1.f / lsum;
    const int row = (qb == 0 ? MX + b * CTX : b * SEQ + (qb - 1) * 256) + wid * 32 + l32;
    if (VAR != 0 && inv != 12345.f) return;
    bf16_t* yp = (bf16_t*)(ws + WS_Y) + (size_t)row * 2048 + 512 + h * 64 + 4 * hf;
#pragma unroll
    for (int t = 0; t < 2; ++t)
#pragma unroll
        for (int i4 = 0; i4 < 4; ++i4) { f32x4 v; v[0] = O[t][4 * i4] * inv; v[1] = O[t][4 * i4 + 1] * inv; v[2] = O[t][4 * i4 + 2] * inv; v[3] = O[t][4 * i4 + 3] * inv;
            *(u32x2*)(yp + 32 * t + 8 * i4) = pack4(v); }
}
template <int VAR> __device__ __forceinline__ void attn_phase(LAS unsigned char* lds, KP p, int l, int wv) {
    const int G = gridDim.x, c = blockIdx.x;
    const int NU = (l == DEPTH - 1) ? 768 : 864;
    for (int u = c; u < NU; u += G) {
        if (u < 256) { const int xcd = u & 7, j = u >> 3; attn_unit_a<VAR>(lds, p, l, xcd * 4 + (j >> 3), 1 + (j & 7), wv); }
        else if (u < 768) { const int u2 = u - 256, r = u2 >> 8, c2 = u2 & 255, xcd = c2 & 7, j = c2 >> 3; attn_unit_b<VAR>(lds, p, xcd * 8 + (j >> 3) * 2 + r, 1 + (j & 7), wv); }
        else { const int u3 = u - 768; if (u3 < 32) attn_unit_a<VAR>(lds, p, l, u3, 0, wv); else attn_unit_b<VAR>(lds, p, u3 - 32, 0, wv); }
    }
}

__device__ __forceinline__ void tr_item(const float* W, int N, bf16_t* WT, int ldk, int row_off, int split, int shift, int ncopy, int copy_stride, LAS float* scr, int item, int lane) {
    const int nblk = N / 32, kb = item / nblk, nb = item % nblk, k0 = 64 * kb, n0 = 32 * nb;
    float wv_[32];
#pragma unroll
    for (int i = 0; i < 32; ++i) wv_[i] = W[(size_t)(k0 + 2 * i + (lane >> 5)) * N + n0 + (lane & 31)];
#pragma unroll
    for (int i = 0; i < 32; ++i) scr[(2 * i + (lane >> 5)) * 33 + (lane & 31)] = wv_[i];
    asm volatile("s_waitcnt lgkmcnt(0)" ::: "memory");
    const int c = lane & 7;
    const int rsh = row_off + n0 + (n0 >= split ? shift : 0);
#pragma unroll
    for (int j = 0; j < 4; ++j) { const int n = (lane >> 3) + 8 * j; const LAS float* s = scr + (8 * c) * 33 + n;
        u32x4 o; o.x = cvtpk(s[0 * 33], s[1 * 33]); o.y = cvtpk(s[2 * 33], s[3 * 33]); o.z = cvtpk(s[4 * 33], s[5 * 33]); o.w = cvtpk(s[6 * 33], s[7 * 33]);
        for (int cp = 0; cp < ncopy; ++cp) *(u32x4*)(WT + (size_t)(rsh + n) * ldk + cp * copy_stride + k0 + 8 * c) = o; }
    asm volatile("s_waitcnt lgkmcnt(0)" ::: "memory");
}
__device__ __forceinline__ void convert_weights(LAS unsigned char* lds, KP p, int l, int wv) {
    unsigned char* ws = p->ws;
    const int tid_ = otid(); const int lane = tid_ & 63, wid = tid_ >> 6;
    LAS float* scr = (LAS float*)(lds + wid * 8704);
    const int gw = blockIdx.x * 8 + wid, NGW = gridDim.x * 8;
    constexpr int I_IN = 16 * (DIN / 32), I_UQ = 6 * 24, I_UKV = 4 * 32, I_BR = 8 * 32, I_O = 16 * 32, I_F1 = 16 * 128, I_F2 = 64 * 32;
    constexpr int NIT = I_IN + I_UQ + I_UKV + 3 * I_BR + I_O + I_F1 + I_F2;
    const int BIG = 1 << 30;
    for (int it = gw; it < NIT; it += NGW) {
        int r = it;
        if (r < I_IN) { tr_item(p->w_in + (size_t)l * DM * DIN, DIN, (bf16_t*)(ws + WS_WIN), DM, 0, NGATE0, NPM - NGATE0, 1, 0, scr, r, lane); continue; } r -= I_IN;
        if (r < I_UQ) { const int nb = r % 24, hh = nb / 3, part = nb % 3, dest = part < 2 ? (2 * hh + part) * 32 : 512 + 32 * hh;
            tr_item(p->w_uq + (size_t)l * 384 * 768, 768, (bf16_t*)(ws + WS_WUQ), 384, dest - 32 * nb, BIG, 0, 1, 0, scr, r, lane); continue; } r -= I_UQ;
        if (r < I_UKV) { tr_item(p->w_ukv + (size_t)l * 256 * 1024, 1024, (bf16_t*)(ws + WS_WUKV), 256, 0, BIG, 0, 1, 0, scr, r, lane); continue; } r -= I_UKV;
        if (r < 3 * I_BR) { const int z3 = r / I_BR, z = z3 == 2 ? 3 : z3; tr_item(p->w_branch + ((size_t)l * 4 + z) * 512 * 1024, 1024, (bf16_t*)(ws + WS_WBR), 512, z * 1024, BIG, 0, 1, 0, scr, r % I_BR, lane); continue; } r -= 3 * I_BR;
        if (r < I_O) { tr_item(p->w_o + (size_t)l * DM * DM, DM, (bf16_t*)(ws + WS_WO4), 4096, 0, BIG, 0, 1, 0, scr, r, lane); continue; } r -= I_O;
        if (r < I_F1) { tr_item(p->w_ff1 + (size_t)l * DM * DFF, DFF, (bf16_t*)(ws + WS_WF1), DM, 0, BIG, 0, 1, 0, scr, r, lane); continue; } r -= I_F1;
        tr_item(p->w_ff2 + (size_t)l * DFF * DM, DM, (bf16_t*)(ws + WS_WF2), DFF, 0, BIG, 0, 1, 0, scr, r, lane);
    }
    { const int gt = blockIdx.x * 512 + otid(), NT = gridDim.x * 512; u32x4* z = (u32x4*)((bf16_t*)(ws + WS_WIN) + (size_t)NGATE0 * DM);
      unsigned z0 = 0u; asm volatile("" : "+v"(z0));
      for (int i = gt; i < (NPM - NGATE0) * DM / 8; i += NT) z[i] = (u32x4){z0, z0, z0, z0}; }
    { const float* wp = p->w_pool + (size_t)l * 4 * 128 * 128; const float* sp = p->s_pool + l * 512; const float* wb = p->w_branch + ((size_t)l * 4 + 2) * 512 * 1024;
      bf16_t* dst = (bf16_t*)(ws + WS_WBR) + (size_t)2048 * 512;
      LAS float* As = (LAS float*)lds;
      const int tid = otid();
      int gcur = -1;
      for (int it = blockIdx.x; it < 4 * 256; it += gridDim.x) {
          const int gi = it >> 8, d0 = (it & 255) * 4;
          if (gi != gcur) { __syncthreads();
              for (int i = tid; i < 128 * 128; i += 512) { const int cl = i >> 7, j = i & 127; As[cl * 129 + j] = wp[(size_t)gi * 16384 + i] * sp[gi * 128 + j]; }
              __syncthreads(); gcur = gi; }
          const int cl = tid & 127, d = d0 + __builtin_amdgcn_readfirstlane(tid >> 7);
          const float* br = wb + (size_t)gi * 128 * 1024 + d;
          float a = 0.f;
#pragma unroll 8
          for (int j = 0; j < 128; ++j) a += As[cl * 129 + j] * br[(size_t)j * 1024];
          dst[(size_t)d * 512 + gi * 128 + cl] = (bf16_t)(cvtpk(a, 0.f) & 0xffffu);
      }
      __syncthreads(); }
}
__device__ __forceinline__ void mod_phase(LAS unsigned char* lds, KP p, int wv) {
    LAS float* sv = (LAS float*)lds;
    LAS float* red = (LAS float*)(lds + 9 * 1024 * 4);
    const int tid = otid(), lane = tid & 63, wid = tid >> 6;
    for (int i = tid; i < 9 * 1024; i += 512) { const float v = i < 8192 ? p->c[i] : p->c_ctx[i - 8192]; sv[i] = v / (1.f + __expf(-v)); }
    __syncthreads();
    float* mod = (float*)(p->ws + WS_MOD);
    for (int it = blockIdx.x; it < DEPTH * 96; it += gridDim.x) {
        const int l = it / 96, n0 = (it % 96) * 64;
        const float* W = p->w_mod + (size_t)l * DM * 6144 + n0 + lane;
        float a[9];
#pragma unroll
        for (int r = 0; r < 9; ++r) a[r] = 0.f;
        for (int k = wid * 128; k < wid * 128 + 128; k += 8) { float w[8];
#pragma unroll
            for (int j = 0; j < 8; ++j) w[j] = W[(size_t)(k + j) * 6144];
#pragma unroll
            for (int r = 0; r < 9; ++r) { const f32x4 s0 = *(const LAS f32x4*)(sv + r * 1024 + k), s1 = *(const LAS f32x4*)(sv + r * 1024 + k + 4);
                a[r] += ((s0[0] * w[0] + s0[1] * w[1]) + (s0[2] * w[2] + s0[3] * w[3])) + ((s1[0] * w[4] + s1[1] * w[5]) + (s1[2] * w[6] + s1[3] * w[7])); } }
#pragma unroll
        for (int r = 0; r < 9; ++r) red[(wid * 9 + r) * 64 + lane] = a[r];
        __syncthreads();
        for (int o = tid; o < 9 * 64; o += 512) { const int r = o >> 6, n = o & 63; float s = p->b_mod[l * 6144 + n0 + n];
#pragma unroll
            for (int w = 0; w < 8; ++w) s += red[(w * 9 + r) * 64 + n];
            mod[((size_t)l * 9 + r) * 6144 + n0 + n] = s;
            const int nn = n0 + n, ch = nn >> 10, cc = nn & 1023;
            if (ch == 1) ((float*)(p->ws + WS_VM))[(((size_t)l * 2 + 0) * 9 + r) * DM + cc] = p->g1[l * DM + cc] * (1.f + s);
            if (ch == 4) ((float*)(p->ws + WS_VM))[(((size_t)l * 2 + 1) * 9 + r) * DM + cc] = p->g2[l * DM + cc] * (1.f + s); }
        __syncthreads();
    }
}
__device__ __forceinline__ void bias_gemv(LAS unsigned char* lds, KP p, int l, int wv) {
    LAS float* sv = (LAS float*)lds;
    LAS float* red = (LAS float*)(lds + 2 * 9 * 1024 * 4);
    const int tid = otid(), lane = tid & 63, wid = tid >> 6;
    const float* mod = (const float*)(p->ws + WS_MOD) + (size_t)l * 9 * 6144;
    __syncthreads();
    for (int i = tid; i < 2 * 9 * 1024; i += 512) { const int which = i / 9216, r = (i % 9216) >> 10, k = i & 1023; sv[i] = mod[(size_t)r * 6144 + (which ? 3 : 0) * 1024 + k]; }
    __syncthreads();
    constexpr int IT1 = (DIN + 63) / 64, IT2 = DFF / 64;
    for (int it = blockIdx.x; it < IT1 + IT2; it += gridDim.x) {
        const bool second = it >= IT1; const int n0 = (second ? it - IT1 : it) * 64; const int N = second ? DFF : DIN;
        const int col = n0 + lane; const bool on = col < N;
        const float* W = (second ? p->w_ff1 + (size_t)l * DM * DFF : p->w_in + (size_t)l * DM * DIN) + (on ? col : 0);
        const LAS float* s9 = sv + (second ? 9216 : 0);
        float a[9];
#pragma unroll
        for (int r = 0; r < 9; ++r) a[r] = 0.f;
        for (int k = wid * 128; k < wid * 128 + 128; k += 8) { float w[8];
#pragma unroll
            for (int j = 0; j < 8; ++j) w[j] = W[(size_t)(k + j) * N];
#pragma unroll
            for (int r = 0; r < 9; ++r) { const f32x4 s0 = *(const LAS f32x4*)(s9 + r * 1024 + k), s1 = *(const LAS f32x4*)(s9 + r * 1024 + k + 4);
                a[r] += ((s0[0] * w[0] + s0[1] * w[1]) + (s0[2] * w[2] + s0[3] * w[3])) + ((s1[0] * w[4] + s1[1] * w[5]) + (s1[2] * w[6] + s1[3] * w[7])); } }
#pragma unroll
        for (int r = 0; r < 9; ++r) red[(wid * 9 + r) * 64 + lane] = a[r];
        __syncthreads();
        for (int o = tid; o < 9 * 64; o += 512) { const int r = o >> 6, n = o & 63; const int c = n0 + n;
            if (c < N) { float s = 0.f;
#pragma unroll
                for (int w = 0; w < 8; ++w) s += red[(w * 9 + r) * 64 + n];
                if (second) ((float*)(p->ws + WS_BIAS2))[(size_t)r * DFF + c] = s;
                else ((float*)(p->ws + WS_BIAS1))[(size_t)r * NIN + (c < NGATE0 ? c : c + (NPM - NGATE0))] = s; } }
        __syncthreads();
    }
}
__device__ __forceinline__ void init_h(KP p, int wv) {
    const int tid_ = otid(); const int lane = tid_ & 63, wid = tid_ >> 6;
    const int gw = blockIdx.x * 8 + wid, NGW = gridDim.x * 8;
    const float* vm = (const float*)(p->ws + WS_VM);
    bf16_t* H = (bf16_t*)(p->ws + WS_H); float* part = (float*)(p->ws + WS_PART);
    for (int row = gw; row < MT; row += NGW) {
        const float* xr = row < MX ? p->x + (size_t)row * DM : p->ctx + (size_t)(row - MX) * DM;
        const float* vr = vm + (size_t)(row < MX ? (row >> 11) : 8) * DM;
        float s = 0.f;
#pragma unroll
        for (int j = 0; j < 4; ++j) { const int col = 4 * lane + 256 * j; const f32x4 v = *(const f32x4*)(xr + col); s += (v[0] * v[0] + v[1] * v[1]) + (v[2] * v[2] + v[3] * v[3]);
            *(u32x2*)(H + (size_t)row * DM + col) = pack4(v * *(const f32x4*)(vr + col)); }
        s = wave_sum(s);
        if (lane < 16) part[(size_t)row * 16 + lane] = lane == 0 ? s : 0.f;
    }
}
__device__ __forceinline__ void norm_phase(KP p, int l, int chunk, int nrows, int wv) {
    const int tid_ = otid(); const int lane = tid_ & 63, wid = tid_ >> 6;
    const int gw = blockIdx.x * 8 + wid, NGW = gridDim.x * 8;
    const float* g = (chunk == 0 ? p->g1 : p->g2) + l * DM;
    const float* mod = (const float*)(p->ws + WS_MOD) + (size_t)l * 9 * 6144;
    bf16_t* H = (bf16_t*)(p->ws + WS_H);
    for (int row = gw; row < nrows; row += NGW) {
        const float* xr = row < MX ? p->out + (size_t)row * DM : (const float*)(p->ws + WS_XC) + (size_t)(row - MX) * DM;
        const float* mr = mod + (size_t)(row < MX ? (row >> 11) : 8) * 6144 + chunk * 1024;
        f32x4 v[4]; float s = 0.f;
#pragma unroll
        for (int j = 0; j < 4; ++j) { v[j] = *(const f32x4*)(xr + 4 * lane + 256 * j); s += (v[j][0] * v[j][0] + v[j][1] * v[j][1]) + (v[j][2] * v[j][2] + v[j][3] * v[j][3]); }
        const float rs = rsq(wave_sum(s) * (1.f / DM) + EPS);
#pragma unroll
        for (int j = 0; j < 4; ++j) { const int col = 4 * lane + 256 * j; const f32x4 gv = *(const f32x4*)(g + col), sh = *(const f32x4*)(mr + col), sc = *(const f32x4*)(mr + 1024 + col);
            f32x4 o = (v[j] * rs * gv) * (1.f + sc) + sh; *(u32x2*)(H + (size_t)row * DM + col) = pack4(o); }
    }
}

__device__ __forceinline__ void prep1_phase(KP p, int l, int wv) {
    unsigned char* ws = p->ws;
    const int tid_ = otid(); const int lane = tid_ & 63, wid = tid_ >> 6;
    const int gw = blockIdx.x * 8 + wid, NGW = gridDim.x * 8;
    const bf16_t* __restrict__ Pm = (const bf16_t*)(ws + WS_R1);
    bf16_t* __restrict__ QA = (bf16_t*)(ws + WS_QA); bf16_t* __restrict__ KA = (bf16_t*)(ws + WS_KA); bf16_t* __restrict__ VA = (bf16_t*)(ws + WS_VA);
    bf16_t* __restrict__ CQ = (bf16_t*)(ws + WS_CQ); bf16_t* __restrict__ CKV = (bf16_t*)(ws + WS_CKV); bf16_t* __restrict__ KR = (bf16_t*)(ws + WS_KR); bf16_t* __restrict__ Y = (bf16_t*)(ws + WS_Y);
    f32x8 invA, invB, gq, gk, gcq, gckv, gkr;
#pragma unroll
    for (int e = 0; e < 8; ++e) { invA[e] = (lane & 1) ? INVA_REV[8 + e] : INVA_REV[e]; invB[e] = INVB_REV[e];
        gq[e] = p->gq_a[l * 64 + (lane & 7) * 8 + e] * CS_A; gk[e] = p->gk_a[l * 64 + (lane & 7) * 8 + e];
        gcq[e] = lane < 48 ? p->g_cq[l * 384 + 8 * lane + e] : 0.f; gckv[e] = lane < 32 ? p->g_ckv[l * 256 + 8 * lane + e] : 0.f; gkr[e] = lane < 4 ? p->gk_b[l * 96 + 64 + 8 * lane + e] : 0.f; }
    const float* wcv = p->w_conv + (size_t)l * 3 * 512 + 8 * lane;
#pragma unroll 2
    for (int row = gw; row < MT; row += NGW) {
        const bool isx = row < MX;
        const int b = isx ? (row >> 11) : ((row - MX) >> 8);
        const int t = isx ? (row & 2047) : ((row - MX) & 255);
        const int S = isx ? SEQ : CTX;
        const int arow = isx ? CTX + t : t;
        const bf16_t* pr = Pm + (size_t)row * NPM;
        f32x8 csA, snA, csB, snB;
        if (isx) { const float posA = (float)((lane & 2) ? (t & 63) : (t >> 6)); const float posB = (float)((lane & 1) ? (t & 63) : (t >> 6));
#pragma unroll
            for (int e = 0; e < 8; ++e) { const float a = posA * invA[e]; csA[e] = __builtin_amdgcn_cosf(a); snA[e] = __builtin_amdgcn_sinf(a); const float bq = posB * invB[e]; csB[e] = __builtin_amdgcn_cosf(bq); snB[e] = __builtin_amdgcn_sinf(bq); } }
        const u32x4 rq = ld16(pr + C_Q + 8 * lane), rk = ld16(pr + C_K + 8 * lane);
        const u32x4 rcq = ld16(pr + C_CQ + 8 * min(lane, 47)), rckv = ld16(pr + C_CKV + 8 * (lane & 31)), rkr = ld16(pr + C_KR + 8 * (lane & 3));
        const u32x4 rpb = ld16(pr + C_PB + 8 * lane), rpc = ld16(pr + C_PC + 8 * lane), rpx = ld16(pr + C_PX + 8 * lane);
        const bf16_t* prm = (t > 0) ? pr - NPM : pr; const bf16_t* prp = (t < S - 1) ? pr + NPM : pr;
        const float fm = (t > 0) ? 1.f : 0.f, fp = (t < S - 1) ? 1.f : 0.f;
        const u32x4 rpcm = ld16(prm + C_PC + 8 * lane), rpxm = ld16(prm + C_PX + 8 * lane), rpcp = ld16(prp + C_PC + 8 * lane), rpxp = ld16(prp + C_PX + 8 * lane);
        const int hw = 1 << (lane >> 4); const int lo = max(t - hw, 0), hi = min(t + hw, S);
        const bf16_t* pp = pr + C_POOL + 8 * lane;
        u32x4 pw[16]; float pvf[16];
#pragma unroll
        for (int j = 0; j < 16; ++j) { const int o = j - 8; const int tt = t + o; const bool v = (o >= -hw) && (o < hw) && (tt >= 0) && (tt < S); pw[j] = ld16(pp + (ptrdiff_t)(v ? o : 0) * NPM); pvf[j] = v ? 1.f : 0.f; }
        const u32x4 rpu = ld16(pp);
        asm volatile("" ::: "memory");
#pragma unroll
        for (int which = 0; which < 2; ++which) {
            f32x8 v = unpack8(which == 0 ? rq : rk);
            float ss = sum8(v); ss += shx<1>(ss); ss += shx<2>(ss); ss += shx<4>(ss);
            const float rs = rsq(ss * (1.f / 64.f) + EPS);
#pragma unroll
            for (int e = 0; e < 8; ++e) v[e] = v[e] * rs * (which == 0 ? gq[e] : gk[e]);
            if (isx) {
#pragma unroll
                for (int e = 0; e < 8; ++e) { const float o = shx<4>(v[e]); v[e] = (lane & 4) ? (o * snA[e] + v[e] * csA[e]) : (v[e] * csA[e] - o * snA[e]); } }
            bf16_t* dst = (which == 0 ? QA : KA) + ((size_t)(b * 8 + (lane >> 3)) * TK + arow) * 64 + (lane & 7) * 8;
            *(u32x4*)dst = pack8(v);
        }
        { f32x8 v = unpack8(rcq);
          if (lane >= 48) {
#pragma unroll
              for (int e = 0; e < 8; ++e) v[e] = 0.f; }
          const float rs = rsq(wave_sum(sum8(v)) * (1.f / 384.f) + EPS);
          if (lane < 48) {
#pragma unroll
              for (int e = 0; e < 8; ++e) v[e] = v[e] * rs * gcq[e];
              *(u32x4*)(CQ + (size_t)row * 384 + 8 * lane) = pack8(v); } }
        { f32x8 v = unpack8(rckv);
          if (lane >= 32) {
#pragma unroll
              for (int e = 0; e < 8; ++e) v[e] = 0.f; }
          const float rs = rsq(wave_sum(sum8(v)) * (1.f / 256.f) + EPS);
          if (lane < 32) {
#pragma unroll
              for (int e = 0; e < 8; ++e) v[e] = v[e] * rs * gckv[e];
              *(u32x4*)(CKV + (size_t)row * 256 + 8 * lane) = pack8(v); } }
        { f32x8 v = unpack8(rkr);
          float ss = sum8(v); ss += shx<1>(ss); ss += shx<2>(ss);
          const float rs = rsq(ss * (1.f / 32.f) + EPS);
#pragma unroll
          for (int e = 0; e < 8; ++e) v[e] = v[e] * rs * p->gk_b[l * 96 + 64 + 8 * (lane & 3) + e];
          if (isx) {
#pragma unroll
              for (int e = 0; e < 8; ++e) { const float o = shx<2>(v[e]); v[e] = (lane & 2) ? (o * snB[e] + v[e] * csB[e]) : (v[e] * csB[e] - o * snB[e]); } }
          if (lane < 4) *(u32x4*)(KR + (size_t)row * 32 + 8 * lane) = pack8(v); }
        { f32x8 sum;
#pragma unroll
          for (int e = 0; e < 8; ++e) sum[e] = 0.f;
#pragma unroll
          for (int j = 0; j < 16; ++j) sum += unpack8(pw[j]) * pvf[j];
          const float inv = 1.f / (float)(hi - lo);
          *(u32x4*)(Y + (size_t)row * 2048 + 1024 + 8 * lane) = pack8(sum * inv - unpack8(rpu)); }
        { const f32x8 pb = unpack8(rpb);
          const f32x8 uc = unpack8(rpc) * unpack8(rpx);
          const f32x8 um = unpack8(rpcm) * unpack8(rpxm) * fm, up = unpack8(rpcp) * unpack8(rpxp) * fp;
          f32x8 y;
#pragma unroll
          for (int e = 0; e < 8; ++e) y[e] = pb[e] * (um[e] * wcv[e] + uc[e] * wcv[512 + e] + up[e] * wcv[1024 + e]);
          *(u32x4*)(Y + (size_t)row * 2048 + 1536 + 8 * lane) = pack8(y); }
    }
}
__device__ __forceinline__ void prep2_phase(KP p, int l, int wv) {
    unsigned char* ws = p->ws;
    const int tid_ = otid(); const int lane = tid_ & 63, wid = tid_ >> 6;
    const int gw = blockIdx.x * 8 + wid, NGW = gridDim.x * 8;
    const bf16_t* __restrict__ QBR = (const bf16_t*)(ws + WS_QBR); const bf16_t* __restrict__ KVR = (const bf16_t*)(ws + WS_KVR); const bf16_t* __restrict__ KR = (const bf16_t*)(ws + WS_KR);
    bf16_t* __restrict__ QB = (bf16_t*)(ws + WS_QB); bf16_t* __restrict__ KB = (bf16_t*)(ws + WS_KB); bf16_t* __restrict__ VB = (bf16_t*)(ws + WS_VB);
    const int h = lane >> 3, sub = lane & 7;
    f32x8 gqn, gkn; f32x4 gqr, invB;
#pragma unroll
    for (int e = 0; e < 8; ++e) { gqn[e] = p->gq_b[l * 96 + sub * 8 + e]; gkn[e] = p->gk_b[l * 96 + sub * 8 + e]; }
#pragma unroll
    for (int e = 0; e < 4; ++e) { gqr[e] = p->gq_b[l * 96 + 64 + sub * 4 + e]; invB[e] = (sub & 1) ? INVB_REV[4 + e] : INVB_REV[e]; }
    for (int row0 = gw; row0 < MT; row0 += 3 * NGW) {
        u32x4 rqn[3], rkn[3], rvv[3]; u32x2 rqr[3], rkr[3];
#pragma unroll
        for (int q = 0; q < 3; ++q) { const int row = (row0 + q * NGW < MT) ? row0 + q * NGW : row0;
            const bf16_t* qr = QBR + (size_t)row * 768 + h * 96; const bf16_t* kr = KVR + (size_t)row * 1024 + h * 128;
            rqn[q] = ld16(qr + sub * 8); rqr[q] = *(const u32x2*)(qr + 64 + sub * 4); rkn[q] = ld16(kr + sub * 8); rvv[q] = ld16(kr + 64 + sub * 8); rkr[q] = *(const u32x2*)(KR + (size_t)row * 32 + sub * 4); }
        asm volatile("" ::: "memory");
#pragma unroll
        for (int q = 0; q < 3; ++q) { const int row = row0 + q * NGW;
            if (row < MT) {
                const bool isx = row < MX;
                const int b = isx ? (row >> 11) : ((row - MX) >> 8);
                const int t = isx ? (row & 2047) : ((row - MX) & 255);
                const int arow = isx ? CTX + t : t;
                const size_t ar = (size_t)(b * 8 + h) * TK + arow;
                f32x8 vn = unpack8(rqn[q]);
                f32x4 vr = unpack4(rqr[q]);
                float sn_ = sum8(vn); sn_ += shx<1>(sn_); sn_ += shx<2>(sn_); sn_ += shx<4>(sn_);
                float sr_ = (vr[0] * vr[0] + vr[1] * vr[1]) + (vr[2] * vr[2] + vr[3] * vr[3]); sr_ += shx<1>(sr_); sr_ += shx<2>(sr_); sr_ += shx<4>(sr_);
                const float rn = rsq(sn_ * (1.f / 64.f) + EPS), rr = rsq(sr_ * (1.f / 32.f) + EPS);
#pragma unroll
                for (int e = 0; e < 8; ++e) vn[e] = vn[e] * rn * gqn[e];
#pragma unroll
                for (int e = 0; e < 4; ++e) vr[e] = vr[e] * rr * gqr[e];
                if (isx) { const float pos = (float)((sub & 2) ? (t & 63) : (t >> 6));
#pragma unroll
                    for (int e = 0; e < 4; ++e) { const float a = pos * invB[e]; const float cs = __builtin_amdgcn_cosf(a), sn = __builtin_amdgcn_sinf(a); const float o = shx<4>(vr[e]);
                        vr[e] = (sub & 4) ? (o * sn + vr[e] * cs) : (vr[e] * cs - o * sn); } }
                *(u32x4*)(QB + ar * 96 + sub * 8) = pack8(vn);
                *(u32x2*)(QB + ar * 96 + 64 + sub * 4) = pack4(vr);
                f32x8 kn = unpack8(rkn[q]);
                float sk = sum8(kn); sk += shx<1>(sk); sk += shx<2>(sk); sk += shx<4>(sk);
                const float rk = rsq(sk * (1.f / 64.f) + EPS);
#pragma unroll
                for (int e = 0; e < 8; ++e) kn[e] = kn[e] * rk * gkn[e];
                *(u32x4*)(KB + ar * 96 + sub * 8) = pack8(kn);
                *(u32x2*)(KB + ar * 96 + 64 + sub * 4) = rkr[q];
                *(u32x4*)(VB + ar * 64 + sub * 8) = rvv[q];
            } }
    }
}

__device__ __forceinline__ void presum_phase(KP p, int nrows, int wv) {
    const bf16_t* __restrict__ Gm = (const bf16_t*)(p->ws + WS_R1);
    bf16_t* __restrict__ Sm = (bf16_t*)(p->ws + WS_MIX);
    const int gt = blockIdx.x * 512 + otid(), NT = gridDim.x * 512;
    const int total = nrows * 128;
    for (int i = gt; i < total; i += 4 * NT) {
        u32x4 a[4], b[4], c[4], d[4]; int idx[4];
#pragma unroll
        for (int q = 0; q < 4; ++q) { idx[q] = (i + q * NT < total) ? i + q * NT : i; const bf16_t* g = Gm + (size_t)(idx[q] >> 7) * 4096 + (idx[q] & 127) * 8;
            a[q] = ld16(g); b[q] = ld16(g + 1024); c[q] = ld16(g + 2048); d[q] = ld16(g + 3072); }
        asm volatile("" ::: "memory");
#pragma unroll
        for (int q = 0; q < 4; ++q) *(u32x4*)(Sm + (size_t)(idx[q] >> 7) * DM + (idx[q] & 127) * 8) = pack8((unpack8(a[q]) + unpack8(b[q])) + (unpack8(c[q]) + unpack8(d[q])));
    }
}

#define XB_TMO      128
#define XB_XCNT(j)  (256  + 64 * (j))
#define XB_XSUB(j)  (1280 + 64 * (j))
#define XB_XGEN(j)  (2304 + 64 * (j))
#define XB_TOP      3328
#define XB_TOPGEN   3392
#define XCD_BAR_WORDS 3456
#define XB_SPIN_CAP (1u << 22)
__device__ __forceinline__ unsigned xb_ld(unsigned* p)              { return __hip_atomic_load(p, __ATOMIC_RELAXED, __HIP_MEMORY_SCOPE_AGENT); }
__device__ __forceinline__ unsigned xb_add(unsigned* p, unsigned v) { return __hip_atomic_fetch_add(p, v, __ATOMIC_RELAXED, __HIP_MEMORY_SCOPE_AGENT); }
__device__ __forceinline__ unsigned xb_xcc_id() { return (unsigned)__builtin_amdgcn_s_getreg((3 << 11) | 20) & 0xFu; }
#define XB_SPIN(cond, bar) do { unsigned _sp = 0; while (cond) { __builtin_amdgcn_s_sleep(1); \
    if ((++_sp & 255u) == 0u) { if (xb_ld(&(bar)[XB_TMO])) break; if (_sp > XB_SPIN_CAP) { atomicAdd(&(bar)[XB_TMO], 1u); break; } } } } while (0)
struct XcdBarrier { unsigned* bar; unsigned x; volatile LAS unsigned* st; };
__device__ __forceinline__ XcdBarrier xcd_barrier_post(unsigned* bar, volatile LAS unsigned* st) {
    XcdBarrier b; b.bar = bar; b.x = xb_xcc_id(); b.st = st;
    if (threadIdx.x == 0) (void)xb_add(&bar[XB_XCNT(b.x)], 1u);
    return b;
}
__device__ __forceinline__ void xcd_barrier_complete(unsigned* bar, unsigned x, unsigned& nloc, unsigned& nx) {
    const unsigned G = gridDim.x * gridDim.y * gridDim.z;
    unsigned sum, cnt, mine, sp = 0u;
    for (;;) {
        sum = 0u; cnt = 0u; mine = 0u;
#pragma unroll
        for (unsigned j = 0; j < 16; ++j) { const unsigned c = xb_ld(&bar[XB_XCNT(j)]); sum += c; cnt += (c > 0u) ? 1u : 0u; mine = (j == x) ? c : mine; }
        if (sum == G) break;
        __builtin_amdgcn_s_sleep(1);
        if ((++sp & 255u) == 0u) { if (xb_ld(&bar[XB_TMO])) break; if (sp > XB_SPIN_CAP) { atomicAdd(&bar[XB_TMO], 1u); break; } }
    }
    nloc = mine > 0u ? mine : 1u; nx = cnt > 0u ? cnt : 1u;
}
__device__ __forceinline__ void xcd_barrier(const XcdBarrier& b, int wv) {
    asm volatile("s_waitcnt vmcnt(0)" ::: "memory");
    __syncthreads();
    if (otid() == 0) {
        unsigned* bar = b.bar; unsigned bx = b.x;
        asm volatile("" : "+s"(bar), "+s"(bx));
        __builtin_amdgcn_s_waitcnt(0);
        unsigned nloc = b.st[0], nx = b.st[1];
        if (nloc == 0u) { xcd_barrier_complete(bar, bx, nloc, nx); b.st[0] = nloc; b.st[1] = nx; }
        const unsigned old = xb_add(&bar[XB_XSUB(bx)], 1u);
        const unsigned gen = old / nloc;
        if (old + 1u == (gen + 1u) * nloc) {
            __builtin_amdgcn_fence(__ATOMIC_RELEASE, "agent");
            asm volatile("s_waitcnt vmcnt(0)" ::: "memory");
            const unsigned og = xb_add(&bar[XB_TOP], 1u);
            const unsigned tg = og / nx;
            if (og + 1u == (tg + 1u) * nx) xb_add(&bar[XB_TOPGEN], 1u);
            else XB_SPIN(xb_ld(&bar[XB_TOPGEN]) == tg, bar);
            __builtin_amdgcn_fence(__ATOMIC_ACQUIRE, "agent");
            xb_add(&bar[XB_XGEN(bx)], 1u);
            asm volatile("s_waitcnt vmcnt(0)" ::: "memory");
        } else {
            XB_SPIN(xb_ld(&bar[XB_XGEN(bx)]) == gen, bar);
            __builtin_amdgcn_fence(__ATOMIC_ACQUIRE, "agent");
            asm volatile("s_waitcnt vmcnt(0)" ::: "memory");
        }
    }
    __syncthreads();
}

constexpr int N_PHASES = 1 + DEPTH * 10;
constexpr int ATT_PROBE = -1;
constexpr int REP0 = 1, REP1 = 1, REP2 = 1, REP3 = 1, REP4 = 1, REP5 = 1, REP6 = 1, REP7 = 1, REP8 = 1, REP9 = 1;

#define PHASE_BEGIN KP p = (KP)__builtin_amdgcn_kernarg_segment_ptr(); asm volatile("" : "+s"(p)); unsigned char* ws = p->ws; const int G = gridDim.x, c = obid(); (void)G; (void)c; (void)ws;
__global__ void __launch_bounds__(512) mega(Params p_unused, int ph_lo, int ph_hi) {
    extern __shared__ __attribute__((aligned(16))) unsigned char lds_raw[];
    LAS unsigned char* lds = (LAS unsigned char*)lds_raw;
    cg::grid_group grid = cg::this_grid();
    const int wv = __builtin_amdgcn_readfirstlane((int)(threadIdx.x >> 6));
    { volatile LAS unsigned* st0 = (volatile LAS unsigned*)(lds + 131072); if (threadIdx.x == 0) { st0[0] = 0u; st0[1] = 0u; } __syncthreads(); }
    const XcdBarrier xbar = xcd_barrier_post((unsigned*)(((KP)__builtin_amdgcn_kernarg_segment_ptr())->ws + WS_BAR), (volatile LAS unsigned*)(lds + 131072));
    {   PHASE_BEGIN
        mod_phase(lds, p, wv);
        const int tid0 = otid();
        if (c == 0 && tid0 < 64) { const int lane = tid0;
            for (int l = 0; l < DEPTH; ++l) { const float* la = p->lam_a + l * 256; const float s1 = wave_sum(la[lane] * la[64 + lane]), s2 = wave_sum(la[128 + lane] * la[192 + lane]);
                const float li = l == 0 ? LAM_INIT[0] : (l == 1 ? LAM_INIT[1] : (l == 2 ? LAM_INIT[2] : LAM_INIT[3]));
                if (lane == 0) { ((float*)(ws + WS_LAM))[l] = __expf(s1) - __expf(s2) + li; ((float*)(ws + WS_LAM))[8 + l] = li; } } }
    }
    if (ph_hi == 0x7fffffff) grid.sync();
    xcd_barrier(xbar, wv);
    for (int l = 0; l < DEPTH; ++l) {
        const bool last = (l == DEPTH - 1);
        const int Mact = last ? MX : MT;
        for (int rep = 0; rep < REP0; ++rep) { PHASE_BEGIN
            if (rep) __syncthreads();
            convert_weights(lds, p, l, wv); bias_gemv(lds, p, l, wv); if (l == 0) init_h(p, wv); }
        xcd_barrier(xbar, wv);
        for (int rep = 0; rep < REP1; ++rep) { PHASE_BEGIN
            pg8::Gemm g{(const bf16_t*)(ws + WS_H), (const bf16_t*)(ws + WS_WIN), DM, DM, DM, 0, 0};
            pg8::Epi<1> E{(bf16_t*)(ws + WS_R1), NPM, NPM / 256, (bf16_t*)(ws + WS_R2), NPG, nullptr, nullptr, nullptr, nullptr, nullptr, nullptr, nullptr, (bf16_t*)(ws + WS_VA), nullptr, (const float*)(ws + WS_PART), (const float*)(ws + WS_BIAS1), NIN};
            pg8::StaticOrder S; S.init(MT, NIN, G, c);
            pg8::gemm_phase(lds, g, S, E, wv); }
        xcd_barrier(xbar, wv);
        for (int rep = 0; rep < REP2; ++rep) { PHASE_BEGIN prep1_phase(p, l, wv); }
        xcd_barrier(xbar, wv);
        for (int rep = 0; rep < REP3; ++rep) { PHASE_BEGIN
            { int k1 = 384; asm volatile("" : "+s"(k1));
              pg8::Gemm g{(const bf16_t*)(ws + WS_CQ), (const bf16_t*)(ws + WS_WUQ), k1, k1, k1, 0, 0};
              pg8::Epi<6> E{(bf16_t*)(ws + WS_QB), l, 0, nullptr, 0, nullptr, nullptr, nullptr, p->gq_b + l * 96, nullptr, nullptr, nullptr, nullptr, nullptr, nullptr, nullptr, 0};
              pg8::StaticOrder S; S.init(MT, 768, G, c);
              pg8::gemm_phase(lds, g, S, E, wv); }
            { int k2 = 256; asm volatile("" : "+s"(k2));
              pg8::Gemm g{(const bf16_t*)(ws + WS_CKV), (const bf16_t*)(ws + WS_WUKV), k2, k2, k2, 0, 0};
              pg8::Epi<7> E{(bf16_t*)(ws + WS_KB), l, 0, (bf16_t*)(ws + WS_VB), 0, (const bf16_t*)(ws + WS_KR), nullptr, nullptr, p->gk_b + l * 96, nullptr, nullptr, nullptr, nullptr, nullptr, nullptr, nullptr, 0};
              pg8::StaticOrder S; S.init(MT, 1024, G, (c + 40) % G);
              pg8::gemm_phase(lds, g, S, E, wv); } }
        xcd_barrier(xbar, wv);
        { PHASE_BEGIN attn_phase<0>(lds, p, l, wv); }
        if (ATT_PROBE >= 0) { PHASE_BEGIN __syncthreads(); attn_phase<(ATT_PROBE < 0 ? 0 : ATT_PROBE)>(lds, p, l, wv); }
        xcd_barrier(xbar, wv);
        for (int rep = 0; rep < REP6; ++rep) { PHASE_BEGIN
            pg8::Gemm g{(const bf16_t*)(ws + WS_Y), (const bf16_t*)(ws + WS_WBR), 512, 2048, 512, 2, 1024};
            pg8::Epi<2> E{(bf16_t*)(ws + WS_R1), 4096, 0, nullptr, 0, (const bf16_t*)(ws + WS_R2), nullptr, nullptr, nullptr, nullptr, nullptr, nullptr, nullptr, nullptr, nullptr, nullptr, 0};
            pg8::StaticOrder S; S.init(Mact, 4096, G, c);
            pg8::gemm_phase(lds, g, S, E, wv); }
        xcd_barrier(xbar, wv);
        { PHASE_BEGIN presum_phase(p, Mact, wv); }
        xcd_barrier(xbar, wv);
        for (int rep = 0; rep < REP7; ++rep) { PHASE_BEGIN
            pg8::Gemm g{(const bf16_t*)(ws + WS_MIX), (const bf16_t*)(ws + WS_WO4), DM, DM, 4096, 0, 0};
            pg8::Epi<3> E{nullptr, rep ? 12345 : 0, 0, nullptr, 0, nullptr, p->out, (float*)(ws + WS_XC), (const float*)(ws + WS_MOD) + (size_t)l * 9 * 6144 + 2 * 1024, l == 0 ? p->x : (const float*)p->out, l == 0 ? p->ctx : (const float*)(ws + WS_XC),
                          (const float*)(ws + WS_VM) + ((size_t)l * 2 + 1) * 9 * DM, (bf16_t*)(ws + WS_H), (float*)(ws + WS_PART), nullptr, nullptr, 0};
            pg8::StaticOrder S; S.init(Mact, DM, G, c);
            pg8::gemm_phase(lds, g, S, E, wv); }
        xcd_barrier(xbar, wv);
        for (int rep = 0; rep < REP8; ++rep) { PHASE_BEGIN
            pg8::Gemm g{(const bf16_t*)(ws + WS_H), (const bf16_t*)(ws + WS_WF1), DM, DM, DM, 0, 0};
            pg8::Epi<4> E{(bf16_t*)(ws + WS_R2), DFF, 0, nullptr, 0, nullptr, nullptr, nullptr, nullptr, nullptr, nullptr, nullptr, nullptr, nullptr, (const float*)(ws + WS_PART), (const float*)(ws + WS_BIAS2), DFF};
            pg8::StaticOrder S; S.init(Mact, DFF, G, c);
            pg8::gemm_phase(lds, g, S, E, wv); }
        xcd_barrier(xbar, wv);
        for (int rep = 0; rep < REP9; ++rep) { PHASE_BEGIN
            pg8::Gemm g{(const bf16_t*)(ws + WS_R2), (const bf16_t*)(ws + WS_WF2), DFF, DFF, DFF, 0, 0};
            pg8::Epi<3> E{nullptr, rep ? 12345 : 0, 0, nullptr, 0, nullptr, p->out, (float*)(ws + WS_XC), (const float*)(ws + WS_MOD) + (size_t)l * 9 * 6144 + 5 * 1024, (const float*)p->out, (const float*)(ws + WS_XC),
                          last ? nullptr : (const float*)(ws + WS_VM) + ((size_t)(l + 1) * 2 + 0) * 9 * DM, (bf16_t*)(ws + WS_H), (float*)(ws + WS_PART), nullptr, nullptr, 0};
            pg8::StaticOrder S; S.init(Mact, DM, G, c);
            pg8::gemm_phase(lds, g, S, E, wv); }
        if (!last) xcd_barrier(xbar, wv);
    }
}

extern "C" void kernel_launch(void* const* d_in, const int* in_sizes, int n_in, void* d_out, int out_size, void* d_ws, size_t ws_size, hipStream_t stream) {
    static int grid = 0;
    if (grid == 0) {
        if (n_in != 26 || out_size != MX * DM || ws_size < WS_END) { fprintf(stderr, "kernel_launch: unexpected problem (n_in %d out %d ws %zu)\n", n_in, out_size, ws_size); grid = -1; return; }
        int dev = 0, cus = 0, per_cu = 0;
        hipGetDevice(&dev); hipDeviceGetAttribute(&cus, hipDeviceAttributeMultiprocessorCount, dev);
        hipFuncSetAttribute((const void*)mega, hipFuncAttributeMaxDynamicSharedMemorySize, LDS_BYTES);
        hipOccupancyMaxActiveBlocksPerMultiprocessor(&per_cu, (const void*)mega, 512, LDS_BYTES);
        (void)hipGetLastError();
        grid = cus > 0 ? cus : 256;
        if (per_cu < 1) fprintf(stderr, "kernel_launch: occupancy query says %d blocks/CU\n", per_cu);
    }
    if (grid < 0) return;
    Params p{};
    const float** pp = (const float**)&p;
    for (int i = 0; i < 26; ++i) pp[i] = (const float*)d_in[i];
    p.out = (float*)d_out; p.ws = (unsigned char*)d_ws;
    if (hipMemsetAsync((char*)d_ws + WS_BAR, 0, XCD_BAR_WORDS * 4, stream) != hipSuccess) { fprintf(stderr, "memset failed\n"); return; }
#if MK_COOP
    int lo = 0, hi = N_PHASES;
    void* args[] = {&p, &lo, &hi};
    hipError_t e = hipLaunchCooperativeKernel((const void*)mega, dim3(grid), dim3(512), args, LDS_BYTES, stream);
    if (e != hipSuccess) fprintf(stderr, "cooperative launch failed: %s\n", hipGetErrorString(e));
#else
    for (int ph = 0; ph < N_PHASES; ++ph) hipLaunchKernelGGL(mega, dim3(grid), dim3(512), LDS_BYTES, stream, p, ph, ph + 1);
#endif
}
```
